# Optimizing an MI355X kernel written in HIP

```python
import jax, jax.numpy as jnp
from jax import lax
import numpy as np

D_MODEL = 1024
BATCH = 4
SEQ = 4096
DEPTH = 1

GLA_HEADS = 4
GLA_DK = D_MODEL // 8
GLA_DV = D_MODEL // 4
GLA_GATE_RANK = 16
GLA_TAU = 16.0
GLA_CHUNK = 64
NSA_HEADS = 8
NSA_KV_HEADS = 2
NSA_HD = 128
NSA_GROUP = NSA_HEADS // NSA_KV_HEADS
CMP_LEN = 32
CMP_STRIDE = 16
CMP_HIDDEN = 2 * NSA_HD
SEL_BLOCK = 64
SEL_TOPK = 16
SEL_QCHUNK = 64
WIN = 512
WIN_BLOCK = 128
N_EXPERTS = 32
TOP_K = 4
D_EXPERT = D_MODEL
SWIGLU_LIMIT = 7.0
SWIGLU_ALPHA = 1.702
MOE_BLOCK = 256
RMS_EPS = 1e-5

IN_SPLITS = (
    GLA_HEADS * GLA_DK,
    GLA_HEADS * GLA_DK,
    GLA_HEADS * GLA_DV,
    GLA_HEADS * GLA_DV,
    GLA_GATE_RANK,
    NSA_HEADS * NSA_HD,
    NSA_KV_HEADS * NSA_HD, NSA_KV_HEADS * NSA_HD,
    NSA_KV_HEADS * NSA_HD, NSA_KV_HEADS * NSA_HD,
    NSA_KV_HEADS * NSA_HD, NSA_KV_HEADS * NSA_HD,
    NSA_HEADS * 3,
    2 * D_MODEL,
)
IN_COLS = sum(IN_SPLITS)

kernel_name = "hybrid_gla_nsa_moe_block"


def _rmsnorm(x, g):
    xf = x.astype(jnp.float32)
    y = xf * lax.rsqrt(jnp.mean(xf * xf, axis=-1, keepdims=True) + RMS_EPS)
    return (y * g.astype(jnp.float32)).astype(x.dtype)


def _masked_softmax(s, mask):
    s = jnp.where(mask, s, -jnp.inf)
    m = jnp.max(s, axis=-1, keepdims=True)
    m = jnp.where(jnp.isfinite(m), m, 0.0)
    e = jnp.where(mask, jnp.exp(s - m), 0.0)
    return e / jnp.maximum(jnp.sum(e, axis=-1, keepdims=True), 1e-30)


def _gla(q, k, v, log_a):
    B, T, H, dk = q.shape
    dv = v.shape[-1]
    C = GLA_CHUNK
    N = T // C

    def chunks(t):
        return t.reshape(B, N, C, H, t.shape[-1]).transpose(0, 3, 1, 2, 4)

    qc = chunks(q) * dk ** -0.5
    kc = chunks(k)
    vc = chunks(v)
    bcum = jnp.cumsum(chunks(log_a).astype(jnp.float32), axis=3)
    qe = qc * jnp.exp(bcum)
    ke = kc * jnp.exp(-bcum)
    causal = jnp.tril(jnp.ones((C, C), dtype=bool))
    A = jnp.where(causal, jnp.einsum('bhnid,bhnjd->bhnij', qe, ke), 0.0)
    intra = jnp.einsum('bhnij,bhnjv->bhniv', A, vc)
    blast = bcum[:, :, :, -1:, :]
    kdec = kc * jnp.exp(blast - bcum)
    cstate = jnp.einsum('bhncd,bhncv->nbhdv', kdec, vc)
    cdecay = jnp.exp(blast[:, :, :, 0, :]).transpose(2, 0, 1, 3)

    def step(S, inp):
        dec, cs = inp
        return dec[..., None] * S + cs, S

    _, s_prev = lax.scan(step, jnp.zeros((B, H, dk, dv), jnp.float32), (cdecay, cstate))
    inter = jnp.einsum('bhnid,nbhdv->bhniv', qe, s_prev)
    o = intra + inter
    return o.transpose(0, 2, 3, 1, 4).reshape(B, T, H, dv).astype(v.dtype)


def _compress(k, pe, w1, w2):
    B, G, T, hd = k.shape
    ncmp = (T - CMP_LEN) // CMP_STRIDE + 1
    idx = jnp.arange(ncmp)[:, None] * CMP_STRIDE + jnp.arange(CMP_LEN)[None, :]
    blocks = k[:, :, idx] + pe
    flat = blocks.reshape(B, G, ncmp, CMP_LEN * hd)
    return jax.nn.gelu(flat @ w1) @ w2


def _nsa_selected(q, k, v, blk_idx, blk_ok):
    B, G, R, T, hd = q.shape
    n = blk_idx.shape[-1]
    QS = SEL_QCHUNK
    nq = T // QS
    kb = k.reshape(B, G, T // SEL_BLOCK, SEL_BLOCK, hd)
    vb = v.reshape(B, G, T // SEL_BLOCK, SEL_BLOCK, hd)
    bi = jnp.arange(B)[:, None, None, None]
    gi = jnp.arange(G)[None, :, None, None]
    offs = jnp.arange(SEL_BLOCK)

    def one_chunk(args):
        qc, ic, okc, pos = args
        kg = kb[bi, gi, ic]
        vg = vb[bi, gi, ic]
        s = jnp.einsum('bgrqd,bgqnld->bgrqnl', qc, kg).astype(jnp.float32) * hd ** -0.5
        kpos = ic[..., None] * SEL_BLOCK + offs
        mask = okc[..., None] & (kpos <= pos[:, None, None])
        mask = mask.reshape(B, G, 1, QS, n * SEL_BLOCK)
        p = _masked_softmax(s.reshape(B, G, R, QS, n * SEL_BLOCK), mask)
        p = p.reshape(B, G, R, QS, n, SEL_BLOCK)
        return jnp.einsum('bgrqnl,bgqnld->bgrqd', p.astype(vg.dtype), vg)

    xs = (jnp.moveaxis(q.reshape(B, G, R, nq, QS, hd), 3, 0),
          jnp.moveaxis(blk_idx.reshape(B, G, nq, QS, n), 2, 0),
          jnp.moveaxis(blk_ok.reshape(B, G, nq, QS, n), 2, 0),
          jnp.arange(T).reshape(nq, QS))
    out = lax.map(one_chunk, xs)
    return jnp.moveaxis(out, 0, 3).reshape(B, G, R, T, hd)


def _nsa_window(q, k, v):
    B, G, R, T, hd = q.shape
    nb = T // WIN_BLOCK
    nw = WIN // WIN_BLOCK
    pad = ((0, 0), (0, 0), (WIN, 0), (0, 0))
    kp = jnp.pad(k, pad).reshape(B, G, nb + nw, WIN_BLOCK, hd)
    vp = jnp.pad(v, pad).reshape(B, G, nb + nw, WIN_BLOCK, hd)
    kw = jnp.concatenate([kp[:, :, i:i + nb] for i in range(nw + 1)], axis=3)
    vw = jnp.concatenate([vp[:, :, i:i + nb] for i in range(nw + 1)], axis=3)
    qb = q.reshape(B, G, R, nb, WIN_BLOCK, hd)
    s = jnp.einsum('bgrnqd,bgnkd->bgrnqk', qb, kw).astype(jnp.float32) * hd ** -0.5
    qpos = jnp.arange(nb)[:, None, None] * WIN_BLOCK + jnp.arange(WIN_BLOCK)[None, :, None]
    kpos = jnp.arange(nb)[:, None, None] * WIN_BLOCK - WIN + jnp.arange((nw + 1) * WIN_BLOCK)[None, None, :]
    mask = (kpos >= 0) & (kpos <= qpos) & (qpos - kpos < WIN)
    p = _masked_softmax(s, mask)
    o = jnp.einsum('bgrnqk,bgnkd->bgrnqd', p.astype(vw.dtype), vw)
    return o.reshape(B, G, R, T, hd)


def _nsa(q, k_c, v_c, k_s, v_s, k_w, v_w, gates, cmp_pe, cmp_w1, cmp_w2):
    T, hd = q.shape[3], q.shape[4]
    ncmp = (T - CMP_LEN) // CMP_STRIDE + 1
    nsel = T // SEL_BLOCK
    n_top = min(SEL_TOPK, nsel)
    tpos = jnp.arange(T)
    kc = _compress(k_c, cmp_pe[0], cmp_w1[0], cmp_w2[0])
    vc = _compress(v_c, cmp_pe[1], cmp_w1[1], cmp_w2[1])
    s = jnp.einsum('bgrtd,bgcd->bgrtc', q, kc).astype(jnp.float32) * hd ** -0.5
    cmask = (jnp.arange(ncmp) * CMP_STRIDE + CMP_LEN - 1)[None, :] <= tpos[:, None]
    p_cmp = _masked_softmax(s, cmask)
    o_cmp = jnp.einsum('bgrtc,bgcd->bgrtd', p_cmp.astype(vc.dtype), vc)
    cstart = jnp.arange(ncmp) * CMP_STRIDE
    sstart = jnp.arange(nsel) * SEL_BLOCK
    overlap = ((cstart[:, None] < sstart[None, :] + SEL_BLOCK)
               & (cstart[:, None] + CMP_LEN > sstart[None, :])).astype(jnp.float32)
    imp = jnp.einsum('bgtc,cs->bgts', jnp.sum(p_cmp, axis=2), overlap)
    jblk = jnp.arange(nsel)[None, :]
    tblk = (tpos // SEL_BLOCK)[:, None]
    forced = (jblk == 0) | (jblk == tblk) | (jblk == tblk - 1)
    valid = jblk * SEL_BLOCK <= tpos[:, None]
    score = jnp.where(forced, jnp.inf, jnp.where(valid, imp, -jnp.inf))
    top_val, top_idx = lax.top_k(score, n_top)
    o_sel = _nsa_selected(q, k_s, v_s, top_idx, top_val > -jnp.inf)
    o_win = _nsa_window(q, k_w, v_w)
    return gates[..., 0:1] * o_cmp + gates[..., 1:2] * o_sel + gates[..., 2:3] * o_win


def _hybrid_mixer(u, w_in, gla_wa2, gla_ba, gla_norm_g, cmp_pe, cmp_w1, cmp_w2, proj_gla, proj_nsa, w_out):
    B, T, _ = u.shape
    proj = u @ w_in
    offs = np.cumsum(IN_SPLITS)[:-1].tolist()
    (g_q, g_k, g_v, g_r, g_a, n_q, n_kc, n_vc, n_ks, n_vs, n_kw, n_vw, n_g, m_g) = jnp.split(proj, offs, axis=-1)
    log_a = jax.nn.log_sigmoid((g_a @ gla_wa2 + gla_ba).astype(jnp.float32)) / GLA_TAU
    o_gla = _gla(g_q.reshape(B, T, GLA_HEADS, GLA_DK), g_k.reshape(B, T, GLA_HEADS, GLA_DK),
                 g_v.reshape(B, T, GLA_HEADS, GLA_DV), log_a.reshape(B, T, GLA_HEADS, GLA_DK))
    y_gla = (_rmsnorm(o_gla, gla_norm_g) * jax.nn.silu(g_r.reshape(B, T, GLA_HEADS, GLA_DV)))
    y_gla = y_gla.reshape(B, T, GLA_HEADS * GLA_DV)
    qn = n_q.reshape(B, T, NSA_KV_HEADS, NSA_GROUP, NSA_HD).transpose(0, 2, 3, 1, 4)

    def kv(t):
        return t.reshape(B, T, NSA_KV_HEADS, NSA_HD).transpose(0, 2, 1, 3)

    gates = jax.nn.sigmoid(n_g).reshape(B, T, NSA_KV_HEADS, NSA_GROUP, 3).transpose(0, 2, 3, 1, 4)
    o_nsa = _nsa(qn, kv(n_kc), kv(n_vc), kv(n_ks), kv(n_vs), kv(n_kw), kv(n_vw), gates, cmp_pe, cmp_w1, cmp_w2)
    y_nsa = o_nsa.transpose(0, 3, 1, 2, 4).reshape(B, T, NSA_HEADS * NSA_HD)
    mg = jax.nn.sigmoid(m_g).reshape(B, T, 2, D_MODEL)
    merged = mg[:, :, 0] * (y_gla @ proj_gla) + mg[:, :, 1] * (y_nsa @ proj_nsa)
    return merged @ w_out


def _moe(u, router_w, router_b, w1, b1, w2, b2):
    B, T, D = u.shape
    N = B * T
    A = N * TOP_K
    M = MOE_BLOCK
    xt = u.reshape(N, D)
    logits = (xt @ router_w + router_b).astype(jnp.float32)
    top_v, top_e = lax.top_k(logits, TOP_K)
    wts = jax.nn.softmax(top_v, axis=-1)
    flat_e = top_e.reshape(-1)
    flat_t = jnp.repeat(jnp.arange(N, dtype=jnp.int32), TOP_K)
    flat_w = wts.reshape(-1)
    order = jnp.argsort(flat_e)
    se, st, sw = flat_e[order], flat_t[order], flat_w[order]
    counts = jnp.bincount(flat_e, length=N_EXPERTS)
    starts = jnp.cumsum(counts) - counts
    padded = ((counts + M - 1) // M) * M
    pends = jnp.cumsum(padded)
    pstarts = pends - padded
    dest = pstarts[se] + jnp.arange(A) - starts[se]
    P = A + N_EXPERTS * M
    nblk = P // M
    row_tok = jnp.full((P,), N, jnp.int32).at[dest].set(st)
    row_w = jnp.zeros((P,), jnp.float32).at[dest].set(sw)
    blk_e = jnp.minimum(jnp.searchsorted(pends, jnp.arange(nblk) * M, side='right'), N_EXPERTS - 1)
    xpad = jnp.concatenate([xt, jnp.zeros((1, D), xt.dtype)], axis=0)

    def expert_block(args):
        e, toks = args
        hb = xpad[toks] @ w1[e] + b1[e]
        gate, up = hb[:, :D_EXPERT], hb[:, D_EXPERT:]
        gate = jnp.minimum(gate, SWIGLU_LIMIT)
        up = jnp.clip(up, -SWIGLU_LIMIT, SWIGLU_LIMIT)
        act = gate * jax.nn.sigmoid(SWIGLU_ALPHA * gate) * (up + 1.0)
        return act @ w2[e] + b2[e]

    yb = lax.map(expert_block, (blk_e, row_tok.reshape(nblk, M)))
    yb = yb.reshape(P, D)
    y = jnp.zeros((N + 1, D), yb.dtype).at[row_tok].add(yb * row_w[:, None].astype(yb.dtype))
    return y[:N].reshape(B, T, D)


def setup_inputs(seed: int = 0) -> dict:
    key = jax.random.key(seed)
    ks = jax.random.split(key, 24)
    D, L, E, F = D_MODEL, DEPTH, N_EXPERTS, D_EXPERT

    def nrm(k, shape, scale):
        return jax.random.normal(k, shape, jnp.float32) * scale

    return {
        'x': nrm(ks[0], (BATCH, SEQ, D), 1.0),
        'c': nrm(ks[1], (BATCH, D), 1.0),
        'w_ada': nrm(ks[2], (L, D, 6 * D), D ** -0.5),
        'b_ada': nrm(ks[3], (L, 6 * D), 0.02),
        'norm1_g': 1.0 + nrm(ks[4], (L, D), 0.02),
        'w_in': nrm(ks[5], (L, D, IN_COLS), D ** -0.5),
        'gla_wa2': nrm(ks[6], (L, GLA_GATE_RANK, GLA_HEADS * GLA_DK), GLA_GATE_RANK ** -0.5),
        'gla_ba': nrm(ks[7], (L, GLA_HEADS * GLA_DK), 0.1),
        'gla_norm_g': 1.0 + nrm(ks[8], (L, GLA_DV), 0.02),
        'cmp_pe': nrm(ks[9], (L, 2, CMP_LEN, NSA_HD), 0.1),
        'cmp_w1': nrm(ks[10], (L, 2, CMP_LEN * NSA_HD, CMP_HIDDEN), (CMP_LEN * NSA_HD) ** -0.5),
        'cmp_w2': nrm(ks[11], (L, 2, CMP_HIDDEN, NSA_HD), CMP_HIDDEN ** -0.5),
        'proj_gla': nrm(ks[12], (L, GLA_HEADS * GLA_DV, D), (GLA_HEADS * GLA_DV) ** -0.5),
        'proj_nsa': nrm(ks[13], (L, NSA_HEADS * NSA_HD, D), (NSA_HEADS * NSA_HD) ** -0.5),
        'w_out': nrm(ks[14], (L, D, D), D ** -0.5),
        'norm2_g': 1.0 + nrm(ks[15], (L, D), 0.02),
        'router_w': nrm(ks[16], (L, D, E), D ** -0.5),
        'router_b': nrm(ks[17], (L, E), 0.01),
        'moe_w1': nrm(ks[18], (L, E, D, 2 * F), D ** -0.5),
        'moe_b1': nrm(ks[19], (L, E, 2 * F), 0.02),
        'moe_w2': nrm(ks[20], (L, E, F, D), F ** -0.5),
        'moe_b2': nrm(ks[21], (L, E, D), 0.02),
        'final_g': 1.0 + nrm(ks[22], (D,), 0.02),
    }


def reference(x, c, w_ada, b_ada, norm1_g, w_in, gla_wa2, gla_ba, gla_norm_g, cmp_pe, cmp_w1, cmp_w2,
              proj_gla, proj_nsa, w_out, norm2_g, router_w, router_b, moe_w1, moe_b1, moe_w2, moe_b2, final_g):
    B = x.shape[0]
    h = x
    cond = jax.nn.silu(c)
    for l in range(DEPTH):
        mod = (cond @ w_ada[l] + b_ada[l]).reshape(B, 6, 1, D_MODEL)
        shift1, scale1, gate1, shift2, scale2, gate2 = [mod[:, i] for i in range(6)]
        u1 = _rmsnorm(h, norm1_g[l]) * (1.0 + scale1) + shift1
        h = h + gate1 * _hybrid_mixer(u1, w_in[l], gla_wa2[l], gla_ba[l], gla_norm_g[l], cmp_pe[l], cmp_w1[l],
                                      cmp_w2[l], proj_gla[l], proj_nsa[l], w_out[l])
        u2 = _rmsnorm(h, norm2_g[l]) * (1.0 + scale2) + shift2
        h = h + gate2 * _moe(u2, router_w[l], router_b[l], moe_w1[l], moe_b1[l], moe_w2[l], moe_b2[l])
    return _rmsnorm(h, final_g)
```

```cpp
#include <hip/hip_runtime.h>
#include <stdint.h>
#include <math.h>

typedef unsigned short bf16_t;
typedef unsigned long long u64;

constexpr int BATCH = 4, SEQ = 4096, DM = 1024, NTOK = BATCH * SEQ;
constexpr int IN_COLS = 7720, PLD = 7936;
constexpr int C_GQ = 0, C_GK = 512, C_GV = 1024, C_GR = 2048, C_NQ = 3072, C_KC = 4096, C_VC = 4352, C_KS = 4608, C_VS = 4864,
              C_KW = 5120, C_VW = 5376, C_MG = 5632, C_GA = 7680, C_NG = 7696;
constexpr int NCMP = 255, NSEL = 64, NEXP = 32, TOPK = 4, MOEB = 256;
constexpr int PROWS = NTOK * TOPK + NEXP * MOEB;
constexpr float RMS_EPS = 1e-5f;

__host__ __device__ inline int orig_col(int j) {
    if (j < 3072) return j;
    if (j < 5632) return j + 16;
    if (j < 7680) return j + 40;
    if (j < 7696) return j - 4608;
    return j - 2048;
}

constexpr size_t MiB = 1u << 20;
constexpr size_t WS_CTL = 0;
constexpr size_t WS_MOD = 1 * MiB;
constexpr size_t WS_U1 = 2 * MiB;
constexpr size_t WS_PROJ = 34 * MiB;
constexpr size_t WS_LOGA = 282 * MiB;
constexpr size_t WS_OGLA = 314 * MiB;
constexpr size_t WS_YGLA = 378 * MiB;
constexpr size_t WS_HID = 410 * MiB;
constexpr size_t WS_KCVC = 414 * MiB;
constexpr size_t WS_SELM = 416 * MiB;
constexpr size_t WS_OCMP = 417 * MiB;
constexpr size_t WS_OSEL = 481 * MiB;
constexpr size_t WS_OWIN = 545 * MiB;
constexpr size_t WS_YNSA = 609 * MiB;
constexpr size_t WS_TMPF = 641 * MiB;
constexpr size_t WS_MERG = 705 * MiB;
constexpr size_t WS_H1 = 737 * MiB;
constexpr size_t WS_U2 = 801 * MiB;
constexpr size_t WS_TOPE = 833 * MiB;
constexpr size_t WS_TOPW = 833 * MiB + 512 * 1024;
constexpr size_t WS_ROWTOK = 834 * MiB;
constexpr size_t WS_SLOTOF = 834 * MiB + 512 * 1024;
constexpr size_t WS_ACT = 34 * MiB;
constexpr size_t WS_YSLOT = 178 * MiB;
constexpr int CT_CNT = 0, CT_FILL = 64, CT_PSTART = 128, CT_PTOT = 192, CT_BLKE = 256;

__device__ __forceinline__ float bf2f(bf16_t v) { return __uint_as_float(((unsigned)v) << 16); }
__device__ __forceinline__ bf16_t f2bf(float f) { unsigned u = __float_as_uint(f); return (bf16_t)((u + 0x7fffu + ((u >> 16) & 1u)) >> 16); }
__device__ __forceinline__ float sigmoidf_(float x) { return 1.f / (1.f + __expf(-x)); }
__device__ __forceinline__ float siluf_(float x) { return x / (1.f + __expf(-x)); }
__device__ __forceinline__ float wave_sum(float v) {
#pragma unroll
    for (int o = 1; o < 64; o <<= 1) v += __shfl_xor(v, o);
    return v;
}
__device__ __forceinline__ float wave_max(float v) {
#pragma unroll
    for (int o = 1; o < 64; o <<= 1) v = fmaxf(v, __shfl_xor(v, o));
    return v;
}

struct P {
    const float *x, *c, *w_ada, *b_ada, *norm1_g, *w_in, *gla_wa2, *gla_ba, *gla_norm_g, *cmp_pe, *cmp_w1, *cmp_w2, *proj_gla, *proj_nsa,
        *w_out, *norm2_g, *router_w, *router_b, *moe_w1, *moe_b1, *moe_w2, *moe_b2, *final_g;
    float* out;
    unsigned char* ws;
};
#define WSP(T, off) ((T*)(p.ws + (off)))

__global__ void __launch_bounds__(256) k_mod(P p) {
    __shared__ float sc[4 * 1024];
    for (int i = threadIdx.x; i < 4096; i += 256) sc[i] = siluf_(p.c[i]);
    __syncthreads();
    const int j = blockIdx.x * 256 + threadIdx.x;
    float a0 = 0, a1 = 0, a2 = 0, a3 = 0;
    for (int k = 0; k < 1024; ++k) { const float w = p.w_ada[(size_t)k * 6144 + j]; a0 += sc[k] * w; a1 += sc[1024 + k] * w; a2 += sc[2048 + k] * w; a3 += sc[3072 + k] * w; }
    float* mod = WSP(float, WS_MOD); const float bb = p.b_ada[j];
    mod[j] = a0 + bb; mod[6144 + j] = a1 + bb; mod[2 * 6144 + j] = a2 + bb; mod[3 * 6144 + j] = a3 + bb;
}

__global__ void __launch_bounds__(256) k_u1(P p) {
    const int row = blockIdx.x * 4 + (threadIdx.x >> 6), lane = threadIdx.x & 63, b = row / SEQ;
    const float* xr = p.x + (size_t)row * DM; const float* mod = WSP(float, WS_MOD) + b * 6144;
    float v[16]; float ss = 0.f;
#pragma unroll
    for (int i = 0; i < 16; ++i) { v[i] = xr[lane + 64 * i]; ss += v[i] * v[i]; }
    const float rstd = rsqrtf(wave_sum(ss) * (1.f / DM) + RMS_EPS);
    bf16_t* u = WSP(bf16_t, WS_U1) + (size_t)row * DM;
#pragma unroll
    for (int i = 0; i < 16; ++i) { const int col = lane + 64 * i; u[col] = f2bf(v[i] * rstd * p.norm1_g[col] * (1.f + mod[1024 + col]) + mod[col]); }
}

template <class F, bool DUAL>
__global__ void __launch_bounds__(256) sgemm_k(F f, P p) {
    __shared__ float As[16][68]; __shared__ float Bs[16][68]; __shared__ float Bs2[16][68];
    const int tid = threadIdx.x, tx = tid & 15, ty = tid >> 4;
    const int m0 = blockIdx.y * 64, n0 = blockIdx.x * 64;
    if (!f.init(p, m0)) return;
    float acc[4][4], acc2[4][4];
#pragma unroll
    for (int i = 0; i < 4; ++i)
#pragma unroll
        for (int j = 0; j < 4; ++j) { acc[i][j] = 0.f; acc2[i][j] = 0.f; }
    const int K = f.K;
    for (int k0 = 0; k0 < K; k0 += 16) {
        { const int r = tid >> 2, kq = (tid & 3) * 4;
#pragma unroll
          for (int i = 0; i < 4; ++i) As[kq + i][r] = f.a(p, m0 + r, k0 + kq + i); }
        { const int kk = tid >> 4, cc = (tid & 15) * 4;
#pragma unroll
          for (int i = 0; i < 4; ++i) { Bs[kk][cc + i] = f.b(p, k0 + kk, n0 + cc + i); if (DUAL) Bs2[kk][cc + i] = f.b2(p, k0 + kk, n0 + cc + i); } }
        __syncthreads();
#pragma unroll
        for (int kk = 0; kk < 16; ++kk) {
            float a[4], b[4], b2[4];
#pragma unroll
            for (int i = 0; i < 4; ++i) { a[i] = As[kk][ty * 4 + i]; b[i] = Bs[kk][tx * 4 + i]; b2[i] = DUAL ? Bs2[kk][tx * 4 + i] : 0.f; }
#pragma unroll
            for (int i = 0; i < 4; ++i)
#pragma unroll
                for (int j = 0; j < 4; ++j) { acc[i][j] += a[i] * b[j]; if (DUAL) acc2[i][j] += a[i] * b2[j]; }
        }
        __syncthreads();
    }
#pragma unroll
    for (int i = 0; i < 4; ++i)
#pragma unroll
        for (int j = 0; j < 4; ++j) f.store(p, m0 + ty * 4 + i, n0 + tx * 4 + j, acc[i][j], acc2[i][j]);
}

struct F_inproj {
    int K;
    __device__ bool init(const P&, int) { return true; }
    __device__ float a(const P& p, int r, int k) const { return bf2f(WSP(bf16_t, WS_U1)[(size_t)r * DM + k]); }
    __device__ float b(const P& p, int k, int c) const { return c < IN_COLS ? p.w_in[(size_t)k * IN_COLS + orig_col(c)] : 0.f; }
    __device__ float b2(const P&, int, int) const { return 0.f; }
    __device__ void store(const P& p, int r, int c, float v, float) const { WSP(bf16_t, WS_PROJ)[(size_t)r * PLD + c] = f2bf(v); }
};
__device__ __forceinline__ float gelu_tanh(float x) { const float u = 0.7978845608028654f * (x + 0.044715f * x * x * x); return 0.5f * x * (1.f + tanhf(u)); }
struct F_cmp1 {
    int K, which;
    __device__ bool init(const P&, int) { return true; }
    __device__ float a(const P& p, int r, int k) const {
        if (r >= 2040) return 0.f;
        const int b = r / 510, g = (r / 255) & 1, c = r % 255, l = k >> 7, d = k & 127;
        const size_t tok = (size_t)b * SEQ + 16 * c + l;
        return bf2f(WSP(bf16_t, WS_PROJ)[tok * PLD + (which ? C_VC : C_KC) + g * 128 + d]) + p.cmp_pe[(which * 32 + l) * 128 + d];
    }
    __device__ float b(const P& p, int k, int c) const { return p.cmp_w1[((size_t)which * 4096 + k) * 256 + c]; }
    __device__ float b2(const P&, int, int) const { return 0.f; }
    __device__ void store(const P& p, int r, int c, float v, float) const { if (r < 2040) WSP(float, WS_HID)[((size_t)which * 2040 + r) * 256 + c] = gelu_tanh(v); }
};
struct F_cmp2 {
    int K, which;
    __device__ bool init(const P&, int) { return true; }
    __device__ float a(const P& p, int r, int k) const { return r < 2040 ? WSP(float, WS_HID)[((size_t)which * 2040 + r) * 256 + k] : 0.f; }
    __device__ float b(const P& p, int k, int c) const { return p.cmp_w2[((size_t)which * 256 + k) * 128 + c]; }
    __device__ float b2(const P&, int, int) const { return 0.f; }
    __device__ void store(const P& p, int r, int c, float v, float) const {
        if (r >= 2040) return;
        const int b = r / 510, g = (r / 255) & 1, cc = r % 255;
        WSP(bf16_t, WS_KCVC)[((((size_t)which * 4 + b) * 2 + g) * 256 + cc) * 128 + c] = f2bf(v);
    }
};
struct F_merge1 {
    int K;
    __device__ bool init(const P&, int) { return true; }
    __device__ float a(const P& p, int r, int k) const { return bf2f(WSP(bf16_t, WS_YGLA)[(size_t)r * DM + k]); }
    __device__ float b(const P& p, int k, int c) const { return p.proj_gla[(size_t)k * DM + c]; }
    __device__ float b2(const P&, int, int) const { return 0.f; }
    __device__ void store(const P& p, int r, int c, float v, float) const {
        const float mg = sigmoidf_(bf2f(WSP(bf16_t, WS_PROJ)[(size_t)r * PLD + C_MG + c]));
        WSP(float, WS_TMPF)[(size_t)r * DM + c] = mg * v;
    }
};
struct F_merge2 {
    int K;
    __device__ bool init(const P&, int) { return true; }
    __device__ float a(const P& p, int r, int k) const { return bf2f(WSP(bf16_t, WS_YNSA)[(size_t)r * DM + k]); }
    __device__ float b(const P& p, int k, int c) const { return p.proj_nsa[(size_t)k * DM + c]; }
    __device__ float b2(const P&, int, int) const { return 0.f; }
    __device__ void store(const P& p, int r, int c, float v, float) const {
        const float mg = sigmoidf_(bf2f(WSP(bf16_t, WS_PROJ)[(size_t)r * PLD + C_MG + 1024 + c]));
        WSP(bf16_t, WS_MERG)[(size_t)r * DM + c] = f2bf(WSP(float, WS_TMPF)[(size_t)r * DM + c] + mg * v);
    }
};
struct F_out {
    int K;
    __device__ bool init(const P&, int) { return true; }
    __device__ float a(const P& p, int r, int k) const { return bf2f(WSP(bf16_t, WS_MERG)[(size_t)r * DM + k]); }
    __device__ float b(const P& p, int k, int c) const { return p.w_out[(size_t)k * DM + c]; }
    __device__ float b2(const P&, int, int) const { return 0.f; }
    __device__ void store(const P& p, int r, int c, float v, float) const {
        const int b = r / SEQ; const float gate1 = WSP(float, WS_MOD)[b * 6144 + 2048 + c];
        WSP(float, WS_H1)[(size_t)r * DM + c] = p.x[(size_t)r * DM + c] + gate1 * v;
    }
};
struct F_moe1 {
    int K; int e;
    __device__ bool init(const P& p, int m0) { const int* ctl = WSP(int, WS_CTL); if (m0 >= ctl[CT_PTOT]) return false; e = ctl[CT_BLKE + m0 / MOEB]; return true; }
    __device__ float a(const P& p, int r, int k) const { const int tok = WSP(int, WS_ROWTOK)[r]; return tok < 0 ? 0.f : bf2f(WSP(bf16_t, WS_U2)[(size_t)tok * DM + k]); }
    __device__ float b(const P& p, int k, int c) const { return p.moe_w1[((size_t)e * DM + k) * 2048 + c]; }
    __device__ float b2(const P& p, int k, int c) const { return p.moe_w1[((size_t)e * DM + k) * 2048 + 1024 + c]; }
    __device__ void store(const P& p, int r, int c, float g, float u) const {
        g += p.moe_b1[e * 2048 + c]; u += p.moe_b1[e * 2048 + 1024 + c];
        g = fminf(g, 7.f); u = fminf(fmaxf(u, -7.f), 7.f);
        WSP(bf16_t, WS_ACT)[(size_t)r * DM + c] = f2bf(g * sigmoidf_(1.702f * g) * (u + 1.f));
    }
};
struct F_moe2 {
    int K; int e;
    __device__ bool init(const P& p, int m0) { const int* ctl = WSP(int, WS_CTL); if (m0 >= ctl[CT_PTOT]) return false; e = ctl[CT_BLKE + m0 / MOEB]; return true; }
    __device__ float a(const P& p, int r, int k) const { return bf2f(WSP(bf16_t, WS_ACT)[(size_t)r * DM + k]); }
    __device__ float b(const P& p, int k, int c) const { return p.moe_w2[((size_t)e * DM + k) * DM + c]; }
    __device__ float b2(const P&, int, int) const { return 0.f; }
    __device__ void store(const P& p, int r, int c, float v, float) const { WSP(bf16_t, WS_YSLOT)[(size_t)r * DM + c] = f2bf(v + p.moe_b2[e * DM + c]); }
};

__global__ void __launch_bounds__(256) k_loga(P p) {
    const int row = blockIdx.x >> 1, j = (blockIdx.x & 1) * 256 + threadIdx.x;
    const bf16_t* pr = WSP(bf16_t, WS_PROJ) + (size_t)row * PLD + C_GA;
    float xx = p.gla_ba[j];
#pragma unroll
    for (int r = 0; r < 16; ++r) xx += bf2f(pr[r]) * p.gla_wa2[r * 512 + j];
    const float ls = fminf(xx, 0.f) - log1pf(__expf(-fabsf(xx)));
    WSP(float, WS_LOGA)[(size_t)row * 512 + j] = ls * (1.f / 16.f);
}
__global__ void __launch_bounds__(256) k_gla(P p) {
    const int blk = blockIdx.x, b = blk >> 6, h = (blk >> 4) & 3, vg = blk & 15;
    const int tid = threadIdx.x, vl = tid >> 4, kg = tid & 15;
    const int vcol = h * 256 + vg * 16 + vl;
    float S[8];
#pragma unroll
    for (int i = 0; i < 8; ++i) S[i] = 0.f;
    const bf16_t* proj = WSP(bf16_t, WS_PROJ); const float* loga = WSP(float, WS_LOGA); float* og = WSP(float, WS_OGLA);
    for (int t = 0; t < SEQ; ++t) {
        const size_t row = (size_t)b * SEQ + t;
        const bf16_t* pr = proj + row * PLD;
        const float vv = bf2f(pr[C_GV + vcol]);
        float part = 0.f;
#pragma unroll
        for (int i = 0; i < 8; ++i) {
            const int d = h * 128 + kg * 8 + i;
            const float a = __expf(loga[row * 512 + d]);
            S[i] = a * S[i] + bf2f(pr[C_GK + d]) * vv;
            part += bf2f(pr[C_GQ + d]) * S[i];
        }
        part += __shfl_xor(part, 1); part += __shfl_xor(part, 2); part += __shfl_xor(part, 4); part += __shfl_xor(part, 8);
        if (kg == 0) og[row * DM + vcol] = part * 0.08838834764831845f;
    }
}
__global__ void __launch_bounds__(256) k_ygla(P p) {
    const int w = blockIdx.x * 4 + (threadIdx.x >> 6), lane = threadIdx.x & 63, row = w >> 2, h = w & 3;
    const float* o = WSP(float, WS_OGLA) + (size_t)row * DM + h * 256;
    float v[4]; float ss = 0.f;
#pragma unroll
    for (int i = 0; i < 4; ++i) { v[i] = o[lane + 64 * i]; ss += v[i] * v[i]; }
    const float rstd = rsqrtf(wave_sum(ss) * (1.f / 256.f) + RMS_EPS);
    const bf16_t* pr = WSP(bf16_t, WS_PROJ) + (size_t)row * PLD + C_GR + h * 256;
    bf16_t* y = WSP(bf16_t, WS_YGLA) + (size_t)row * DM + h * 256;
#pragma unroll
    for (int i = 0; i < 4; ++i) { const int dv = lane + 64 * i; y[dv] = f2bf(v[i] * rstd * p.gla_norm_g[dv] * siluf_(bf2f(pr[dv]))); }
}

constexpr float ATT_SCALE = 0.08838834764831845f;
__global__ void __launch_bounds__(256) k_cmpattn(P p) {
    __shared__ float sq[4][128]; __shared__ float sp[4][256]; __shared__ float sps[4][256];
    const int wid = threadIdx.x >> 6, lane = threadIdx.x & 63;
    const int w = blockIdx.x * 4 + wid, b = w >> 13, g = (w >> 12) & 1, t = w & 4095;
    const size_t row = (size_t)b * SEQ + t;
    const bf16_t* pr = WSP(bf16_t, WS_PROJ) + row * PLD;
    const bf16_t* kc = WSP(bf16_t, WS_KCVC) + (((size_t)0 * 4 + b) * 2 + g) * 256 * 128;
    const bf16_t* vc = WSP(bf16_t, WS_KCVC) + (((size_t)1 * 4 + b) * 2 + g) * 256 * 128;
    const int ncv = t >= 31 ? (t - 31) / 16 + 1 : 0;
    float* q = sq[wid]; float* pp = sp[wid]; float* ps = sps[wid];
    for (int i = 0; i < 4; ++i) ps[lane + 64 * i] = 0.f;
    for (int r = 0; r < 4; ++r) {
        const int hq = g * 4 + r;
        q[lane] = bf2f(pr[C_NQ + hq * 128 + lane]); q[lane + 64] = bf2f(pr[C_NQ + hq * 128 + 64 + lane]);
        __builtin_amdgcn_wave_barrier();
        float s[4]; float m = -INFINITY;
        for (int i = 0; i < 4; ++i) {
            const int c = lane + 64 * i; s[i] = -INFINITY;
            if (c < ncv) { float a = 0.f; for (int d = 0; d < 128; ++d) a += q[d] * bf2f(kc[c * 128 + d]); s[i] = a * ATT_SCALE; }
            m = fmaxf(m, s[i]);
        }
        m = wave_max(m);
        float e[4]; float sum = 0.f;
        for (int i = 0; i < 4; ++i) { const int c = lane + 64 * i; e[i] = (c < ncv) ? __expf(s[i] - m) : 0.f; sum += e[i]; }
        sum = wave_sum(sum);
        const float inv = 1.f / fmaxf(sum, 1e-30f);
        for (int i = 0; i < 4; ++i) { const int c = lane + 64 * i; const float pv = e[i] * inv; pp[c] = pv; ps[c] += pv; }
        __builtin_amdgcn_wave_barrier();
        float o0 = 0.f, o1 = 0.f;
        for (int c = 0; c < ncv; ++c) { const float pv = pp[c]; o0 += pv * bf2f(vc[c * 128 + lane]); o1 += pv * bf2f(vc[c * 128 + 64 + lane]); }
        float* oc = WSP(float, WS_OCMP) + row * DM + hq * 128;
        oc[lane] = o0; oc[lane + 64] = o1;
        __builtin_amdgcn_wave_barrier();
    }
    const int s = lane, tb = t >> 6;
    float imp = 0.f;
    for (int c = 4 * s - 1; c <= 4 * s + 3; ++c) if (c >= 0 && c < NCMP) imp += ps[c];
    const bool forced = (s == 0) || (s == tb) || (s == tb - 1), valid = s <= tb;
    const float score = forced ? INFINITY : (valid ? imp : -INFINITY);
    int rank = 0;
    for (int j = 0; j < 64; ++j) { const float sj = __shfl(score, j); rank += (sj > score) || (sj == score && j < s); }
    const bool sel = rank < 16 && score > -INFINITY;
    const u64 mask = __ballot(sel);
    if (lane == 0) WSP(u64, WS_SELM)[(b * 2 + g) * SEQ + t] = mask;
}
template <bool WIN>
__global__ void __launch_bounds__(256) k_sparseattn(P p) {
    __shared__ float sq[4][128]; __shared__ float sp[4][1024];
    const int wid = threadIdx.x >> 6, lane = threadIdx.x & 63;
    const int w = blockIdx.x * 4 + wid, b = w >> 13, g = (w >> 12) & 1, t = w & 4095;
    const size_t row = (size_t)b * SEQ + t;
    const bf16_t* proj = WSP(bf16_t, WS_PROJ);
    const bf16_t* pr = proj + row * PLD;
    const int kcol = (WIN ? C_KW : C_KS) + g * 128, vcol = (WIN ? C_VW : C_VS) + g * 128;
    const u64 mask = WIN ? 0ull : WSP(u64, WS_SELM)[(b * 2 + g) * SEQ + t];
    const int nch = WIN ? 8 : __popcll(mask);
    int base[16];
    { u64 mm = mask;
#pragma unroll
      for (int jj = 0; jj < 16; ++jj) { if (WIN) base[jj] = t - 511 + jj * 64; else { const int bi = mm ? __ffsll((long long)mm) - 1 : 0; base[jj] = bi * 64; mm &= mm - 1; } } }
    float* q = sq[wid]; float* pp = sp[wid];
    for (int r = 0; r < 4; ++r) {
        const int hq = g * 4 + r;
        q[lane] = bf2f(pr[C_NQ + hq * 128 + lane]); q[lane + 64] = bf2f(pr[C_NQ + hq * 128 + 64 + lane]);
        __builtin_amdgcn_wave_barrier();
        float s[16]; float m = -INFINITY;
#pragma unroll
        for (int jj = 0; jj < 16; ++jj) {
            s[jj] = -INFINITY;
            if (jj < nch) { const int pos = base[jj] + lane;
                if (pos >= 0 && pos <= t) { const bf16_t* kr = proj + ((size_t)b * SEQ + pos) * PLD + kcol; float a = 0.f; for (int d = 0; d < 128; ++d) a += q[d] * bf2f(kr[d]); s[jj] = a * ATT_SCALE; } }
            m = fmaxf(m, s[jj]);
        }
        m = wave_max(m);
        float sum = 0.f;
#pragma unroll
        for (int jj = 0; jj < 16; ++jj) { s[jj] = (s[jj] > -INFINITY) ? __expf(s[jj] - m) : 0.f; sum += s[jj]; }
        sum = wave_sum(sum);
        const float inv = 1.f / fmaxf(sum, 1e-30f);
#pragma unroll
        for (int jj = 0; jj < 16; ++jj) pp[jj * 64 + lane] = s[jj] * inv;
        __builtin_amdgcn_wave_barrier();
        float o0 = 0.f, o1 = 0.f;
#pragma unroll
        for (int jj = 0; jj < 16; ++jj) {
            if (jj < nch) {
                for (int l = 0; l < 64; ++l) {
                    const float pv = pp[jj * 64 + l];
                    int pos = base[jj] + l; pos = pos < 0 ? 0 : (pos > SEQ - 1 ? SEQ - 1 : pos);
                    const bf16_t* vr = proj + ((size_t)b * SEQ + pos) * PLD + vcol;
                    o0 += pv * bf2f(vr[lane]); o1 += pv * bf2f(vr[64 + lane]);
                }
            }
        }
        float* oo = WSP(float, WIN ? WS_OWIN : WS_OSEL) + row * DM + hq * 128;
        oo[lane] = o0; oo[lane + 64] = o1;
        __builtin_amdgcn_wave_barrier();
    }
}
__global__ void __launch_bounds__(256) k_ynsa(P p) {
    const size_t idx = (size_t)blockIdx.x * 256 + threadIdx.x; const size_t row = idx >> 10; const int col = (int)(idx & 1023), hq = col >> 7;
    const bf16_t* pr = WSP(bf16_t, WS_PROJ) + row * PLD + C_NG + hq * 3;
    const float g0 = sigmoidf_(bf2f(pr[0])), g1 = sigmoidf_(bf2f(pr[1])), g2 = sigmoidf_(bf2f(pr[2]));
    WSP(bf16_t, WS_YNSA)[idx] = f2bf(g0 * WSP(float, WS_OCMP)[idx] + g1 * WSP(float, WS_OSEL)[idx] + g2 * WSP(float, WS_OWIN)[idx]);
}

__global__ void __launch_bounds__(256) k_route(P p) {
    __shared__ float su[4][1024];
    const int wid = threadIdx.x >> 6, lane = threadIdx.x & 63, row = blockIdx.x * 4 + wid, b = row / SEQ;
    const float* hr = WSP(float, WS_H1) + (size_t)row * DM; const float* mod = WSP(float, WS_MOD) + b * 6144;
    float v[16]; float ss = 0.f;
#pragma unroll
    for (int i = 0; i < 16; ++i) { v[i] = hr[lane + 64 * i]; ss += v[i] * v[i]; }
    const float rstd = rsqrtf(wave_sum(ss) * (1.f / DM) + RMS_EPS);
    bf16_t* u = WSP(bf16_t, WS_U2) + (size_t)row * DM; float* uu = su[wid];
#pragma unroll
    for (int i = 0; i < 16; ++i) { const int col = lane + 64 * i; const float val = v[i] * rstd * p.norm2_g[col] * (1.f + mod[4096 + col]) + mod[3072 + col]; uu[col] = val; u[col] = f2bf(val); }
    __builtin_amdgcn_wave_barrier();
    const int e = lane & 31, kh = lane >> 5;
    float acc = 0.f;
    for (int k = kh * 512; k < kh * 512 + 512; ++k) acc += uu[k] * p.router_w[k * 32 + e];
    acc += __shfl_xor(acc, 32);
    float logit = acc + p.router_b[e];
    int rank = 0;
    for (int j = 0; j < 32; ++j) { const float lj = __shfl(logit, j); rank += (lj > logit) || (lj == logit && j < e); }
    const float mx = wave_max(logit);
    const bool sel = rank < 4;
    const float ex = sel ? __expf(logit - mx) : 0.f;
    float sum = ex; for (int o = 1; o < 32; o <<= 1) sum += __shfl_xor(sum, o);
    if (sel && lane < 32) {
        WSP(int, WS_TOPE)[row * 4 + rank] = e; WSP(float, WS_TOPW)[row * 4 + rank] = ex / sum;
        atomicAdd(WSP(int, WS_CTL) + CT_CNT + e, 1);
    }
}
__global__ void k_offsets(P p) {
    if (threadIdx.x != 0) return;
    int* ctl = WSP(int, WS_CTL); int ps = 0;
    for (int e = 0; e < NEXP; ++e) { ctl[CT_PSTART + e] = ps; const int nb = (ctl[CT_CNT + e] + MOEB - 1) / MOEB; for (int i = 0; i < nb; ++i) ctl[CT_BLKE + ps / MOEB + i] = e; ps += nb * MOEB; }
    ctl[CT_PSTART + NEXP] = ps; ctl[CT_PTOT] = ps;
}
__global__ void __launch_bounds__(256) k_assign(P p) {
    const int idx = blockIdx.x * 256 + threadIdx.x;
    int* ctl = WSP(int, WS_CTL);
    const int e = WSP(int, WS_TOPE)[idx];
    const int pos = ctl[CT_PSTART + e] + atomicAdd(ctl + CT_FILL + e, 1);
    WSP(int, WS_ROWTOK)[pos] = idx >> 2; WSP(int, WS_SLOTOF)[idx] = pos;
}
__global__ void __launch_bounds__(256) k_final(P p) {
    const int row = blockIdx.x * 4 + (threadIdx.x >> 6), lane = threadIdx.x & 63, b = row / SEQ;
    const float* hr = WSP(float, WS_H1) + (size_t)row * DM; const float* mod = WSP(float, WS_MOD) + b * 6144;
    const int* so = WSP(int, WS_SLOTOF) + row * 4; const float* tw = WSP(float, WS_TOPW) + row * 4;
    const bf16_t* ys = WSP(bf16_t, WS_YSLOT);
    float v[16]; float ss = 0.f;
#pragma unroll
    for (int i = 0; i < 16; ++i) {
        const int col = lane + 64 * i; float m = 0.f;
        for (int k = 0; k < 4; ++k) m += tw[k] * bf2f(ys[(size_t)so[k] * DM + col]);
        v[i] = hr[col] + mod[5120 + col] * m; ss += v[i] * v[i];
    }
    const float rstd = rsqrtf(wave_sum(ss) * (1.f / DM) + RMS_EPS);
#pragma unroll
    for (int i = 0; i < 16; ++i) { const int col = lane + 64 * i; p.out[(size_t)row * DM + col] = v[i] * rstd * p.final_g[col]; }
}

extern "C" void kernel_launch(void* const* d_in, const int* in_sizes, int n_in, void* d_out, int out_size, void* d_ws, size_t ws_size, hipStream_t stream) {
    P p{};
    const float** pp = (const float**)&p;
    for (int i = 0; i < 23; ++i) pp[i] = (const float*)d_in[i];
    p.out = (float*)d_out; p.ws = (unsigned char*)d_ws;
    hipMemsetAsync((char*)d_ws + WS_CTL, 0, 4096, stream);
    hipMemsetAsync((char*)d_ws + WS_ROWTOK, 0xFF, (size_t)PROWS * 4, stream);
    k_mod<<<24, 256, 0, stream>>>(p);
    k_u1<<<NTOK / 4, 256, 0, stream>>>(p);
    sgemm_k<F_inproj, false><<<dim3(PLD / 64, NTOK / 64), 256, 0, stream>>>(F_inproj{1024}, p);
    k_loga<<<NTOK * 2, 256, 0, stream>>>(p);
    k_gla<<<256, 256, 0, stream>>>(p);
    k_ygla<<<NTOK, 256, 0, stream>>>(p);
    for (int which = 0; which < 2; ++which) {
        sgemm_k<F_cmp1, false><<<dim3(4, 32), 256, 0, stream>>>(F_cmp1{4096, which}, p);
        sgemm_k<F_cmp2, false><<<dim3(2, 32), 256, 0, stream>>>(F_cmp2{256, which}, p);
    }
    k_cmpattn<<<BATCH * 2 * SEQ / 4, 256, 0, stream>>>(p);
    k_sparseattn<false><<<BATCH * 2 * SEQ / 4, 256, 0, stream>>>(p);
    k_sparseattn<true><<<BATCH * 2 * SEQ / 4, 256, 0, stream>>>(p);
    k_ynsa<<<NTOK * 4, 256, 0, stream>>>(p);
    sgemm_k<F_merge1, false><<<dim3(16, NTOK / 64), 256, 0, stream>>>(F_merge1{1024}, p);
    sgemm_k<F_merge2, false><<<dim3(16, NTOK / 64), 256, 0, stream>>>(F_merge2{1024}, p);
    sgemm_k<F_out, false><<<dim3(16, NTOK / 64), 256, 0, stream>>>(F_out{1024}, p);
    k_route<<<NTOK / 4, 256, 0, stream>>>(p);
    k_offsets<<<1, 64, 0, stream>>>(p);
    k_assign<<<NTOK * 4 / 256, 256, 0, stream>>>(p);
    sgemm_k<F_moe1, true><<<dim3(16, PROWS / 64), 256, 0, stream>>>(F_moe1{1024, 0}, p);
    sgemm_k<F_moe2, false><<<dim3(16, PROWS / 64), 256, 0, stream>>>(F_moe2{1024, 0}, p);
    k_final<<<NTOK / 4, 256, 0, stream>>>(p);
}
```

```cpp
#include <hip/hip_runtime.h>
#include <stdint.h>
#include <math.h>

typedef unsigned short bf16_t;
typedef unsigned long long u64;

constexpr int BATCH = 4, SEQ = 4096, DM = 1024, NTOK = BATCH * SEQ;
constexpr int IN_COLS = 7720, PLD = 7936;
constexpr int C_GQ = 0, C_GK = 512, C_GV = 1024, C_GR = 2048, C_NQ = 3072, C_KC = 4096, C_VC = 4352, C_KS = 4608, C_VS = 4864,
              C_KW = 5120, C_VW = 5376, C_MG = 5632, C_GA = 7680, C_NG = 7696;
constexpr int NCMP = 255, NSEL = 64, NEXP = 32, TOPK = 4, MOEB = 256;
constexpr int PROWS = NTOK * TOPK + NEXP * MOEB;
constexpr float RMS_EPS = 1e-5f;

__host__ __device__ inline int orig_col(int j) {
    if (j < 3072) return j;
    if (j < 5632) return j + 16;
    if (j < 7680) return j + 40;
    if (j < 7696) return j - 4608;
    return j - 2048;
}

constexpr size_t MiB = 1u << 20;
constexpr size_t WS_CTL = 0;
constexpr size_t WS_MOD = 1 * MiB;
constexpr size_t WS_W1T = 2 * MiB;
constexpr size_t WS_W2T = 130 * MiB;
constexpr size_t WS_WINT = 194 * MiB;
constexpr size_t WS_PGLAT = 210 * MiB, WS_PNSAT = 212 * MiB, WS_WOUTT = 214 * MiB;
constexpr size_t WS_CW1T = 216 * MiB;
constexpr size_t WS_CW2T = 220 * MiB;
constexpr size_t WS_H1 = 221 * MiB;
constexpr size_t WS_U2 = 285 * MiB;
constexpr size_t WS_TOPE = 317 * MiB;
constexpr size_t WS_TOPW = 317 * MiB + 512 * 1024;
constexpr size_t WS_ROWTOK = 318 * MiB;
constexpr size_t WS_SLOTOF = 318 * MiB + 512 * 1024;
constexpr size_t WS_U1 = 320 * MiB;
constexpr size_t WS_PROJ = 352 * MiB;
constexpr size_t WS_LOGA = 600 * MiB;
constexpr size_t WS_OGLA = 632 * MiB;
constexpr size_t WS_YGLA = 696 * MiB;
constexpr size_t WS_HID = 728 * MiB;
constexpr size_t WS_KCVC = 732 * MiB;
constexpr size_t WS_SELM = 734 * MiB;
constexpr size_t WS_OCMP = 735 * MiB;
constexpr size_t WS_OSEL = 799 * MiB;
constexpr size_t WS_OWIN = 863 * MiB;
constexpr size_t WS_YNSA = 927 * MiB;
constexpr size_t WS_MERG = 959 * MiB;
constexpr size_t WS_T1 = 991 * MiB;
constexpr size_t WS_TMPF = 600 * MiB;
constexpr size_t WS_XS = 320 * MiB;
constexpr size_t WS_ACT = 464 * MiB;
constexpr size_t WS_YSLOT = 608 * MiB;
constexpr int CT_CNT = 0, CT_FILL = 64, CT_PSTART = 128, CT_PTOT = 192, CT_BLKE = 256;

__device__ __forceinline__ float bf2f(bf16_t v) { return __uint_as_float(((unsigned)v) << 16); }
__device__ __forceinline__ bf16_t f2bf(float f) { unsigned u = __float_as_uint(f); return (bf16_t)((u + 0x7fffu + ((u >> 16) & 1u)) >> 16); }
__device__ __forceinline__ float sigmoidf_(float x) { return 1.f / (1.f + __expf(-x)); }
__device__ __forceinline__ float siluf_(float x) { return x / (1.f + __expf(-x)); }
__device__ __forceinline__ float wave_sum(float v) {
#pragma unroll
    for (int o = 1; o < 64; o <<= 1) v += __shfl_xor(v, o);
    return v;
}
__device__ __forceinline__ float wave_max(float v) {
#pragma unroll
    for (int o = 1; o < 64; o <<= 1) v = fmaxf(v, __shfl_xor(v, o));
    return v;
}

struct P {
    const float *x, *c, *w_ada, *b_ada, *norm1_g, *w_in, *gla_wa2, *gla_ba, *gla_norm_g, *cmp_pe, *cmp_w1, *cmp_w2, *proj_gla, *proj_nsa,
        *w_out, *norm2_g, *router_w, *router_b, *moe_w1, *moe_b1, *moe_w2, *moe_b2, *final_g;
    float* out;
    unsigned char* ws;
};
#define WSP(T, off) ((T*)(p.ws + (off)))

__global__ void __launch_bounds__(256) k_mod(P p) {
    __shared__ float sc[4 * 1024];
    for (int i = threadIdx.x; i < 4096; i += 256) sc[i] = siluf_(p.c[i]);
    __syncthreads();
    const int j = blockIdx.x * 256 + threadIdx.x;
    float a0 = 0, a1 = 0, a2 = 0, a3 = 0;
    for (int k = 0; k < 1024; ++k) { const float w = p.w_ada[(size_t)k * 6144 + j]; a0 += sc[k] * w; a1 += sc[1024 + k] * w; a2 += sc[2048 + k] * w; a3 += sc[3072 + k] * w; }
    float* mod = WSP(float, WS_MOD); const float bb = p.b_ada[j];
    mod[j] = a0 + bb; mod[6144 + j] = a1 + bb; mod[2 * 6144 + j] = a2 + bb; mod[3 * 6144 + j] = a3 + bb;
}

__global__ void __launch_bounds__(256) k_u1(P p) {
    const int row = blockIdx.x * 4 + (threadIdx.x >> 6), lane = threadIdx.x & 63, b = row / SEQ;
    const float* xr = p.x + (size_t)row * DM; const float* mod = WSP(float, WS_MOD) + b * 6144;
    float v[16]; float ss = 0.f;
#pragma unroll
    for (int i = 0; i < 16; ++i) { v[i] = xr[lane + 64 * i]; ss += v[i] * v[i]; }
    const float rstd = rsqrtf(wave_sum(ss) * (1.f / DM) + RMS_EPS);
    bf16_t* u = WSP(bf16_t, WS_U1) + (size_t)row * DM;
#pragma unroll
    for (int i = 0; i < 16; ++i) { const int col = lane + 64 * i; u[col] = f2bf(v[i] * rstd * p.norm1_g[col] * (1.f + mod[1024 + col]) + mod[col]); }
}

template <class F, bool DUAL>
__global__ void __launch_bounds__(256) sgemm_k(F f, P p) {
    __shared__ float As[16][68]; __shared__ float Bs[16][68]; __shared__ float Bs2[16][68];
    const int tid = threadIdx.x, tx = tid & 15, ty = tid >> 4;
    const int m0 = blockIdx.y * 64, n0 = blockIdx.x * 64;
    if (!f.init(p, m0)) return;
    float acc[4][4], acc2[4][4];
#pragma unroll
    for (int i = 0; i < 4; ++i)
#pragma unroll
        for (int j = 0; j < 4; ++j) { acc[i][j] = 0.f; acc2[i][j] = 0.f; }
    const int K = f.K;
    for (int k0 = 0; k0 < K; k0 += 16) {
        { const int r = tid >> 2, kq = (tid & 3) * 4;
#pragma unroll
          for (int i = 0; i < 4; ++i) As[kq + i][r] = f.a(p, m0 + r, k0 + kq + i); }
        { const int kk = tid >> 4, cc = (tid & 15) * 4;
#pragma unroll
          for (int i = 0; i < 4; ++i) { Bs[kk][cc + i] = f.b(p, k0 + kk, n0 + cc + i); if (DUAL) Bs2[kk][cc + i] = f.b2(p, k0 + kk, n0 + cc + i); } }
        __syncthreads();
#pragma unroll
        for (int kk = 0; kk < 16; ++kk) {
            float a[4], b[4], b2[4];
#pragma unroll
            for (int i = 0; i < 4; ++i) { a[i] = As[kk][ty * 4 + i]; b[i] = Bs[kk][tx * 4 + i]; b2[i] = DUAL ? Bs2[kk][tx * 4 + i] : 0.f; }
#pragma unroll
            for (int i = 0; i < 4; ++i)
#pragma unroll
                for (int j = 0; j < 4; ++j) { acc[i][j] += a[i] * b[j]; if (DUAL) acc2[i][j] += a[i] * b2[j]; }
        }
        __syncthreads();
    }
#pragma unroll
    for (int i = 0; i < 4; ++i)
#pragma unroll
        for (int j = 0; j < 4; ++j) f.store(p, m0 + ty * 4 + i, n0 + tx * 4 + j, acc[i][j], acc2[i][j]);
}

struct F_inproj {
    int K;
    __device__ bool init(const P&, int) { return true; }
    __device__ float a(const P& p, int r, int k) const { return bf2f(WSP(bf16_t, WS_U1)[(size_t)r * DM + k]); }
    __device__ float b(const P& p, int k, int c) const { return c < IN_COLS ? p.w_in[(size_t)k * IN_COLS + orig_col(c)] : 0.f; }
    __device__ float b2(const P&, int, int) const { return 0.f; }
    __device__ void store(const P& p, int r, int c, float v, float) const { WSP(bf16_t, WS_PROJ)[(size_t)r * PLD + c] = f2bf(v); }
};
__device__ __forceinline__ float gelu_tanh(float x) { const float u = 0.7978845608028654f * (x + 0.044715f * x * x * x); return 0.5f * x * (1.f + tanhf(u)); }
struct F_cmp1 {
    int K, which;
    __device__ bool init(const P&, int) { return true; }
    __device__ float a(const P& p, int r, int k) const {
        if (r >= 2040) return 0.f;
        const int b = r / 510, g = (r / 255) & 1, c = r % 255, l = k >> 7, d = k & 127;
        const size_t tok = (size_t)b * SEQ + 16 * c + l;
        return bf2f(WSP(bf16_t, WS_PROJ)[tok * PLD + (which ? C_VC : C_KC) + g * 128 + d]) + p.cmp_pe[(which * 32 + l) * 128 + d];
    }
    __device__ float b(const P& p, int k, int c) const { return p.cmp_w1[((size_t)which * 4096 + k) * 256 + c]; }
    __device__ float b2(const P&, int, int) const { return 0.f; }
    __device__ void store(const P& p, int r, int c, float v, float) const { if (r < 2040) WSP(float, WS_HID)[((size_t)which * 2040 + r) * 256 + c] = gelu_tanh(v); }
};
struct F_cmp2 {
    int K, which;
    __device__ bool init(const P&, int) { return true; }
    __device__ float a(const P& p, int r, int k) const { return r < 2040 ? WSP(float, WS_HID)[((size_t)which * 2040 + r) * 256 + k] : 0.f; }
    __device__ float b(const P& p, int k, int c) const { return p.cmp_w2[((size_t)which * 256 + k) * 128 + c]; }
    __device__ float b2(const P&, int, int) const { return 0.f; }
    __device__ void store(const P& p, int r, int c, float v, float) const {
        if (r >= 2040) return;
        const int b = r / 510, g = (r / 255) & 1, cc = r % 255;
        WSP(bf16_t, WS_KCVC)[((((size_t)which * 4 + b) * 2 + g) * 256 + cc) * 128 + c] = f2bf(v);
    }
};
struct F_merge1 {
    int K;
    __device__ bool init(const P&, int) { return true; }
    __device__ float a(const P& p, int r, int k) const { return bf2f(WSP(bf16_t, WS_YGLA)[(size_t)r * DM + k]); }
    __device__ float b(const P& p, int k, int c) const { return p.proj_gla[(size_t)k * DM + c]; }
    __device__ float b2(const P&, int, int) const { return 0.f; }
    __device__ void store(const P& p, int r, int c, float v, float) const {
        const float mg = sigmoidf_(bf2f(WSP(bf16_t, WS_PROJ)[(size_t)r * PLD + C_MG + c]));
        WSP(float, WS_TMPF)[(size_t)r * DM + c] = mg * v;
    }
};
struct F_merge2 {
    int K;
    __device__ bool init(const P&, int) { return true; }
    __device__ float a(const P& p, int r, int k) const { return bf2f(WSP(bf16_t, WS_YNSA)[(size_t)r * DM + k]); }
    __device__ float b(const P& p, int k, int c) const { return p.proj_nsa[(size_t)k * DM + c]; }
    __device__ float b2(const P&, int, int) const { return 0.f; }
    __device__ void store(const P& p, int r, int c, float v, float) const {
        const float mg = sigmoidf_(bf2f(WSP(bf16_t, WS_PROJ)[(size_t)r * PLD + C_MG + 1024 + c]));
        WSP(bf16_t, WS_MERG)[(size_t)r * DM + c] = f2bf(WSP(float, WS_TMPF)[(size_t)r * DM + c] + mg * v);
    }
};
struct F_out {
    int K;
    __device__ bool init(const P&, int) { return true; }
    __device__ float a(const P& p, int r, int k) const { return bf2f(WSP(bf16_t, WS_MERG)[(size_t)r * DM + k]); }
    __device__ float b(const P& p, int k, int c) const { return p.w_out[(size_t)k * DM + c]; }
    __device__ float b2(const P&, int, int) const { return 0.f; }
    __device__ void store(const P& p, int r, int c, float v, float) const {
        const int b = r / SEQ; const float gate1 = WSP(float, WS_MOD)[b * 6144 + 2048 + c];
        WSP(float, WS_H1)[(size_t)r * DM + c] = p.x[(size_t)r * DM + c] + gate1 * v;
    }
};
struct F_moe1 {
    int K; int e;
    __device__ bool init(const P& p, int m0) { const int* ctl = WSP(int, WS_CTL); if (m0 >= ctl[CT_PTOT]) return false; e = ctl[CT_BLKE + m0 / MOEB]; return true; }
    __device__ float a(const P& p, int r, int k) const { const int tok = WSP(int, WS_ROWTOK)[r]; return tok < 0 ? 0.f : bf2f(WSP(bf16_t, WS_U2)[(size_t)tok * DM + k]); }
    __device__ float b(const P& p, int k, int c) const { return p.moe_w1[((size_t)e * DM + k) * 2048 + c]; }
    __device__ float b2(const P& p, int k, int c) const { return p.moe_w1[((size_t)e * DM + k) * 2048 + 1024 + c]; }
    __device__ void store(const P& p, int r, int c, float g, float u) const {
        g += p.moe_b1[e * 2048 + c]; u += p.moe_b1[e * 2048 + 1024 + c];
        g = fminf(g, 7.f); u = fminf(fmaxf(u, -7.f), 7.f);
        WSP(bf16_t, WS_ACT)[(size_t)r * DM + c] = f2bf(g * sigmoidf_(1.702f * g) * (u + 1.f));
    }
};
struct F_moe2 {
    int K; int e;
    __device__ bool init(const P& p, int m0) { const int* ctl = WSP(int, WS_CTL); if (m0 >= ctl[CT_PTOT]) return false; e = ctl[CT_BLKE + m0 / MOEB]; return true; }
    __device__ float a(const P& p, int r, int k) const { return bf2f(WSP(bf16_t, WS_ACT)[(size_t)r * DM + k]); }
    __device__ float b(const P& p, int k, int c) const { return p.moe_w2[((size_t)e * DM + k) * DM + c]; }
    __device__ float b2(const P&, int, int) const { return 0.f; }
    __device__ void store(const P& p, int r, int c, float v, float) const { WSP(bf16_t, WS_YSLOT)[(size_t)r * DM + c] = f2bf(v + p.moe_b2[e * DM + c]); }
};

__global__ void __launch_bounds__(256) k_loga(P p) {
    const int row = blockIdx.x >> 1, j = (blockIdx.x & 1) * 256 + threadIdx.x;
    const bf16_t* pr = WSP(bf16_t, WS_PROJ) + (size_t)row * PLD + C_GA;
    float xx = p.gla_ba[j];
#pragma unroll
    for (int r = 0; r < 16; ++r) xx += bf2f(pr[r]) * p.gla_wa2[r * 512 + j];
    const float ls = fminf(xx, 0.f) - log1pf(__expf(-fabsf(xx)));
    WSP(float, WS_LOGA)[(size_t)row * 512 + j] = ls * (1.f / 16.f);
}
__global__ void __launch_bounds__(256) k_gla(P p) {
    const int blk = blockIdx.x, b = blk >> 6, h = (blk >> 4) & 3, vg = blk & 15;
    const int tid = threadIdx.x, vl = tid >> 4, kg = tid & 15;
    const int vcol = h * 256 + vg * 16 + vl;
    float S[8];
#pragma unroll
    for (int i = 0; i < 8; ++i) S[i] = 0.f;
    const bf16_t* proj = WSP(bf16_t, WS_PROJ); const float* loga = WSP(float, WS_LOGA); float* og = WSP(float, WS_OGLA);
    for (int t = 0; t < SEQ; ++t) {
        const size_t row = (size_t)b * SEQ + t;
        const bf16_t* pr = proj + row * PLD;
        const float vv = bf2f(pr[C_GV + vcol]);
        float part = 0.f;
#pragma unroll
        for (int i = 0; i < 8; ++i) {
            const int d = h * 128 + kg * 8 + i;
            const float a = __expf(loga[row * 512 + d]);
            S[i] = a * S[i] + bf2f(pr[C_GK + d]) * vv;
            part += bf2f(pr[C_GQ + d]) * S[i];
        }
        part += __shfl_xor(part, 1); part += __shfl_xor(part, 2); part += __shfl_xor(part, 4); part += __shfl_xor(part, 8);
        if (kg == 0) og[row * DM + vcol] = part * 0.08838834764831845f;
    }
}
__global__ void __launch_bounds__(256) k_ygla(P p) {
    const int w = blockIdx.x * 4 + (threadIdx.x >> 6), lane = threadIdx.x & 63, row = w >> 2, h = w & 3;
    const float* o = WSP(float, WS_OGLA) + (size_t)row * DM + h * 256;
    float v[4]; float ss = 0.f;
#pragma unroll
    for (int i = 0; i < 4; ++i) { v[i] = o[lane + 64 * i]; ss += v[i] * v[i]; }
    const float rstd = rsqrtf(wave_sum(ss) * (1.f / 256.f) + RMS_EPS);
    const bf16_t* pr = WSP(bf16_t, WS_PROJ) + (size_t)row * PLD + C_GR + h * 256;
    bf16_t* y = WSP(bf16_t, WS_YGLA) + (size_t)row * DM + h * 256;
#pragma unroll
    for (int i = 0; i < 4; ++i) { const int dv = lane + 64 * i; y[dv] = f2bf(v[i] * rstd * p.gla_norm_g[dv] * siluf_(bf2f(pr[dv]))); }
}

constexpr float ATT_SCALE = 0.08838834764831845f;
__global__ void __launch_bounds__(256) k_cmpattn(P p) {
    __shared__ float sq[4][128]; __shared__ float sp[4][256]; __shared__ float sps[4][256];
    const int wid = threadIdx.x >> 6, lane = threadIdx.x & 63;
    const int w = blockIdx.x * 4 + wid, b = w >> 13, g = (w >> 12) & 1, t = w & 4095;
    const size_t row = (size_t)b * SEQ + t;
    const bf16_t* pr = WSP(bf16_t, WS_PROJ) + row * PLD;
    const bf16_t* kc = WSP(bf16_t, WS_KCVC) + (((size_t)0 * 4 + b) * 2 + g) * 256 * 128;
    const bf16_t* vc = WSP(bf16_t, WS_KCVC) + (((size_t)1 * 4 + b) * 2 + g) * 256 * 128;
    const int ncv = t >= 31 ? (t - 31) / 16 + 1 : 0;
    float* q = sq[wid]; float* pp = sp[wid]; float* ps = sps[wid];
    for (int i = 0; i < 4; ++i) ps[lane + 64 * i] = 0.f;
    for (int r = 0; r < 4; ++r) {
        const int hq = g * 4 + r;
        q[lane] = bf2f(pr[C_NQ + hq * 128 + lane]); q[lane + 64] = bf2f(pr[C_NQ + hq * 128 + 64 + lane]);
        __builtin_amdgcn_wave_barrier();
        float s[4]; float m = -INFINITY;
        for (int i = 0; i < 4; ++i) {
            const int c = lane + 64 * i; s[i] = -INFINITY;
            if (c < ncv) { float a = 0.f; for (int d = 0; d < 128; ++d) a += q[d] * bf2f(kc[c * 128 + d]); s[i] = a * ATT_SCALE; }
            m = fmaxf(m, s[i]);
        }
        m = wave_max(m);
        float e[4]; float sum = 0.f;
        for (int i = 0; i < 4; ++i) { const int c = lane + 64 * i; e[i] = (c < ncv) ? __expf(s[i] - m) : 0.f; sum += e[i]; }
        sum = wave_sum(sum);
        const float inv = 1.f / fmaxf(sum, 1e-30f);
        for (int i = 0; i < 4; ++i) { const int c = lane + 64 * i; const float pv = e[i] * inv; pp[c] = pv; ps[c] += pv; }
        __builtin_amdgcn_wave_barrier();
        float o0 = 0.f, o1 = 0.f;
        for (int c = 0; c < ncv; ++c) { const float pv = pp[c]; o0 += pv * bf2f(vc[c * 128 + lane]); o1 += pv * bf2f(vc[c * 128 + 64 + lane]); }
        float* oc = WSP(float, WS_OCMP) + row * DM + hq * 128;
        oc[lane] = o0; oc[lane + 64] = o1;
        __builtin_amdgcn_wave_barrier();
    }
    const int s = lane, tb = t >> 6;
    float imp = 0.f;
    for (int c = 4 * s - 1; c <= 4 * s + 3; ++c) if (c >= 0 && c < NCMP) imp += ps[c];
    const bool forced = (s == 0) || (s == tb) || (s == tb - 1), valid = s <= tb;
    const float score = forced ? INFINITY : (valid ? imp : -INFINITY);
    int rank = 0;
    for (int j = 0; j < 64; ++j) { const float sj = __shfl(score, j); rank += (sj > score) || (sj == score && j < s); }
    const bool sel = rank < 16 && score > -INFINITY;
    const u64 mask = __ballot(sel);
    if (lane == 0) WSP(u64, WS_SELM)[(b * 2 + g) * SEQ + t] = mask;
}
template <bool WIN>
__global__ void __launch_bounds__(256) k_sparseattn(P p) {
    __shared__ float sq[4][128]; __shared__ float sp[4][1024];
    const int wid = threadIdx.x >> 6, lane = threadIdx.x & 63;
    const int w = blockIdx.x * 4 + wid, b = w >> 13, g = (w >> 12) & 1, t = w & 4095;
    const size_t row = (size_t)b * SEQ + t;
    const bf16_t* proj = WSP(bf16_t, WS_PROJ);
    const bf16_t* pr = proj + row * PLD;
    const int kcol = (WIN ? C_KW : C_KS) + g * 128, vcol = (WIN ? C_VW : C_VS) + g * 128;
    const u64 mask = WIN ? 0ull : WSP(u64, WS_SELM)[(b * 2 + g) * SEQ + t];
    const int nch = WIN ? 8 : __popcll(mask);
    int base[16];
    { u64 mm = mask;
#pragma unroll
      for (int jj = 0; jj < 16; ++jj) { if (WIN) base[jj] = t - 511 + jj * 64; else { const int bi = mm ? __ffsll((long long)mm) - 1 : 0; base[jj] = bi * 64; mm &= mm - 1; } } }
    float* q = sq[wid]; float* pp = sp[wid];
    for (int r = 0; r < 4; ++r) {
        const int hq = g * 4 + r;
        q[lane] = bf2f(pr[C_NQ + hq * 128 + lane]); q[lane + 64] = bf2f(pr[C_NQ + hq * 128 + 64 + lane]);
        __builtin_amdgcn_wave_barrier();
        float s[16]; float m = -INFINITY;
#pragma unroll
        for (int jj = 0; jj < 16; ++jj) {
            s[jj] = -INFINITY;
            if (jj < nch) { const int pos = base[jj] + lane;
                if (pos >= 0 && pos <= t) { const bf16_t* kr = proj + ((size_t)b * SEQ + pos) * PLD + kcol; float a = 0.f; for (int d = 0; d < 128; ++d) a += q[d] * bf2f(kr[d]); s[jj] = a * ATT_SCALE; } }
            m = fmaxf(m, s[jj]);
        }
        m = wave_max(m);
        float sum = 0.f;
#pragma unroll
        for (int jj = 0; jj < 16; ++jj) { s[jj] = (s[jj] > -INFINITY) ? __expf(s[jj] - m) : 0.f; sum += s[jj]; }
        sum = wave_sum(sum);
        const float inv = 1.f / fmaxf(sum, 1e-30f);
#pragma unroll
        for (int jj = 0; jj < 16; ++jj) pp[jj * 64 + lane] = s[jj] * inv;
        __builtin_amdgcn_wave_barrier();
        float o0 = 0.f, o1 = 0.f;
#pragma unroll
        for (int jj = 0; jj < 16; ++jj) {
            if (jj < nch) {
                for (int l = 0; l < 64; ++l) {
                    const float pv = pp[jj * 64 + l];
                    int pos = base[jj] + l; pos = pos < 0 ? 0 : (pos > SEQ - 1 ? SEQ - 1 : pos);
                    const bf16_t* vr = proj + ((size_t)b * SEQ + pos) * PLD + vcol;
                    o0 += pv * bf2f(vr[lane]); o1 += pv * bf2f(vr[64 + lane]);
                }
            }
        }
        float* oo = WSP(float, WIN ? WS_OWIN : WS_OSEL) + row * DM + hq * 128;
        oo[lane] = o0; oo[lane + 64] = o1;
        __builtin_amdgcn_wave_barrier();
    }
}
__global__ void __launch_bounds__(256) k_ynsa(P p) {
    const size_t idx = (size_t)blockIdx.x * 256 + threadIdx.x; const size_t row = idx >> 10; const int col = (int)(idx & 1023), hq = col >> 7;
    const bf16_t* pr = WSP(bf16_t, WS_PROJ) + row * PLD + C_NG + hq * 3;
    const float g0 = sigmoidf_(bf2f(pr[0])), g1 = sigmoidf_(bf2f(pr[1])), g2 = sigmoidf_(bf2f(pr[2]));
    WSP(bf16_t, WS_YNSA)[idx] = f2bf(g0 * WSP(float, WS_OCMP)[idx] + g1 * WSP(float, WS_OSEL)[idx] + g2 * WSP(float, WS_OWIN)[idx]);
}

__global__ void __launch_bounds__(256) k_route(P p) {
    __shared__ float su[4][1024];
    const int wid = threadIdx.x >> 6, lane = threadIdx.x & 63, row = blockIdx.x * 4 + wid, b = row / SEQ;
    const float* hr = WSP(float, WS_H1) + (size_t)row * DM; const float* mod = WSP(float, WS_MOD) + b * 6144;
    float v[16]; float ss = 0.f;
#pragma unroll
    for (int i = 0; i < 16; ++i) { v[i] = hr[lane + 64 * i]; ss += v[i] * v[i]; }
    const float rstd = rsqrtf(wave_sum(ss) * (1.f / DM) + RMS_EPS);
    bf16_t* u = WSP(bf16_t, WS_U2) + (size_t)row * DM; float* uu = su[wid];
#pragma unroll
    for (int i = 0; i < 16; ++i) { const int col = lane + 64 * i; const float val = v[i] * rstd * p.norm2_g[col] * (1.f + mod[4096 + col]) + mod[3072 + col]; uu[col] = val; u[col] = f2bf(val); }
    __builtin_amdgcn_wave_barrier();
    const int e = lane & 31, kh = lane >> 5;
    float acc = 0.f;
    for (int k = kh * 512; k < kh * 512 + 512; ++k) acc += uu[k] * p.router_w[k * 32 + e];
    acc += __shfl_xor(acc, 32);
    float logit = acc + p.router_b[e];
    int rank = 0;
    for (int j = 0; j < 32; ++j) { const float lj = __shfl(logit, j); rank += (lj > logit) || (lj == logit && j < e); }
    const float mx = wave_max(logit);
    const bool sel = rank < 4;
    const float ex = sel ? __expf(logit - mx) : 0.f;
    float sum = ex; for (int o = 1; o < 32; o <<= 1) sum += __shfl_xor(sum, o);
    if (sel && lane < 32) {
        WSP(int, WS_TOPE)[row * 4 + rank] = e; WSP(float, WS_TOPW)[row * 4 + rank] = ex / sum;
        atomicAdd(WSP(int, WS_CTL) + CT_CNT + e, 1);
    }
}
__global__ void k_offsets(P p) {
    if (threadIdx.x != 0) return;
    int* ctl = WSP(int, WS_CTL); int ps = 0;
    for (int e = 0; e < NEXP; ++e) { ctl[CT_PSTART + e] = ps; const int nb = (ctl[CT_CNT + e] + MOEB - 1) / MOEB; for (int i = 0; i < nb; ++i) ctl[CT_BLKE + ps / MOEB + i] = e; ps += nb * MOEB; }
    ctl[CT_PSTART + NEXP] = ps; ctl[CT_PTOT] = ps;
}
__global__ void __launch_bounds__(256) k_assign(P p) {
    const int idx = blockIdx.x * 256 + threadIdx.x;
    int* ctl = WSP(int, WS_CTL);
    const int e = WSP(int, WS_TOPE)[idx];
    const int pos = ctl[CT_PSTART + e] + atomicAdd(ctl + CT_FILL + e, 1);
    WSP(int, WS_ROWTOK)[pos] = idx >> 2; WSP(int, WS_SLOTOF)[idx] = pos;
}
__global__ void __launch_bounds__(256) k_final(P p) {
    const int row = blockIdx.x * 4 + (threadIdx.x >> 6), lane = threadIdx.x & 63, b = row / SEQ;
    const float* hr = WSP(float, WS_H1) + (size_t)row * DM; const float* mod = WSP(float, WS_MOD) + b * 6144;
    const int* so = WSP(int, WS_SLOTOF) + row * 4; const float* tw = WSP(float, WS_TOPW) + row * 4;
    const bf16_t* ys = WSP(bf16_t, WS_YSLOT);
    float v[16]; float ss = 0.f;
#pragma unroll
    for (int i = 0; i < 16; ++i) {
        const int col = lane + 64 * i; float m = 0.f;
        for (int k = 0; k < 4; ++k) m += tw[k] * bf2f(ys[(size_t)so[k] * DM + col]);
        v[i] = hr[col] + mod[5120 + col] * m; ss += v[i] * v[i];
    }
    const float rstd = rsqrtf(wave_sum(ss) * (1.f / DM) + RMS_EPS);
#pragma unroll
    for (int i = 0; i < 16; ++i) { const int col = lane + 64 * i; p.out[(size_t)row * DM + col] = v[i] * rstd * p.final_g[col]; }
}

namespace pg8 {
#define PG8_LAS __attribute__((address_space(3)))
typedef unsigned short bf16_t;
typedef short bf16x8 __attribute__((ext_vector_type(8)));
typedef float f32x4 __attribute__((ext_vector_type(4)));
typedef unsigned u32x4 __attribute__((ext_vector_type(4)));
constexpr int BM = 256, BK = 64, HALF = 128, HTB = HALF * BK * 2  , STAGE_BYTES = 8 * HTB, NXCD = 8, WGM = 8;

__host__ __device__ __forceinline__ int lds_byte(int r, int c) { const int st = (r >> 4) * 2 + (c >> 5), rr = r & 15, cc = c & 31, ob = rr * 64 + cc * 2; return st * 1024 + (ob ^ (((ob >> 9) & 1) << 5)); }
__host__ __device__ __forceinline__ void stage_rc(int b, int& R, int& C) { const int st = b / 1024, sb = b % 1024, swz = sb ^ (((sb >> 9) & 1) << 5); R = (st >> 1) * 16 + swz / 64; C = (st & 1) * 32 + (swz % 64) / 2; }
__host__ __device__ __forceinline__ int perm32(int rho) { const int n = rho >> 4, i = rho & 15; return 8 * (i >> 2) + 4 * n + (i & 3); }

struct Unit { int pm, pn, e; };
struct Gemm { const bf16_t* A; const bf16_t* Bt; int M, N, K; };

struct StaticOrder {
    int nM, nN, nwg, G, c;
    __host__ __device__ void init(int M, int N, int G_, int c_) { nM = M / BM; nN = N / BM; nwg = nM * nN; G = G_; c = c_; }
    __host__ __device__ bool next(int i, Unit& u) const {
        const long L = (long)i * G + c; if (L >= nwg) return false;
        int wgid = (int)L; { const int q = nwg / NXCD, r = nwg % NXCD, xcd = wgid % NXCD, off = wgid / NXCD; wgid = (xcd < r ? xcd * (q + 1) : r * (q + 1) + (xcd - r) * q) + off; }
        const int nig = WGM * nN, gid = wgid / nig, fm = gid * WGM, gsz = (nM - fm) < WGM ? (nM - fm) : WGM;
        u.pm = fm + ((wgid % nig) % gsz); u.pn = (wgid % nig) / gsz; u.e = 0; return true;
    }
    __device__ __forceinline__ void a_ready(const Unit&) const {}
    __device__ __forceinline__ void done(const Unit&) const {}
    __device__ __forceinline__ const char* abase(const Gemm& g, const Unit& u, size_t tstep) const { return (const char*)g.A + (size_t)u.pm * tstep; }
    __device__ __forceinline__ const char* bbase(const Gemm& g, const Unit& u, size_t tstep) const { return (const char*)g.Bt + (size_t)u.pn * tstep; }
};

template <class Epi, class Sched, bool ALIGN_EPI = false, bool SP2 = false>
__device__ __forceinline__ void gemm_phase(PG8_LAS unsigned char* lds, const Gemm g, const Sched& S, const Epi& E) {
    const int tid = threadIdx.x, wid = __builtin_amdgcn_readfirstlane(tid >> 6), lane = tid & 63, wr = wid >> 2, wc = wid & 3, fr = lane & 15, fq = lane >> 4;
    const int K = g.K, nt = K / BK;
    unsigned voffA[2], voffB[2];
#pragma unroll
    for (int i = 0; i < 2; ++i) { int R, C; stage_rc(tid * 16 + i * 8192, R, C); const int Rb = Epi::PERM ? ((R & ~31) + perm32(R & 31)) : R;
        voffA[i] = (unsigned)(R * K + C) * 2u; voffB[i] = (unsigned)(Rb * K + C) * 2u; }
    const size_t kstep = (size_t)(BK * 2);
    const size_t hstep = (size_t)HALF * K * 2;
    const size_t tstep = 2 * hstep;
    const unsigned ldsw = (unsigned)wid * 1024u;
    const int aoff = lds_byte(wr * 64 + fr, fq * 8), boff = lds_byte(wc * 32 + fr, fq * 8);
#define PG8_SA(b, h) (((b) * 2 + (h)) * HTB)
#define PG8_SB(b, h) ((4 + (b) * 2 + (h)) * HTB)
#define PG8_STAGE(bufoff, gbase, voff) do { _Pragma("unroll") for (int _i = 0; _i < 2; ++_i) \
        __builtin_amdgcn_global_load_lds((const unsigned*)((const char*)(gbase) + (voff)[_i]), (PG8_LAS unsigned*)(lds + (bufoff) + ldsw + _i * 8192), 16, 0, 0); } while (0)
#define PG8_LDA(dst, b, h) do { _Pragma("unroll") for (int m = 0; m < 4; ++m) _Pragma("unroll") for (int k = 0; k < 2; ++k) dst[m][k] = *(const PG8_LAS bf16x8*)(lds + PG8_SA(b, h) + aoff + m * 2048 + k * 1024); } while (0)
#define PG8_LDB(dst, b, h) do { _Pragma("unroll") for (int n = 0; n < 2; ++n) _Pragma("unroll") for (int k = 0; k < 2; ++k) dst[n][k] = *(const PG8_LAS bf16x8*)(lds + PG8_SB(b, h) + boff + n * 2048 + k * 1024); } while (0)
#define PG8_MMA(ai, bj, At, Bt) do { __builtin_amdgcn_s_setprio(1); _Pragma("unroll") for (int m = 0; m < 4; ++m) _Pragma("unroll") for (int n = 0; n < 2; ++n) _Pragma("unroll") for (int k = 0; k < 2; ++k) \
        acc[ai][bj][m][n] = __builtin_amdgcn_mfma_f32_16x16x32_bf16(Bt[n][k], At[m][k], acc[ai][bj][m][n], 0, 0, 0); __builtin_amdgcn_s_setprio(0); } while (0)
#define PG8_WAIT_V(n) asm volatile("s_waitcnt vmcnt(" #n ")" ::: "memory")
#define PG8_WAIT_L(n) asm volatile("s_waitcnt lgkmcnt(" #n ")" ::: "memory")
#define PG8_BAR __builtin_amdgcn_s_barrier()
#define PG8_SCHED __builtin_amdgcn_sched_barrier(0)
    Unit cur, nxt; int ui = 0;
    if (!S.next(0, cur)) return;
    f32x4 acc[2][2][4][2];
#pragma unroll
    for (int a = 0; a < 2; ++a)
#pragma unroll
        for (int b = 0; b < 2; ++b)
#pragma unroll
            for (int m = 0; m < 4; ++m)
#pragma unroll
                for (int n = 0; n < 2; ++n) acc[a][b][m][n] = (f32x4){0.f, 0.f, 0.f, 0.f};
    bf16x8 At[4][2], B0[2][2], B1[2][2];
    const char* cA = S.abase(g, cur, tstep); const char* cB = S.bbase(g, cur, tstep);
    S.a_ready(cur);
    if constexpr (SP2) {
        PG8_STAGE(PG8_SB(0, 0), cB, voffB); PG8_STAGE(PG8_SB(0, 1), cB + hstep, voffB); PG8_STAGE(PG8_SA(0, 0), cA, voffA); PG8_STAGE(PG8_SA(0, 1), cA + hstep, voffA);
        if (wr == 1) PG8_BAR;
        PG8_WAIT_V(2); PG8_BAR;
        PG8_STAGE(PG8_SB(1, 0), cB + kstep, voffB); PG8_STAGE(PG8_SA(1, 0), cA + kstep, voffA); PG8_STAGE(PG8_SB(1, 1), cB + hstep + kstep, voffB);
        PG8_WAIT_V(6); PG8_BAR;
    } else {
        PG8_STAGE(PG8_SB(0, 0), cB, voffB); PG8_STAGE(PG8_SA(0, 0), cA, voffA); PG8_STAGE(PG8_SB(0, 1), cB + hstep, voffB); PG8_STAGE(PG8_SA(0, 1), cA + hstep, voffA);
        if (wr == 1) PG8_BAR;
        PG8_WAIT_V(4); PG8_BAR;
        PG8_STAGE(PG8_SB(1, 0), cB + kstep, voffB); PG8_STAGE(PG8_SA(1, 0), cA + kstep, voffA); PG8_STAGE(PG8_SB(1, 1), cB + hstep + kstep, voffB);
        PG8_WAIT_V(6); PG8_BAR;
    }
    for (;;) {
        const bool has_next = S.next(ui + 1, nxt);
        const char* nA = has_next ? S.abase(g, nxt, tstep) : cA; const char* nB = has_next ? S.bbase(g, nxt, tstep) : cB;
        for (int t = 0; t < nt; t += 2) {
            const bool last = (t == nt - 2);
            const char* a1 = cA + (size_t)(t + 1) * kstep;
            const char* a2 = last ? nA : cA + (size_t)(t + 2) * kstep; const char* b2 = last ? nB : cB + (size_t)(t + 2) * kstep;
            const char* a3 = a2 + kstep; const char* b3 = b2 + kstep;
            if (last && has_next) S.a_ready(nxt);
            if constexpr (SP2) {
            PG8_LDB(B0, 0, 0); PG8_LDB(B1, 0, 1); PG8_SCHED; PG8_LDA(At, 0, 0); PG8_STAGE(PG8_SA(1, 1), a1 + hstep, voffA);
            PG8_WAIT_V(8); PG8_WAIT_L(0); PG8_BAR; PG8_MMA(0, 0, At, B0); PG8_MMA(0, 1, At, B1); PG8_BAR; PG8_SCHED;
            PG8_LDA(At, 0, 1); PG8_STAGE(PG8_SB(0, 0), b2, voffB); PG8_STAGE(PG8_SB(0, 1), b2 + hstep, voffB); PG8_STAGE(PG8_SA(0, 0), a2, voffA);
            PG8_WAIT_V(8); PG8_WAIT_L(0); PG8_BAR; PG8_MMA(1, 0, At, B0); PG8_MMA(1, 1, At, B1); PG8_BAR; PG8_SCHED;
            PG8_LDB(B0, 1, 0); PG8_LDB(B1, 1, 1); PG8_SCHED; PG8_LDA(At, 1, 0); PG8_STAGE(PG8_SA(0, 1), a2 + hstep, voffA);
            PG8_WAIT_V(8); PG8_WAIT_L(0); PG8_BAR; PG8_MMA(0, 0, At, B0); PG8_MMA(0, 1, At, B1); PG8_BAR; PG8_SCHED;
            PG8_LDA(At, 1, 1); PG8_STAGE(PG8_SB(1, 0), b3, voffB); PG8_STAGE(PG8_SB(1, 1), b3 + hstep, voffB); PG8_STAGE(PG8_SA(1, 0), a3, voffA);
            PG8_WAIT_V(8); PG8_WAIT_L(0); PG8_BAR; PG8_MMA(1, 0, At, B0); PG8_MMA(1, 1, At, B1); PG8_BAR; PG8_SCHED;
            } else {
            PG8_LDB(B0, 0, 0); PG8_SCHED; PG8_LDA(At, 0, 0); PG8_STAGE(PG8_SA(1, 1), a1 + hstep, voffA);
            PG8_WAIT_L(8); PG8_BAR; PG8_WAIT_L(0); PG8_MMA(0, 0, At, B0); PG8_BAR; PG8_SCHED;
            PG8_LDB(B1, 0, 1); PG8_STAGE(PG8_SB(0, 0), b2, voffB);
            PG8_BAR; PG8_WAIT_L(0); PG8_MMA(0, 1, At, B1); PG8_BAR;
            PG8_LDA(At, 0, 1); PG8_STAGE(PG8_SA(0, 0), a2, voffA);
            PG8_BAR; PG8_WAIT_L(0); PG8_MMA(1, 0, At, B0); PG8_BAR; PG8_SCHED;
            PG8_STAGE(PG8_SB(0, 1), b2 + hstep, voffB);
            PG8_WAIT_V(6); PG8_BAR; PG8_MMA(1, 1, At, B1); PG8_BAR;
            PG8_LDB(B0, 1, 0); PG8_SCHED; PG8_LDA(At, 1, 0); PG8_STAGE(PG8_SA(0, 1), a2 + hstep, voffA);
            PG8_WAIT_L(8); PG8_BAR; PG8_WAIT_L(0); PG8_MMA(0, 0, At, B0); PG8_BAR; PG8_SCHED;
            PG8_LDB(B1, 1, 1); PG8_STAGE(PG8_SB(1, 0), b3, voffB);
            PG8_BAR; PG8_WAIT_L(0); PG8_MMA(0, 1, At, B1); PG8_BAR;
            PG8_LDA(At, 1, 1); PG8_STAGE(PG8_SA(1, 0), a3, voffA);
            PG8_BAR; PG8_WAIT_L(0); PG8_MMA(1, 0, At, B0); PG8_BAR; PG8_SCHED;
            PG8_STAGE(PG8_SB(1, 1), b3 + hstep, voffB);
            PG8_WAIT_V(6); PG8_BAR; PG8_MMA(1, 1, At, B1); PG8_BAR;
            }
        }
        if constexpr (ALIGN_EPI) { if (wr == 0) PG8_BAR; }
        if constexpr (!Epi::AFTER_DRAIN) { E(acc, cur, wr, wc, fr, fq); S.done(cur); }
        if (!has_next) break;
#pragma unroll
        for (int a = 0; a < 2; ++a)
#pragma unroll
            for (int b = 0; b < 2; ++b)
#pragma unroll
                for (int m = 0; m < 4; ++m)
#pragma unroll
                    for (int n = 0; n < 2; ++n) acc[a][b][m][n] = (f32x4){0.f, 0.f, 0.f, 0.f};
        cur = nxt; cA = nA; cB = nB; ++ui;
        if constexpr (ALIGN_EPI) { if (wr == 1) PG8_BAR; }
    }
    PG8_WAIT_V(0);
    if constexpr (!ALIGN_EPI) { if (wr == 0) PG8_BAR; }
    PG8_BAR;
    if constexpr (Epi::AFTER_DRAIN) { E.fused(acc, cur, wr, wc, fr, fq, lds, wid, lane); S.done(cur); }
#undef PG8_SA
#undef PG8_SB
#undef PG8_STAGE
#undef PG8_LDA
#undef PG8_LDB
#undef PG8_MMA
#undef PG8_WAIT_V
#undef PG8_WAIT_L
#undef PG8_BAR
#undef PG8_SCHED
}
}

#define LAS __attribute__((address_space(3)))
#define GAS __attribute__((address_space(1)))
typedef float f32x4 __attribute__((ext_vector_type(4)));
typedef unsigned u32x4 __attribute__((ext_vector_type(4)));
typedef unsigned u32x2 __attribute__((ext_vector_type(2)));
typedef short bf16x8 __attribute__((ext_vector_type(8)));
constexpr int NTHR = 512, NWAVES = 8;
constexpr int MK_LDS_BYTES = 147456;
constexpr int LDS_MISC_OFF = 131072;

__device__ __forceinline__ unsigned cvt_pk_bf16(float lo, float hi) { unsigned r; asm volatile("v_cvt_pk_bf16_f32 %0, %1, %2" : "=v"(r) : "v"(lo), "v"(hi)); return r; }

struct EpiProj {
    static constexpr bool PERM = true, AFTER_DRAIN = false;
    bf16_t* O; int ldc;
    __device__ __forceinline__ void operator()(const pg8::f32x4 (&acc)[2][2][4][2], const pg8::Unit& u, int wr, int wc, int fr, int fq) const {
        const int row0 = u.pm * 256 + wr * 64 + fr, col0 = u.pn * 256 + wc * 32 + 8 * fq;
#pragma unroll
        for (int ai = 0; ai < 2; ++ai)
#pragma unroll
            for (int m = 0; m < 4; ++m) { bf16_t* rowp = O + (size_t)(row0 + ai * 128 + m * 16) * ldc + col0;
#pragma unroll
                for (int bj = 0; bj < 2; ++bj) { const pg8::f32x4 v0 = acc[ai][bj][m][0], v1 = acc[ai][bj][m][1];
                    u32x4 w; w.x = cvt_pk_bf16(v0[0], v0[1]); w.y = cvt_pk_bf16(v0[2], v0[3]); w.z = cvt_pk_bf16(v1[0], v1[1]); w.w = cvt_pk_bf16(v1[2], v1[3]);
                    *(u32x4*)(rowp + bj * 128) = w; } }
    }
};
__device__ __forceinline__ float bflo(unsigned w) { return __uint_as_float(w << 16); }
__device__ __forceinline__ float bfhi(unsigned w) { return __uint_as_float(w & 0xffff0000u); }
template <int STEP> struct EpiMerge {
    static constexpr bool PERM = true, AFTER_DRAIN = false;
    const bf16_t* proj; bf16_t* T1; bf16_t* MG;
    __device__ __forceinline__ void operator()(const pg8::f32x4 (&acc)[2][2][4][2], const pg8::Unit& u, int wr, int wc, int fr, int fq) const {
        const int row0 = u.pm * 256 + wr * 64 + fr, col0 = u.pn * 256 + wc * 32 + 8 * fq;
#pragma unroll
        for (int ai = 0; ai < 2; ++ai)
#pragma unroll
            for (int m = 0; m < 4; ++m) { const size_t row = (size_t)(row0 + ai * 128 + m * 16);
#pragma unroll
                for (int bj = 0; bj < 2; ++bj) { const int col = col0 + bj * 128;
                    const u32x4 g = *(const u32x4*)(proj + row * PLD + C_MG + (STEP == 2 ? 1024 : 0) + col);
                    const pg8::f32x4 v0 = acc[ai][bj][m][0], v1 = acc[ai][bj][m][1];
                    float r[8];
                    r[0] = sigmoidf_(bflo(g.x)) * v0[0]; r[1] = sigmoidf_(bfhi(g.x)) * v0[1]; r[2] = sigmoidf_(bflo(g.y)) * v0[2]; r[3] = sigmoidf_(bfhi(g.y)) * v0[3];
                    r[4] = sigmoidf_(bflo(g.z)) * v1[0]; r[5] = sigmoidf_(bfhi(g.z)) * v1[1]; r[6] = sigmoidf_(bflo(g.w)) * v1[2]; r[7] = sigmoidf_(bfhi(g.w)) * v1[3];
                    if (STEP == 2) { const u32x4 t = *(const u32x4*)(T1 + row * DM + col);
                        r[0] += bflo(t.x); r[1] += bfhi(t.x); r[2] += bflo(t.y); r[3] += bfhi(t.y); r[4] += bflo(t.z); r[5] += bfhi(t.z); r[6] += bflo(t.w); r[7] += bfhi(t.w); }
                    u32x4 w; w.x = cvt_pk_bf16(r[0], r[1]); w.y = cvt_pk_bf16(r[2], r[3]); w.z = cvt_pk_bf16(r[4], r[5]); w.w = cvt_pk_bf16(r[6], r[7]);
                    *(u32x4*)((STEP == 2 ? MG : T1) + row * DM + col) = w; } }
    }
};
struct EpiOut {
    static constexpr bool PERM = false, AFTER_DRAIN = false;
    const float* x; const float* mod; float* h1;
    __device__ __forceinline__ void operator()(const pg8::f32x4 (&acc)[2][2][4][2], const pg8::Unit& u, int wr, int wc, int fr, int fq) const {
        const int row0 = u.pm * 256 + wr * 64 + fr, col0 = u.pn * 256 + wc * 32 + 4 * fq;
        const float* gate = mod + (u.pm * 256 / SEQ) * 6144 + 2048;
#pragma unroll
        for (int bj = 0; bj < 2; ++bj)
#pragma unroll
            for (int n = 0; n < 2; ++n) { const int col = col0 + bj * 128 + n * 16; const pg8::f32x4 gv = *(const pg8::f32x4*)(gate + col);
#pragma unroll
                for (int ai = 0; ai < 2; ++ai)
#pragma unroll
                    for (int m = 0; m < 4; ++m) { const size_t off = (size_t)(row0 + ai * 128 + m * 16) * DM + col;
                        const pg8::f32x4 xv = *(const pg8::f32x4*)(x + off); *(pg8::f32x4*)(h1 + off) = xv + gv * acc[ai][bj][m][n]; } }
    }
};
struct EpiSwiglu {
    static constexpr bool PERM = true, AFTER_DRAIN = false;
    const float* b1; bf16_t* act;
    __device__ __forceinline__ void operator()(const pg8::f32x4 (&acc)[2][2][4][2], const pg8::Unit& u, int wr, int wc, int fr, int fq) const {
        const int row0 = u.pm * 256 + wr * 64 + fr, col0 = u.pn * 128 + wc * 32 + 8 * fq;
        const float* bg = b1 + u.e * 2048 + col0; const float* bu = bg + 1024;
        float gb[8], ub[8];
#pragma unroll
        for (int j = 0; j < 8; ++j) { gb[j] = bg[j]; ub[j] = bu[j]; }
#pragma unroll
        for (int ai = 0; ai < 2; ++ai)
#pragma unroll
            for (int m = 0; m < 4; ++m) { float r[8];
#pragma unroll
                for (int j = 0; j < 8; ++j) { float g = acc[ai][0][m][j >> 2][j & 3] + gb[j], uu = acc[ai][1][m][j >> 2][j & 3] + ub[j];
                    g = fminf(g, 7.f); uu = fminf(fmaxf(uu, -7.f), 7.f); r[j] = g * sigmoidf_(1.702f * g) * (uu + 1.f); }
                u32x4 w; w.x = cvt_pk_bf16(r[0], r[1]); w.y = cvt_pk_bf16(r[2], r[3]); w.z = cvt_pk_bf16(r[4], r[5]); w.w = cvt_pk_bf16(r[6], r[7]);
                *(u32x4*)(act + (size_t)(row0 + ai * 128 + m * 16) * DM + col0) = w; }
    }
};
struct EpiMoe2 {
    static constexpr bool PERM = true, AFTER_DRAIN = false;
    const float* b2; bf16_t* ys;
    __device__ __forceinline__ void operator()(const pg8::f32x4 (&acc)[2][2][4][2], const pg8::Unit& u, int wr, int wc, int fr, int fq) const {
        const int row0 = u.pm * 256 + wr * 64 + fr, col0 = u.pn * 256 + wc * 32 + 8 * fq;
#pragma unroll
        for (int bj = 0; bj < 2; ++bj) { const float* bb = b2 + u.e * 1024 + col0 + bj * 128; float bv[8];
#pragma unroll
            for (int j = 0; j < 8; ++j) bv[j] = bb[j];
#pragma unroll
            for (int ai = 0; ai < 2; ++ai)
#pragma unroll
                for (int m = 0; m < 4; ++m) { const pg8::f32x4 v0 = acc[ai][bj][m][0], v1 = acc[ai][bj][m][1];
                    u32x4 w; w.x = cvt_pk_bf16(v0[0] + bv[0], v0[1] + bv[1]); w.y = cvt_pk_bf16(v0[2] + bv[2], v0[3] + bv[3]); w.z = cvt_pk_bf16(v1[0] + bv[4], v1[1] + bv[5]); w.w = cvt_pk_bf16(v1[2] + bv[6], v1[3] + bv[7]);
                    *(u32x4*)(ys + (size_t)(row0 + ai * 128 + m * 16) * DM + col0 + bj * 128) = w; } }
    }
};
struct MoeOrder {
    int ntile, nN, G, c; const int* blk_e; size_t estride;
    __device__ __forceinline__ bool next(int i, pg8::Unit& u) const { const int L = i * G + c; if (L >= ntile * nN) return false; u.pm = L / nN; u.pn = L % nN; u.e = blk_e[u.pm]; return true; }
    __device__ __forceinline__ void a_ready(const pg8::Unit&) const {}
    __device__ __forceinline__ void done(const pg8::Unit&) const {}
    __device__ __forceinline__ const char* abase(const pg8::Gemm& g, const pg8::Unit& u, size_t tstep) const { return (const char*)g.A + (size_t)u.pm * tstep; }
    __device__ __forceinline__ const char* bbase(const pg8::Gemm& g, const pg8::Unit& u, size_t tstep) const { return (const char*)g.Bt + (size_t)u.e * estride + (size_t)u.pn * tstep; }
};

constexpr int CW_BAR = 4096;
#define XB_TMO      128
#define XB_XCNT(j)  (256  + 64 * (j))
#define XB_XSUB(j)  (1280 + 64 * (j))
#define XB_XGEN(j)  (2304 + 64 * (j))
#define XB_TOP      3328
#define XB_TOPGEN   3392
#define XCD_BAR_WORDS 3456
#define XB_SPIN_CAP (1u << 18)
__device__ __forceinline__ unsigned xb_ld(unsigned* p)              { return __hip_atomic_load(p, __ATOMIC_RELAXED, __HIP_MEMORY_SCOPE_AGENT); }
__device__ __forceinline__ unsigned xb_add(unsigned* p, unsigned v) { return __hip_atomic_fetch_add(p, v, __ATOMIC_RELAXED, __HIP_MEMORY_SCOPE_AGENT); }
__device__ __forceinline__ unsigned xb_xcc_id() { return (unsigned)__builtin_amdgcn_s_getreg((3 << 11) | 20) & 0xFu; }
#define XB_SPIN(cond, bar) do { unsigned _sp = 0; while (cond) { __builtin_amdgcn_s_sleep(1); \
    if ((++_sp & 255u) == 0u) { if (xb_ld(&(bar)[XB_TMO])) break; if (_sp > XB_SPIN_CAP) { atomicAdd(&(bar)[XB_TMO], 1u); break; } } } } while (0)
struct XcdBarrier { unsigned* bar; unsigned x; volatile LAS unsigned* st; };
__device__ __forceinline__ XcdBarrier xcd_barrier_post(unsigned* bar, volatile LAS unsigned* st) {
    XcdBarrier b; b.bar = bar; b.x = xb_xcc_id(); b.st = st;
    if (threadIdx.x == 0) (void)xb_add(&bar[XB_XCNT(b.x)], 1u);
    return b;
}
__device__ __forceinline__ void xcd_barrier_complete(unsigned* bar, unsigned x, unsigned& nloc, unsigned& nx) {
    const unsigned G = gridDim.x * gridDim.y * gridDim.z;
    unsigned sum, cnt, mine, sp = 0u;
    for (;;) {
        sum = 0u; cnt = 0u; mine = 0u;
#pragma unroll
        for (unsigned j = 0; j < 16; ++j) { const unsigned c = xb_ld(&bar[XB_XCNT(j)]); sum += c; cnt += (c > 0u) ? 1u : 0u; mine = (j == x) ? c : mine; }
        if (sum == G) break;
        __builtin_amdgcn_s_sleep(1);
        if ((++sp & 255u) == 0u) { if (xb_ld(&bar[XB_TMO])) break; if (sp > XB_SPIN_CAP) { atomicAdd(&bar[XB_TMO], 1u); break; } }
    }
    nloc = mine > 0u ? mine : 1u; nx = cnt > 0u ? cnt : 1u;
}
__device__ __forceinline__ void xcd_barrier(const XcdBarrier& b) {
    asm volatile("s_waitcnt vmcnt(0)" ::: "memory");
    __syncthreads();
    if (threadIdx.x == 0) {
        unsigned* bar = b.bar;
        __builtin_amdgcn_s_waitcnt(0);
        unsigned nloc = b.st[0], nx = b.st[1];
        if (nloc == 0u) { xcd_barrier_complete(bar, b.x, nloc, nx); b.st[0] = nloc; b.st[1] = nx; }
        const unsigned old = xb_add(&bar[XB_XSUB(b.x)], 1u);
        const unsigned gen = old / nloc;
        if (old + 1u == (gen + 1u) * nloc) {
            __builtin_amdgcn_fence(__ATOMIC_RELEASE, "agent");
            asm volatile("s_waitcnt vmcnt(0)" ::: "memory");
            const unsigned og = xb_add(&bar[XB_TOP], 1u);
            const unsigned tg = og / nx;
            if (og + 1u == (tg + 1u) * nx) xb_add(&bar[XB_TOPGEN], 1u);
            else XB_SPIN(xb_ld(&bar[XB_TOPGEN]) == tg, bar);
            __builtin_amdgcn_fence(__ATOMIC_ACQUIRE, "agent");
            xb_add(&bar[XB_XGEN(b.x)], 1u);
            asm volatile("s_waitcnt vmcnt(0)" ::: "memory");
        } else {
            XB_SPIN(xb_ld(&bar[XB_XGEN(b.x)]) == gen, bar);
            __builtin_amdgcn_fence(__ATOMIC_ACQUIRE, "agent");
            asm volatile("s_waitcnt vmcnt(0)" ::: "memory");
        }
    }
    __syncthreads();
}

__device__ __forceinline__ void ph_mod(const P& p, LAS unsigned char* lds, int bid, int nblk) {
    LAS float* sc = (LAS float*)lds;
    LAS float* red = (LAS float*)(lds + 16384);
    const int tid = threadIdx.x;
    for (int i = tid; i < 4096; i += NTHR) sc[i] = siluf_(p.c[i]);
    __syncthreads();
    for (int cb = bid; cb < 256; cb += nblk) {
        const int cq = tid % 6, kr = tid / 6;
        float acc[4][4];
#pragma unroll
        for (int b = 0; b < 4; ++b)
#pragma unroll
            for (int j = 0; j < 4; ++j) acc[b][j] = 0.f;
        if (kr < 85)
            for (int k = kr; k < 1024; k += 85) {
                const f32x4 w = *(const f32x4*)(p.w_ada + (size_t)k * 6144 + cb * 24 + cq * 4);
#pragma unroll
                for (int b = 0; b < 4; ++b) { const float s = sc[b * 1024 + k]; acc[b][0] += s * w[0]; acc[b][1] += s * w[1]; acc[b][2] += s * w[2]; acc[b][3] += s * w[3]; }
            }
#pragma unroll
        for (int b = 0; b < 4; ++b)
#pragma unroll
            for (int j = 0; j < 4; ++j) red[tid * 16 + b * 4 + j] = acc[b][j];
        __syncthreads();
        if (tid < 96) {
            const int b = tid / 24, col = tid % 24, q = col >> 2, j = col & 3; float s = 0.f;
            for (int r = 0; r < 85; ++r) s += red[(r * 6 + q) * 16 + b * 4 + j];
            WSP(float, WS_MOD)[b * 6144 + cb * 24 + col] = s + p.b_ada[cb * 24 + col];
        }
        __syncthreads();
    }
}
template <class RowMap>
__device__ __forceinline__ void conv_tile(const float* src, int ldw, int k0, int n0, int N, bf16_t* dst, int dK, const RowMap& rowmap, LAS float* T) {
    const int tid = threadIdx.x, wid = tid >> 6, lane = tid & 63;
#pragma unroll
    for (int r = 0; r < 8; ++r) {
        const int k = 8 * wid + r, n = 4 * lane;
        f32x4 v = (f32x4){0.f, 0.f, 0.f, 0.f};
        if (n0 + n < N) v = *(const f32x4*)(src + (size_t)(k0 + k) * ldw + n0 + n);
        *(LAS f32x4*)(T + k * 260 + (n ^ (wid << 2))) = v;
    }
    __syncthreads();
    const int c = tid & 7;
#pragma unroll
    for (int pass = 0; pass < 4; ++pass) {
        const int n = (tid >> 3) + 64 * pass;
        if (n0 + n < N) {
            float f[8];
#pragma unroll
            for (int i = 0; i < 8; ++i) f[i] = T[(8 * c + i) * 260 + (n ^ (c << 2))];
            u32x4 w; w.x = cvt_pk_bf16(f[0], f[1]); w.y = cvt_pk_bf16(f[2], f[3]); w.z = cvt_pk_bf16(f[4], f[5]); w.w = cvt_pk_bf16(f[6], f[7]);
            *(u32x4*)(dst + (size_t)rowmap(n0 + n) * dK + k0 + 8 * c) = w;
        }
    }
    __syncthreads();
}
struct RowId { __device__ __forceinline__ int operator()(int n) const { return n; } };
struct RowWin { __device__ __forceinline__ int operator()(int n) const {
    if (n < 3072) return n; if (n < 3088) return n + 4608; if (n < 5648) return n - 16; if (n < 5672) return n + 2048; return n - 40; } };
struct RowW1 { __device__ __forceinline__ int operator()(int n) const { const int h = n >> 10, r = n & 1023; return (r >> 7) * 256 + h * 128 + (r & 127); } };
struct RowOff { int off; __device__ __forceinline__ int operator()(int n) const { return n + off; } };
__device__ __forceinline__ void ph_convert(const P& p, LAS unsigned char* lds, int bid, int nblk) {
    LAS float* T = (LAS float*)lds;
    constexpr int I_WIN = 16 * 31, I_SQ = 16 * 4, I_W1 = 32 * 128, I_W2 = 32 * 64, I_C1 = 2 * 2 * 32, I_C2 = 2 * 4;
    constexpr int NITEMS = I_WIN + 3 * I_SQ + I_W1 + I_W2 + I_C1 + I_C2 + 1;
    for (int it = bid; it < NITEMS; it += nblk) {
        int r = it;
        if (r < I_W1) { const int e = r >> 7, t = r & 127, kt = t >> 3, ntile = t & 7;
            conv_tile(p.moe_w1 + (size_t)e * 1024 * 2048, 2048, kt * 64, ntile * 256, 2048, WSP(bf16_t, WS_W1T) + (size_t)e * 2048 * 1024, 1024, RowW1{}, T); continue; } r -= I_W1;
        if (r < I_W2) { const int e = r >> 6, t = r & 63, kt = t >> 2, ntile = t & 3;
            conv_tile(p.moe_w2 + (size_t)e * 1024 * 1024, 1024, kt * 64, ntile * 256, 1024, WSP(bf16_t, WS_W2T) + (size_t)e * 1024 * 1024, 1024, RowId{}, T); continue; } r -= I_W2;
        if (r < I_WIN) { const int kt = r / 31, ntile = r % 31; conv_tile(p.w_in, IN_COLS, kt * 64, ntile * 256, IN_COLS, WSP(bf16_t, WS_WINT), 1024, RowWin{}, T); continue; } r -= I_WIN;
        if (r < I_SQ) { conv_tile(p.proj_gla, 1024, (r >> 2) * 64, (r & 3) * 256, 1024, WSP(bf16_t, WS_PGLAT), 1024, RowId{}, T); continue; } r -= I_SQ;
        if (r < I_SQ) { conv_tile(p.proj_nsa, 1024, (r >> 2) * 64, (r & 3) * 256, 1024, WSP(bf16_t, WS_PNSAT), 1024, RowId{}, T); continue; } r -= I_SQ;
        if (r < I_SQ) { conv_tile(p.w_out, 1024, (r >> 2) * 64, (r & 3) * 256, 1024, WSP(bf16_t, WS_WOUTT), 1024, RowId{}, T); continue; } r -= I_SQ;
        if (r < I_C1) { const int which = r >> 6, half = (r >> 5) & 1, kt = r & 31;
            conv_tile(p.cmp_w1 + ((size_t)which * 4096 + half * 2048) * 256, 256, kt * 64, 0, 256, WSP(bf16_t, WS_CW1T) + (size_t)which * 512 * 2048, 2048, RowOff{half * 256}, T); continue; } r -= I_C1;
        if (r < I_C2) { const int which = r >> 2, kt = r & 3;
            conv_tile(p.cmp_w2 + (size_t)which * 256 * 128, 128, kt * 64, 0, 128, WSP(bf16_t, WS_CW2T) + (size_t)which * 128 * 256, 256, RowId{}, T); continue; }
        { u32x4* z = (u32x4*)(WSP(bf16_t, WS_WINT) + (size_t)IN_COLS * 1024); const int n16 = (PLD - IN_COLS) * 1024 * 2 / 16;
          for (int i = threadIdx.x; i < n16; i += NTHR) z[i] = (u32x4){0u, 0u, 0u, 0u}; }
    }
}
__device__ __forceinline__ void ph_u1(const P& p, int bid, int nblk) {
    const int lane = threadIdx.x & 63, gw = bid * NWAVES + (threadIdx.x >> 6), NGW = nblk * NWAVES;
    for (int row = gw; row < NTOK; row += NGW) {
        const f32x4* xr = (const f32x4*)(p.x + (size_t)row * DM) + lane; const float* mod = WSP(float, WS_MOD) + (row / SEQ) * 6144;
        f32x4 v[4]; float ss = 0.f;
#pragma unroll
        for (int j = 0; j < 4; ++j) { v[j] = xr[64 * j]; ss += (v[j][0] * v[j][0] + v[j][1] * v[j][1]) + (v[j][2] * v[j][2] + v[j][3] * v[j][3]); }
        const float rstd = rsqrtf(wave_sum(ss) * (1.f / DM) + RMS_EPS);
        u32x2* o = (u32x2*)(WSP(bf16_t, WS_U1) + (size_t)row * DM) + lane;
#pragma unroll
        for (int j = 0; j < 4; ++j) { const int col = 4 * lane + 256 * j;
            const f32x4 g = *(const f32x4*)(p.norm1_g + col), sc = *(const f32x4*)(mod + 1024 + col), sh = *(const f32x4*)(mod + col);
            float r[4];
#pragma unroll
            for (int i = 0; i < 4; ++i) r[i] = v[j][i] * rstd * g[i] * (1.f + sc[i]) + sh[i];
            u32x2 w; w.x = cvt_pk_bf16(r[0], r[1]); w.y = cvt_pk_bf16(r[2], r[3]); o[64 * j] = w; }
    }
}

template <class F, bool DUAL>
__device__ __forceinline__ void sgemm_tile_dev(F f, const P& p, int m0, int n0, LAS float* sm) {
    LAS float* As = sm; LAS float* Bs = sm + 16 * 68; LAS float* Bs2 = sm + 32 * 68;
    const int tid = threadIdx.x, tx = tid & 15, ty = (tid >> 4) & 15; const bool act = tid < 256;
    f.init(p, m0);
    float acc[4][4], acc2[4][4];
#pragma unroll
    for (int i = 0; i < 4; ++i)
#pragma unroll
        for (int j = 0; j < 4; ++j) { acc[i][j] = 0.f; acc2[i][j] = 0.f; }
    const int K = f.K;
    for (int k0 = 0; k0 < K; k0 += 16) {
        if (act) {
            { const int r = tid >> 2, kq = (tid & 3) * 4;
#pragma unroll
              for (int i = 0; i < 4; ++i) As[(kq + i) * 68 + r] = f.a(p, m0 + r, k0 + kq + i); }
            { const int kk = tid >> 4, cc = (tid & 15) * 4;
#pragma unroll
              for (int i = 0; i < 4; ++i) { Bs[kk * 68 + cc + i] = f.b(p, k0 + kk, n0 + cc + i); if (DUAL) Bs2[kk * 68 + cc + i] = f.b2(p, k0 + kk, n0 + cc + i); } }
        }
        __syncthreads();
        if (act) {
#pragma unroll
            for (int kk = 0; kk < 16; ++kk) {
                float a[4], b[4], b2[4];
#pragma unroll
                for (int i = 0; i < 4; ++i) { a[i] = As[kk * 68 + ty * 4 + i]; b[i] = Bs[kk * 68 + tx * 4 + i]; b2[i] = DUAL ? Bs2[kk * 68 + tx * 4 + i] : 0.f; }
#pragma unroll
                for (int i = 0; i < 4; ++i)
#pragma unroll
                    for (int j = 0; j < 4; ++j) { acc[i][j] += a[i] * b[j]; if (DUAL) acc2[i][j] += a[i] * b2[j]; }
            }
        }
        __syncthreads();
    }
    if (act) {
#pragma unroll
        for (int i = 0; i < 4; ++i)
#pragma unroll
            for (int j = 0; j < 4; ++j) f.store(p, m0 + ty * 4 + i, n0 + tx * 4 + j, acc[i][j], acc2[i][j]);
    }
}
__device__ __forceinline__ void ph_loga_naive(const P& p, int bid, int nblk) {
    for (size_t idx = (size_t)bid * NTHR + threadIdx.x; idx < (size_t)NTOK * 512; idx += (size_t)nblk * NTHR) {
        const size_t row = idx >> 9; const int j = (int)(idx & 511);
        const bf16_t* pr = WSP(bf16_t, WS_PROJ) + row * PLD + C_GA;
        float xx = p.gla_ba[j];
#pragma unroll
        for (int r = 0; r < 16; ++r) xx += bf2f(pr[r]) * p.gla_wa2[r * 512 + j];
        const float ls = fminf(xx, 0.f) - log1pf(__expf(-fabsf(xx)));
        WSP(float, WS_LOGA)[idx] = ls * (1.f / 16.f);
    }
}
__device__ __forceinline__ void ph_gla_naive(const P& p, int bid, int nblk) {
    const int tid = threadIdx.x;
    if (tid >= 256) return;
    for (int blk = bid; blk < 256; blk += nblk) {
        const int b = blk >> 6, h = (blk >> 4) & 3, vg = blk & 15, vl = tid >> 4, kg = tid & 15;
        const int vcol = h * 256 + vg * 16 + vl;
        float S[8];
#pragma unroll
        for (int i = 0; i < 8; ++i) S[i] = 0.f;
        const bf16_t* proj = WSP(bf16_t, WS_PROJ); const float* loga = WSP(float, WS_LOGA); float* og = WSP(float, WS_OGLA);
        for (int t = 0; t < SEQ; ++t) {
            const size_t row = (size_t)b * SEQ + t;
            const bf16_t* pr = proj + row * PLD;
            const float vv = bf2f(pr[C_GV + vcol]);
            float part = 0.f;
#pragma unroll
            for (int i = 0; i < 8; ++i) {
                const int d = h * 128 + kg * 8 + i;
                const float a = __expf(loga[row * 512 + d]);
                S[i] = a * S[i] + bf2f(pr[C_GK + d]) * vv;
                part += bf2f(pr[C_GQ + d]) * S[i];
            }
            part += __shfl_xor(part, 1); part += __shfl_xor(part, 2); part += __shfl_xor(part, 4); part += __shfl_xor(part, 8);
            if (kg == 0) og[row * DM + vcol] = part * 0.08838834764831845f;
        }
    }
}
__device__ __forceinline__ void ph_ygla_naive(const P& p, int bid, int nblk) {
    const int lane = threadIdx.x & 63, gw = bid * NWAVES + (threadIdx.x >> 6), NGW = nblk * NWAVES;
    for (int w = gw; w < NTOK * 4; w += NGW) {
        const int row = w >> 2, h = w & 3;
        const float* o = WSP(float, WS_OGLA) + (size_t)row * DM + h * 256;
        float v[4]; float ss = 0.f;
#pragma unroll
        for (int i = 0; i < 4; ++i) { v[i] = o[lane + 64 * i]; ss += v[i] * v[i]; }
        const float rstd = rsqrtf(wave_sum(ss) * (1.f / 256.f) + RMS_EPS);
        const bf16_t* pr = WSP(bf16_t, WS_PROJ) + (size_t)row * PLD + C_GR + h * 256;
        bf16_t* y = WSP(bf16_t, WS_YGLA) + (size_t)row * DM + h * 256;
#pragma unroll
        for (int i = 0; i < 4; ++i) { const int dv = lane + 64 * i; y[dv] = f2bf(v[i] * rstd * p.gla_norm_g[dv] * siluf_(bf2f(pr[dv]))); }
    }
}
template <bool WIN>
__device__ __forceinline__ void sparse_attend(const P& p, int b, int g, int t, int hq, u64 mask, LAS float* q, LAS float* pp, int lane, float& o0, float& o1) {
    const bf16_t* proj = WSP(bf16_t, WS_PROJ);
    const int kcol = (WIN ? C_KW : C_KS) + g * 128, vcol = (WIN ? C_VW : C_VS) + g * 128;
    const int nch = WIN ? 8 : __popcll(mask);
    int base[16];
    { u64 mm = mask;
#pragma unroll
      for (int jj = 0; jj < 16; ++jj) { if (WIN) base[jj] = t - 511 + jj * 64; else { const int bi = mm ? __ffsll((long long)mm) - 1 : 0; base[jj] = bi * 64; mm &= mm - 1; } } }
    float s[16]; float m = -INFINITY;
#pragma unroll
    for (int jj = 0; jj < 16; ++jj) {
        s[jj] = -INFINITY;
        if (jj < nch) { const int pos = base[jj] + lane;
            if (pos >= 0 && pos <= t) { const bf16_t* kr = proj + ((size_t)b * SEQ + pos) * PLD + kcol; float a = 0.f; for (int d = 0; d < 128; ++d) a += q[d] * bf2f(kr[d]); s[jj] = a * ATT_SCALE; } }
        m = fmaxf(m, s[jj]);
    }
    m = wave_max(m);
    float sum = 0.f;
#pragma unroll
    for (int jj = 0; jj < 16; ++jj) { s[jj] = (s[jj] > -INFINITY) ? __expf(s[jj] - m) : 0.f; sum += s[jj]; }
    sum = wave_sum(sum);
    const float inv = 1.f / fmaxf(sum, 1e-30f);
#pragma unroll
    for (int jj = 0; jj < 16; ++jj) pp[jj * 64 + lane] = s[jj] * inv;
    __builtin_amdgcn_wave_barrier();
    o0 = 0.f; o1 = 0.f;
#pragma unroll
    for (int jj = 0; jj < 16; ++jj) {
        if (jj < nch) {
            for (int l = 0; l < 64; ++l) {
                const float pv = pp[jj * 64 + l];
                int pos = base[jj] + l; pos = pos < 0 ? 0 : (pos > SEQ - 1 ? SEQ - 1 : pos);
                const bf16_t* vr = proj + ((size_t)b * SEQ + pos) * PLD + vcol;
                o0 += pv * bf2f(vr[lane]); o1 += pv * bf2f(vr[64 + lane]);
            }
        }
    }
    __builtin_amdgcn_wave_barrier();
}
__device__ __forceinline__ void ph_nsa_naive(const P& p, LAS unsigned char* lds, int bid, int nblk) {
    const int wid = threadIdx.x >> 6, lane = threadIdx.x & 63, gw = bid * NWAVES + wid, NGW = nblk * NWAVES;
    LAS float* wl = (LAS float*)lds + wid * 1920;
    LAS float* q = wl; LAS float* pp = wl + 128; LAS float* ps = wl + 1152; LAS float* oc = wl + 1408;
    for (int w = gw; w < BATCH * 2 * SEQ; w += NGW) {
        const int b = w >> 13, g = (w >> 12) & 1, t = w & 4095;
        const size_t row = (size_t)b * SEQ + t;
        const bf16_t* pr = WSP(bf16_t, WS_PROJ) + row * PLD;
        const bf16_t* kc = WSP(bf16_t, WS_KCVC) + (((size_t)0 * 4 + b) * 2 + g) * 256 * 128;
        const bf16_t* vc = WSP(bf16_t, WS_KCVC) + (((size_t)1 * 4 + b) * 2 + g) * 256 * 128;
        const int ncv = t >= 31 ? (t - 31) / 16 + 1 : 0;
        for (int i = 0; i < 4; ++i) ps[lane + 64 * i] = 0.f;
        for (int r = 0; r < 4; ++r) {
            const int hq = g * 4 + r;
            q[lane] = bf2f(pr[C_NQ + hq * 128 + lane]); q[lane + 64] = bf2f(pr[C_NQ + hq * 128 + 64 + lane]);
            __builtin_amdgcn_wave_barrier();
            float s[4]; float m = -INFINITY;
            for (int i = 0; i < 4; ++i) {
                const int c = lane + 64 * i; s[i] = -INFINITY;
                if (c < ncv) { float a = 0.f; for (int d = 0; d < 128; ++d) a += q[d] * bf2f(kc[c * 128 + d]); s[i] = a * ATT_SCALE; }
                m = fmaxf(m, s[i]);
            }
            m = wave_max(m);
            float e[4]; float sum = 0.f;
            for (int i = 0; i < 4; ++i) { const int c = lane + 64 * i; e[i] = (c < ncv) ? __expf(s[i] - m) : 0.f; sum += e[i]; }
            sum = wave_sum(sum);
            const float inv = 1.f / fmaxf(sum, 1e-30f);
            for (int i = 0; i < 4; ++i) { const int c = lane + 64 * i; const float pv = e[i] * inv; pp[c] = pv; ps[c] += pv; }
            __builtin_amdgcn_wave_barrier();
            float o0 = 0.f, o1 = 0.f;
            for (int c = 0; c < ncv; ++c) { const float pv = pp[c]; o0 += pv * bf2f(vc[c * 128 + lane]); o1 += pv * bf2f(vc[c * 128 + 64 + lane]); }
            oc[r * 128 + lane] = o0; oc[r * 128 + 64 + lane] = o1;
            __builtin_amdgcn_wave_barrier();
        }
        const int s = lane, tb = t >> 6;
        float imp = 0.f;
        for (int c = 4 * s - 1; c <= 4 * s + 3; ++c) if (c >= 0 && c < NCMP) imp += ps[c];
        const bool forced = (s == 0) || (s == tb) || (s == tb - 1), valid = s <= tb;
        const float score = forced ? INFINITY : (valid ? imp : -INFINITY);
        int rank = 0;
        for (int j = 0; j < 64; ++j) { const float sj = __shfl(score, j); rank += (sj > score) || (sj == score && j < s); }
        const bool sel = rank < 16 && score > -INFINITY;
        const u64 mask = __ballot(sel);
        for (int r = 0; r < 4; ++r) {
            const int hq = g * 4 + r;
            q[lane] = bf2f(pr[C_NQ + hq * 128 + lane]); q[lane + 64] = bf2f(pr[C_NQ + hq * 128 + 64 + lane]);
            __builtin_amdgcn_wave_barrier();
            float s0, s1, w0, w1;
            sparse_attend<false>(p, b, g, t, hq, mask, q, pp, lane, s0, s1);
            sparse_attend<true>(p, b, g, t, hq, 0ull, q, pp, lane, w0, w1);
            const float g0 = sigmoidf_(bf2f(pr[C_NG + hq * 3 + 0])), g1 = sigmoidf_(bf2f(pr[C_NG + hq * 3 + 1])), g2 = sigmoidf_(bf2f(pr[C_NG + hq * 3 + 2]));
            bf16_t* y = WSP(bf16_t, WS_YNSA) + row * DM + hq * 128;
            y[lane] = f2bf(g0 * oc[r * 128 + lane] + g1 * s0 + g2 * w0);
            y[lane + 64] = f2bf(g0 * oc[r * 128 + 64 + lane] + g1 * s1 + g2 * w1);
            __builtin_amdgcn_wave_barrier();
        }
    }
}
__device__ __forceinline__ void ph_route(const P& p, LAS unsigned char* lds, int bid, int nblk) {
    const int wid = threadIdx.x >> 6, lane = threadIdx.x & 63, gw = bid * NWAVES + wid, NGW = nblk * NWAVES;
    LAS float* uu = (LAS float*)lds + wid * 1024;
    for (int row = gw; row < NTOK; row += NGW) {
        const float* hr = WSP(float, WS_H1) + (size_t)row * DM; const float* mod = WSP(float, WS_MOD) + (row / SEQ) * 6144;
        float v[16]; float ss = 0.f;
#pragma unroll
        for (int i = 0; i < 16; ++i) { v[i] = hr[lane + 64 * i]; ss += v[i] * v[i]; }
        const float rstd = rsqrtf(wave_sum(ss) * (1.f / DM) + RMS_EPS);
        bf16_t* u = WSP(bf16_t, WS_U2) + (size_t)row * DM;
#pragma unroll
        for (int i = 0; i < 16; ++i) { const int col = lane + 64 * i; const float val = v[i] * rstd * p.norm2_g[col] * (1.f + mod[4096 + col]) + mod[3072 + col]; uu[col] = val; u[col] = f2bf(val); }
        __builtin_amdgcn_wave_barrier();
        const int e = lane & 31, kh = lane >> 5;
        float acc = 0.f;
        for (int k = kh * 512; k < kh * 512 + 512; ++k) acc += uu[k] * p.router_w[k * 32 + e];
        acc += __shfl_xor(acc, 32);
        const float logit = acc + p.router_b[e];
        int rank = 0;
        for (int j = 0; j < 32; ++j) { const float lj = __shfl(logit, j); rank += (lj > logit) || (lj == logit && j < e); }
        const float mx = wave_max(logit);
        const bool sel = rank < 4;
        const float ex = sel ? __expf(logit - mx) : 0.f;
        float sum = ex; for (int o = 1; o < 32; o <<= 1) sum += __shfl_xor(sum, o);
        if (sel && lane < 32) {
            WSP(int, WS_TOPE)[row * 4 + rank] = e; WSP(float, WS_TOPW)[row * 4 + rank] = ex / sum;
            atomicAdd(WSP(int, WS_CTL) + CT_CNT + e, 1);
        }
        __builtin_amdgcn_wave_barrier();
    }
}
__device__ __forceinline__ void ph_assign(const P& p, LAS unsigned char* lds, int bid, int nblk) {
    LAS int* pst = (LAS int*)lds;
    int* ctl = WSP(int, WS_CTL);
    if (threadIdx.x == 0) {
        int ps = 0;
        for (int e = 0; e < NEXP; ++e) { pst[e] = ps; const int nb = (ctl[CT_CNT + e] + MOEB - 1) / MOEB;
            if (bid == 0) for (int i = 0; i < nb; ++i) ctl[CT_BLKE + ps / MOEB + i] = e;
            ps += nb * MOEB; }
        pst[NEXP] = ps; if (bid == 0) ctl[CT_PTOT] = ps;
    }
    __syncthreads();
    const int wid = threadIdx.x >> 6, lane = threadIdx.x & 63, gw = bid * NWAVES + wid, NGW = nblk * NWAVES;
    for (int idx = gw; idx < NTOK * 4; idx += NGW) {
        const int e = WSP(int, WS_TOPE)[idx];
        int pos = 0;
        if (lane == 0) pos = pst[e] + atomicAdd(ctl + CT_FILL + e, 1);
        pos = __shfl(pos, 0);
        if (lane == 0) WSP(int, WS_SLOTOF)[idx] = pos;
        const u32x4* s = (const u32x4*)(WSP(bf16_t, WS_U2) + (size_t)(idx >> 2) * DM); u32x4* d = (u32x4*)(WSP(bf16_t, WS_XS) + (size_t)pos * DM);
        d[lane] = s[lane]; d[lane + 64] = s[lane + 64];
    }
}
__device__ __forceinline__ void ph_final(const P& p, int bid, int nblk) {
    const int lane = threadIdx.x & 63, gw = bid * NWAVES + (threadIdx.x >> 6), NGW = nblk * NWAVES;
    for (int row = gw; row < NTOK; row += NGW) {
        const float* hr = WSP(float, WS_H1) + (size_t)row * DM; const float* mod = WSP(float, WS_MOD) + (row / SEQ) * 6144;
        const int* so = WSP(int, WS_SLOTOF) + row * 4; const float* tw = WSP(float, WS_TOPW) + row * 4;
        const bf16_t* ys = WSP(bf16_t, WS_YSLOT);
        const int s0 = so[0], s1 = so[1], s2 = so[2], s3 = so[3]; const float w0 = tw[0], w1 = tw[1], w2 = tw[2], w3 = tw[3];
        float v[16]; float ss = 0.f;
#pragma unroll
        for (int i = 0; i < 16; ++i) {
            const int col = lane + 64 * i;
            const float m = w0 * bf2f(ys[(size_t)s0 * DM + col]) + w1 * bf2f(ys[(size_t)s1 * DM + col]) + w2 * bf2f(ys[(size_t)s2 * DM + col]) + w3 * bf2f(ys[(size_t)s3 * DM + col]);
            v[i] = hr[col] + mod[5120 + col] * m; ss += v[i] * v[i];
        }
        const float rstd = rsqrtf(wave_sum(ss) * (1.f / DM) + RMS_EPS);
#pragma unroll
        for (int i = 0; i < 16; ++i) { const int col = lane + 64 * i; p.out[(size_t)row * DM + col] = v[i] * rstd * p.final_g[col]; }
    }
}

enum { PH_MOD = 0, PH_U1, PH_INPROJ, PH_G3, PH_G4, PH_NSA, PH_MERGE, PH_OUT, PH_ROUTE, PH_ASSIGN, PH_MOE1, PH_MOE2, PH_FINAL, PH_END };
struct Args { P p; int ph_lo, ph_hi; };
__global__ void __launch_bounds__(NTHR, 2) mega(Args a) {
    extern __shared__ __attribute__((aligned(16))) unsigned char lds_raw[];
    LAS unsigned char* lds = (LAS unsigned char*)lds_raw;
    const P& p = a.p;
    const int bid = blockIdx.x, nblk = gridDim.x;
    volatile LAS unsigned* MISC = (volatile LAS unsigned*)(lds + LDS_MISC_OFF);
    for (int u = threadIdx.x; u < (MK_LDS_BYTES - LDS_MISC_OFF) / 4; u += NTHR) ((LAS unsigned*)(lds + LDS_MISC_OFF))[u] = 0u;
    __syncthreads();
    const bool multi = (a.ph_hi - a.ph_lo) > 1;
    XcdBarrier bar; bar.bar = WSP(unsigned, WS_CTL) + CW_BAR; bar.x = 0; bar.st = nullptr;
    if (multi) bar = xcd_barrier_post(WSP(unsigned, WS_CTL) + CW_BAR, MISC + 8);
#define IN(k) (a.ph_lo <= (k) && (k) < a.ph_hi)
#define SEAM(k) do { if (IN(k) && IN((k) + 1)) xcd_barrier(bar); } while (0)
    if (IN(PH_MOD)) { ph_mod(p, lds, bid, nblk); ph_convert(p, lds, bid, nblk); }
    SEAM(PH_MOD);
    if (IN(PH_U1)) ph_u1(p, bid, nblk);
    SEAM(PH_U1);
    if (IN(PH_INPROJ)) {
        pg8::Gemm g{WSP(bf16_t, WS_U1), WSP(bf16_t, WS_WINT), NTOK, PLD, 1024}; pg8::StaticOrder S; S.init(NTOK, PLD, nblk, bid);
        EpiProj E{WSP(bf16_t, WS_PROJ), PLD};
        pg8::gemm_phase<EpiProj, pg8::StaticOrder, true, true>(lds, g, S, E);
    }
    SEAM(PH_INPROJ);
    if (IN(PH_G3)) {
        ph_loga_naive(p, bid, nblk);
        for (int it = bid; it < 256; it += nblk) { const int which = it >> 7, rt = (it >> 2) & 31, ct = it & 3; sgemm_tile_dev<F_cmp1, false>(F_cmp1{4096, which}, p, rt * 64, ct * 64, (LAS float*)lds); }
    }
    SEAM(PH_G3);
    if (IN(PH_G4)) {
        for (int it = bid; it < 128; it += nblk) { const int which = it >> 6, rt = (it >> 1) & 31, ct = it & 1; sgemm_tile_dev<F_cmp2, false>(F_cmp2{256, which}, p, rt * 64, ct * 64, (LAS float*)lds); }
        ph_gla_naive(p, bid, nblk);
    }
    SEAM(PH_G4);
    if (IN(PH_NSA)) { ph_ygla_naive(p, bid, nblk); ph_nsa_naive(p, lds, bid, nblk); }
    SEAM(PH_NSA);
    if (IN(PH_MERGE)) {
        pg8::StaticOrder S; S.init(NTOK, 1024, nblk, bid);
        { pg8::Gemm g{WSP(bf16_t, WS_YGLA), WSP(bf16_t, WS_PGLAT), NTOK, 1024, 1024}; EpiMerge<1> E{WSP(bf16_t, WS_PROJ), WSP(bf16_t, WS_T1), WSP(bf16_t, WS_MERG)};
          pg8::gemm_phase<EpiMerge<1>, pg8::StaticOrder, true, true>(lds, g, S, E); }
        asm volatile("s_waitcnt vmcnt(0)" ::: "memory"); __syncthreads();
        { pg8::Gemm g{WSP(bf16_t, WS_YNSA), WSP(bf16_t, WS_PNSAT), NTOK, 1024, 1024}; EpiMerge<2> E{WSP(bf16_t, WS_PROJ), WSP(bf16_t, WS_T1), WSP(bf16_t, WS_MERG)};
          pg8::gemm_phase<EpiMerge<2>, pg8::StaticOrder, true, true>(lds, g, S, E); }
    }
    SEAM(PH_MERGE);
    if (IN(PH_OUT)) {
        pg8::Gemm g{WSP(bf16_t, WS_MERG), WSP(bf16_t, WS_WOUTT), NTOK, 1024, 1024}; pg8::StaticOrder S; S.init(NTOK, 1024, nblk, bid);
        EpiOut E{p.x, WSP(float, WS_MOD), WSP(float, WS_H1)};
        pg8::gemm_phase<EpiOut, pg8::StaticOrder, true, true>(lds, g, S, E);
    }
    SEAM(PH_OUT);
    if (IN(PH_ROUTE)) ph_route(p, lds, bid, nblk);
    SEAM(PH_ROUTE);
    if (IN(PH_ASSIGN)) ph_assign(p, lds, bid, nblk);
    SEAM(PH_ASSIGN);
    if (IN(PH_MOE1)) {
        const int* ctl = WSP(int, WS_CTL);
        pg8::Gemm g{WSP(bf16_t, WS_XS), WSP(bf16_t, WS_W1T), PROWS, 2048, 1024};
        MoeOrder S{ctl[CT_PTOT] / 256, 8, nblk, bid, ctl + CT_BLKE, (size_t)2048 * 1024 * 2};
        EpiSwiglu E{p.moe_b1, WSP(bf16_t, WS_ACT)};
        pg8::gemm_phase<EpiSwiglu, MoeOrder, true, true>(lds, g, S, E);
    }
    SEAM(PH_MOE1);
    if (IN(PH_MOE2)) {
        const int* ctl = WSP(int, WS_CTL);
        pg8::Gemm g{WSP(bf16_t, WS_ACT), WSP(bf16_t, WS_W2T), PROWS, 1024, 1024};
        MoeOrder S{ctl[CT_PTOT] / 256, 4, nblk, bid, ctl + CT_BLKE, (size_t)1024 * 1024 * 2};
        EpiMoe2 E{p.moe_b2, WSP(bf16_t, WS_YSLOT)};
        pg8::gemm_phase<EpiMoe2, MoeOrder, true, true>(lds, g, S, E);
    }
    SEAM(PH_MOE2);
    if (IN(PH_FINAL)) ph_final(p, bid, nblk);
#undef IN
#undef SEAM
}

extern "C" void kernel_launch(void* const* d_in, const int* in_sizes, int n_in, void* d_out, int out_size, void* d_ws, size_t ws_size, hipStream_t stream) {
    static bool attr_done = false;
    if (!attr_done) { (void)hipFuncSetAttribute((const void*)mega, hipFuncAttributeMaxDynamicSharedMemorySize, MK_LDS_BYTES); attr_done = true; }
    Args a{};
    const float** pp = (const float**)&a.p;
    for (int i = 0; i < 23; ++i) pp[i] = (const float*)d_in[i];
    a.p.out = (float*)d_out; a.p.ws = (unsigned char*)d_ws;
    (void)hipMemsetAsync((char*)d_ws + WS_CTL, 0, 65536, stream);
    a.ph_lo = 0; a.ph_hi = PH_END;
    hipLaunchKernelGGL(mega, dim3(256), dim3(NTHR), MK_LDS_BYTES, stream, a);
}
```

```cpp
#include <hip/hip_runtime.h>
#include <stdint.h>
#include <math.h>

typedef unsigned short bf16_t;
typedef unsigned long long u64;

constexpr int BATCH = 4, SEQ = 4096, DM = 1024, NTOK = BATCH * SEQ;
constexpr int IN_COLS = 7720, PLD = 7936;
constexpr int C_GQ = 0, C_GK = 512, C_GV = 1024, C_GR = 2048, C_NQ = 3072, C_KC = 4096, C_VC = 4352, C_KS = 4608, C_VS = 4864,
              C_KW = 5120, C_VW = 5376, C_MG = 5632, C_GA = 7680, C_NG = 7696;
constexpr int NCMP = 255, NSEL = 64, NEXP = 32, TOPK = 4, MOEB = 256;
constexpr int PROWS = NTOK * TOPK + NEXP * MOEB;
constexpr float RMS_EPS = 1e-5f;

__host__ __device__ inline int orig_col(int j) {
    if (j < 3072) return j;
    if (j < 5632) return j + 16;
    if (j < 7680) return j + 40;
    if (j < 7696) return j - 4608;
    return j - 2048;
}

constexpr size_t MiB = 1u << 20;
constexpr size_t WS_CTL = 0;
constexpr size_t WS_MOD = 1 * MiB;
constexpr size_t WS_W1T = 2 * MiB;
constexpr size_t WS_W2T = 130 * MiB;
constexpr size_t WS_WINT = 194 * MiB;
constexpr size_t WS_PGLAT = 210 * MiB, WS_PNSAT = 212 * MiB, WS_WOUTT = 214 * MiB;
constexpr size_t WS_CW1T = 216 * MiB;
constexpr size_t WS_CW2T = 220 * MiB;
constexpr size_t WS_H1 = 221 * MiB;
constexpr size_t WS_U2 = 285 * MiB;
constexpr size_t WS_TOPE = 317 * MiB;
constexpr size_t WS_TOPW = 317 * MiB + 512 * 1024;
constexpr size_t WS_ROWTOK = 318 * MiB;
constexpr size_t WS_SLOTOF = 318 * MiB + 512 * 1024;
constexpr size_t WS_U1 = 320 * MiB;
constexpr size_t WS_PROJ = 352 * MiB;
constexpr size_t WS_LOGA = 600 * MiB;
constexpr size_t WS_OGLA = 632 * MiB;
constexpr size_t WS_YGLA = 696 * MiB;
constexpr size_t WS_HID = 728 * MiB;
constexpr size_t WS_KCVC = 732 * MiB;
constexpr size_t WS_SELM = 734 * MiB;
constexpr size_t WS_OCMP = 735 * MiB;
constexpr size_t WS_OSEL = 799 * MiB;
constexpr size_t WS_OWIN = 863 * MiB;
constexpr size_t WS_YNSA = 927 * MiB;
constexpr size_t WS_MERG = 959 * MiB;
constexpr size_t WS_T1 = 991 * MiB;
constexpr size_t WS_TMPF = 600 * MiB;
constexpr size_t WS_XS = 320 * MiB;
constexpr size_t WS_ACT = 464 * MiB;
constexpr size_t WS_YSLOT = 608 * MiB;
constexpr int CT_CNT = 0, CT_FILL = 64, CT_PSTART = 128, CT_PTOT = 192, CT_BLKE = 256;

__device__ __forceinline__ float bf2f(bf16_t v) { return __uint_as_float(((unsigned)v) << 16); }
__device__ __forceinline__ bf16_t f2bf(float f) { unsigned u = __float_as_uint(f); return (bf16_t)((u + 0x7fffu + ((u >> 16) & 1u)) >> 16); }
__device__ __forceinline__ float sigmoidf_(float x) { return 1.f / (1.f + __expf(-x)); }
__device__ __forceinline__ float siluf_(float x) { return x / (1.f + __expf(-x)); }
__device__ __forceinline__ float wave_sum(float v) {
#pragma unroll
    for (int o = 1; o < 64; o <<= 1) v += __shfl_xor(v, o);
    return v;
}
__device__ __forceinline__ float wave_max(float v) {
#pragma unroll
    for (int o = 1; o < 64; o <<= 1) v = fmaxf(v, __shfl_xor(v, o));
    return v;
}

struct P {
    const float *x, *c, *w_ada, *b_ada, *norm1_g, *w_in, *gla_wa2, *gla_ba, *gla_norm_g, *cmp_pe, *cmp_w1, *cmp_w2, *proj_gla, *proj_nsa,
        *w_out, *norm2_g, *router_w, *router_b, *moe_w1, *moe_b1, *moe_w2, *moe_b2, *final_g;
    float* out;
    unsigned char* ws;
};
#define WSP(T, off) ((T*)(p.ws + (off)))

__global__ void __launch_bounds__(256) k_mod(P p) {
    __shared__ float sc[4 * 1024];
    for (int i = threadIdx.x; i < 4096; i += 256) sc[i] = siluf_(p.c[i]);
    __syncthreads();
    const int j = blockIdx.x * 256 + threadIdx.x;
    float a0 = 0, a1 = 0, a2 = 0, a3 = 0;
    for (int k = 0; k < 1024; ++k) { const float w = p.w_ada[(size_t)k * 6144 + j]; a0 += sc[k] * w; a1 += sc[1024 + k] * w; a2 += sc[2048 + k] * w; a3 += sc[3072 + k] * w; }
    float* mod = WSP(float, WS_MOD); const float bb = p.b_ada[j];
    mod[j] = a0 + bb; mod[6144 + j] = a1 + bb; mod[2 * 6144 + j] = a2 + bb; mod[3 * 6144 + j] = a3 + bb;
}

__global__ void __launch_bounds__(256) k_u1(P p) {
    const int row = blockIdx.x * 4 + (threadIdx.x >> 6), lane = threadIdx.x & 63, b = row / SEQ;
    const float* xr = p.x + (size_t)row * DM; const float* mod = WSP(float, WS_MOD) + b * 6144;
    float v[16]; float ss = 0.f;
#pragma unroll
    for (int i = 0; i < 16; ++i) { v[i] = xr[lane + 64 * i]; ss += v[i] * v[i]; }
    const float rstd = rsqrtf(wave_sum(ss) * (1.f / DM) + RMS_EPS);
    bf16_t* u = WSP(bf16_t, WS_U1) + (size_t)row * DM;
#pragma unroll
    for (int i = 0; i < 16; ++i) { const int col = lane + 64 * i; u[col] = f2bf(v[i] * rstd * p.norm1_g[col] * (1.f + mod[1024 + col]) + mod[col]); }
}

template <class F, bool DUAL>
__global__ void __launch_bounds__(256) sgemm_k(F f, P p) {
    __shared__ float As[16][68]; __shared__ float Bs[16][68]; __shared__ float Bs2[16][68];
    const int tid = threadIdx.x, tx = tid & 15, ty = tid >> 4;
    const int m0 = blockIdx.y * 64, n0 = blockIdx.x * 64;
    if (!f.init(p, m0)) return;
    float acc[4][4], acc2[4][4];
#pragma unroll
    for (int i = 0; i < 4; ++i)
#pragma unroll
        for (int j = 0; j < 4; ++j) { acc[i][j] = 0.f; acc2[i][j] = 0.f; }
    const int K = f.K;
    for (int k0 = 0; k0 < K; k0 += 16) {
        { const int r = tid >> 2, kq = (tid & 3) * 4;
#pragma unroll
          for (int i = 0; i < 4; ++i) As[kq + i][r] = f.a(p, m0 + r, k0 + kq + i); }
        { const int kk = tid >> 4, cc = (tid & 15) * 4;
#pragma unroll
          for (int i = 0; i < 4; ++i) { Bs[kk][cc + i] = f.b(p, k0 + kk, n0 + cc + i); if (DUAL) Bs2[kk][cc + i] = f.b2(p, k0 + kk, n0 + cc + i); } }
        __syncthreads();
#pragma unroll
        for (int kk = 0; kk < 16; ++kk) {
            float a[4], b[4], b2[4];
#pragma unroll
            for (int i = 0; i < 4; ++i) { a[i] = As[kk][ty * 4 + i]; b[i] = Bs[kk][tx * 4 + i]; b2[i] = DUAL ? Bs2[kk][tx * 4 + i] : 0.f; }
#pragma unroll
            for (int i = 0; i < 4; ++i)
#pragma unroll
                for (int j = 0; j < 4; ++j) { acc[i][j] += a[i] * b[j]; if (DUAL) acc2[i][j] += a[i] * b2[j]; }
        }
        __syncthreads();
    }
#pragma unroll
    for (int i = 0; i < 4; ++i)
#pragma unroll
        for (int j = 0; j < 4; ++j) f.store(p, m0 + ty * 4 + i, n0 + tx * 4 + j, acc[i][j], acc2[i][j]);
}

struct F_inproj {
    int K;
    __device__ bool init(const P&, int) { return true; }
    __device__ float a(const P& p, int r, int k) const { return bf2f(WSP(bf16_t, WS_U1)[(size_t)r * DM + k]); }
    __device__ float b(const P& p, int k, int c) const { return c < IN_COLS ? p.w_in[(size_t)k * IN_COLS + orig_col(c)] : 0.f; }
    __device__ float b2(const P&, int, int) const { return 0.f; }
    __device__ void store(const P& p, int r, int c, float v, float) const { WSP(bf16_t, WS_PROJ)[(size_t)r * PLD + c] = f2bf(v); }
};
__device__ __forceinline__ float gelu_tanh(float x) { const float u = 0.7978845608028654f * (x + 0.044715f * x * x * x); return 0.5f * x * (1.f + tanhf(u)); }
struct F_cmp1 {
    int K, which;
    __device__ bool init(const P&, int) { return true; }
    __device__ float a(const P& p, int r, int k) const {
        if (r >= 2040) return 0.f;
        const int b = r / 510, g = (r / 255) & 1, c = r % 255, l = k >> 7, d = k & 127;
        const size_t tok = (size_t)b * SEQ + 16 * c + l;
        return bf2f(WSP(bf16_t, WS_PROJ)[tok * PLD + (which ? C_VC : C_KC) + g * 128 + d]) + p.cmp_pe[(which * 32 + l) * 128 + d];
    }
    __device__ float b(const P& p, int k, int c) const { return p.cmp_w1[((size_t)which * 4096 + k) * 256 + c]; }
    __device__ float b2(const P&, int, int) const { return 0.f; }
    __device__ void store(const P& p, int r, int c, float v, float) const { if (r < 2040) WSP(float, WS_HID)[((size_t)which * 2040 + r) * 256 + c] = gelu_tanh(v); }
};
struct F_cmp2 {
    int K, which;
    __device__ bool init(const P&, int) { return true; }
    __device__ float a(const P& p, int r, int k) const { return r < 2040 ? WSP(float, WS_HID)[((size_t)which * 2040 + r) * 256 + k] : 0.f; }
    __device__ float b(const P& p, int k, int c) const { return p.cmp_w2[((size_t)which * 256 + k) * 128 + c]; }
    __device__ float b2(const P&, int, int) const { return 0.f; }
    __device__ void store(const P& p, int r, int c, float v, float) const {
        if (r >= 2040) return;
        const int b = r / 510, g = (r / 255) & 1, cc = r % 255;
        WSP(bf16_t, WS_KCVC)[((((size_t)which * 4 + b) * 2 + g) * 256 + cc) * 128 + c] = f2bf(v);
    }
};
struct F_merge1 {
    int K;
    __device__ bool init(const P&, int) { return true; }
    __device__ float a(const P& p, int r, int k) const { return bf2f(WSP(bf16_t, WS_YGLA)[(size_t)r * DM + k]); }
    __device__ float b(const P& p, int k, int c) const { return p.proj_gla[(size_t)k * DM + c]; }
    __device__ float b2(const P&, int, int) const { return 0.f; }
    __device__ void store(const P& p, int r, int c, float v, float) const {
        const float mg = sigmoidf_(bf2f(WSP(bf16_t, WS_PROJ)[(size_t)r * PLD + C_MG + c]));
        WSP(float, WS_TMPF)[(size_t)r * DM + c] = mg * v;
    }
};
struct F_merge2 {
    int K;
    __device__ bool init(const P&, int) { return true; }
    __device__ float a(const P& p, int r, int k) const { return bf2f(WSP(bf16_t, WS_YNSA)[(size_t)r * DM + k]); }
    __device__ float b(const P& p, int k, int c) const { return p.proj_nsa[(size_t)k * DM + c]; }
    __device__ float b2(const P&, int, int) const { return 0.f; }
    __device__ void store(const P& p, int r, int c, float v, float) const {
        const float mg = sigmoidf_(bf2f(WSP(bf16_t, WS_PROJ)[(size_t)r * PLD + C_MG + 1024 + c]));
        WSP(bf16_t, WS_MERG)[(size_t)r * DM + c] = f2bf(WSP(float, WS_TMPF)[(size_t)r * DM + c] + mg * v);
    }
};
struct F_out {
    int K;
    __device__ bool init(const P&, int) { return true; }
    __device__ float a(const P& p, int r, int k) const { return bf2f(WSP(bf16_t, WS_MERG)[(size_t)r * DM + k]); }
    __device__ float b(const P& p, int k, int c) const { return p.w_out[(size_t)k * DM + c]; }
    __device__ float b2(const P&, int, int) const { return 0.f; }
    __device__ void store(const P& p, int r, int c, float v, float) const {
        const int b = r / SEQ; const float gate1 = WSP(float, WS_MOD)[b * 6144 + 2048 + c];
        WSP(float, WS_H1)[(size_t)r * DM + c] = p.x[(size_t)r * DM + c] + gate1 * v;
    }
};
struct F_moe1 {
    int K; int e;
    __device__ bool init(const P& p, int m0) { const int* ctl = WSP(int, WS_CTL); if (m0 >= ctl[CT_PTOT]) return false; e = ctl[CT_BLKE + m0 / MOEB]; return true; }
    __device__ float a(const P& p, int r, int k) const { const int tok = WSP(int, WS_ROWTOK)[r]; return tok < 0 ? 0.f : bf2f(WSP(bf16_t, WS_U2)[(size_t)tok * DM + k]); }
    __device__ float b(const P& p, int k, int c) const { return p.moe_w1[((size_t)e * DM + k) * 2048 + c]; }
    __device__ float b2(const P& p, int k, int c) const { return p.moe_w1[((size_t)e * DM + k) * 2048 + 1024 + c]; }
    __device__ void store(const P& p, int r, int c, float g, float u) const {
        g += p.moe_b1[e * 2048 + c]; u += p.moe_b1[e * 2048 + 1024 + c];
        g = fminf(g, 7.f); u = fminf(fmaxf(u, -7.f), 7.f);
        WSP(bf16_t, WS_ACT)[(size_t)r * DM + c] = f2bf(g * sigmoidf_(1.702f * g) * (u + 1.f));
    }
};
struct F_moe2 {
    int K; int e;
    __device__ bool init(const P& p, int m0) { const int* ctl = WSP(int, WS_CTL); if (m0 >= ctl[CT_PTOT]) return false; e = ctl[CT_BLKE + m0 / MOEB]; return true; }
    __device__ float a(const P& p, int r, int k) const { return bf2f(WSP(bf16_t, WS_ACT)[(size_t)r * DM + k]); }
    __device__ float b(const P& p, int k, int c) const { return p.moe_w2[((size_t)e * DM + k) * DM + c]; }
    __device__ float b2(const P&, int, int) const { return 0.f; }
    __device__ void store(const P& p, int r, int c, float v, float) const { WSP(bf16_t, WS_YSLOT)[(size_t)r * DM + c] = f2bf(v + p.moe_b2[e * DM + c]); }
};

__global__ void __launch_bounds__(256) k_loga(P p) {
    const int row = blockIdx.x >> 1, j = (blockIdx.x & 1) * 256 + threadIdx.x;
    const bf16_t* pr = WSP(bf16_t, WS_PROJ) + (size_t)row * PLD + C_GA;
    float xx = p.gla_ba[j];
#pragma unroll
    for (int r = 0; r < 16; ++r) xx += bf2f(pr[r]) * p.gla_wa2[r * 512 + j];
    const float ls = fminf(xx, 0.f) - log1pf(__expf(-fabsf(xx)));
    WSP(float, WS_LOGA)[(size_t)row * 512 + j] = ls * (1.f / 16.f);
}
__global__ void __launch_bounds__(256) k_gla(P p) {
    const int blk = blockIdx.x, b = blk >> 6, h = (blk >> 4) & 3, vg = blk & 15;
    const int tid = threadIdx.x, vl = tid >> 4, kg = tid & 15;
    const int vcol = h * 256 + vg * 16 + vl;
    float S[8];
#pragma unroll
    for (int i = 0; i < 8; ++i) S[i] = 0.f;
    const bf16_t* proj = WSP(bf16_t, WS_PROJ); const float* loga = WSP(float, WS_LOGA); float* og = WSP(float, WS_OGLA);
    for (int t = 0; t < SEQ; ++t) {
        const size_t row = (size_t)b * SEQ + t;
        const bf16_t* pr = proj + row * PLD;
        const float vv = bf2f(pr[C_GV + vcol]);
        float part = 0.f;
#pragma unroll
        for (int i = 0; i < 8; ++i) {
            const int d = h * 128 + kg * 8 + i;
            const float a = __expf(loga[row * 512 + d]);
            S[i] = a * S[i] + bf2f(pr[C_GK + d]) * vv;
            part += bf2f(pr[C_GQ + d]) * S[i];
        }
        part += __shfl_xor(part, 1); part += __shfl_xor(part, 2); part += __shfl_xor(part, 4); part += __shfl_xor(part, 8);
        if (kg == 0) og[row * DM + vcol] = part * 0.08838834764831845f;
    }
}
__global__ void __launch_bounds__(256) k_ygla(P p) {
    const int w = blockIdx.x * 4 + (threadIdx.x >> 6), lane = threadIdx.x & 63, row = w >> 2, h = w & 3;
    const float* o = WSP(float, WS_OGLA) + (size_t)row * DM + h * 256;
    float v[4]; float ss = 0.f;
#pragma unroll
    for (int i = 0; i < 4; ++i) { v[i] = o[lane + 64 * i]; ss += v[i] * v[i]; }
    const float rstd = rsqrtf(wave_sum(ss) * (1.f / 256.f) + RMS_EPS);
    const bf16_t* pr = WSP(bf16_t, WS_PROJ) + (size_t)row * PLD + C_GR + h * 256;
    bf16_t* y = WSP(bf16_t, WS_YGLA) + (size_t)row * DM + h * 256;
#pragma unroll
    for (int i = 0; i < 4; ++i) { const int dv = lane + 64 * i; y[dv] = f2bf(v[i] * rstd * p.gla_norm_g[dv] * siluf_(bf2f(pr[dv]))); }
}

constexpr float ATT_SCALE = 0.08838834764831845f;
__global__ void __launch_bounds__(256) k_cmpattn(P p) {
    __shared__ float sq[4][128]; __shared__ float sp[4][256]; __shared__ float sps[4][256];
    const int wid = threadIdx.x >> 6, lane = threadIdx.x & 63;
    const int w = blockIdx.x * 4 + wid, b = w >> 13, g = (w >> 12) & 1, t = w & 4095;
    const size_t row = (size_t)b * SEQ + t;
    const bf16_t* pr = WSP(bf16_t, WS_PROJ) + row * PLD;
    const bf16_t* kc = WSP(bf16_t, WS_KCVC) + (((size_t)0 * 4 + b) * 2 + g) * 256 * 128;
    const bf16_t* vc = WSP(bf16_t, WS_KCVC) + (((size_t)1 * 4 + b) * 2 + g) * 256 * 128;
    const int ncv = t >= 31 ? (t - 31) / 16 + 1 : 0;
    float* q = sq[wid]; float* pp = sp[wid]; float* ps = sps[wid];
    for (int i = 0; i < 4; ++i) ps[lane + 64 * i] = 0.f;
    for (int r = 0; r < 4; ++r) {
        const int hq = g * 4 + r;
        q[lane] = bf2f(pr[C_NQ + hq * 128 + lane]); q[lane + 64] = bf2f(pr[C_NQ + hq * 128 + 64 + lane]);
        __builtin_amdgcn_wave_barrier();
        float s[4]; float m = -INFINITY;
        for (int i = 0; i < 4; ++i) {
            const int c = lane + 64 * i; s[i] = -INFINITY;
            if (c < ncv) { float a = 0.f; for (int d = 0; d < 128; ++d) a += q[d] * bf2f(kc[c * 128 + d]); s[i] = a * ATT_SCALE; }
            m = fmaxf(m, s[i]);
        }
        m = wave_max(m);
        float e[4]; float sum = 0.f;
        for (int i = 0; i < 4; ++i) { const int c = lane + 64 * i; e[i] = (c < ncv) ? __expf(s[i] - m) : 0.f; sum += e[i]; }
        sum = wave_sum(sum);
        const float inv = 1.f / fmaxf(sum, 1e-30f);
        for (int i = 0; i < 4; ++i) { const int c = lane + 64 * i; const float pv = e[i] * inv; pp[c] = pv; ps[c] += pv; }
        __builtin_amdgcn_wave_barrier();
        float o0 = 0.f, o1 = 0.f;
        for (int c = 0; c < ncv; ++c) { const float pv = pp[c]; o0 += pv * bf2f(vc[c * 128 + lane]); o1 += pv * bf2f(vc[c * 128 + 64 + lane]); }
        float* oc = WSP(float, WS_OCMP) + row * DM + hq * 128;
        oc[lane] = o0; oc[lane + 64] = o1;
        __builtin_amdgcn_wave_barrier();
    }
    const int s = lane, tb = t >> 6;
    float imp = 0.f;
    for (int c = 4 * s - 1; c <= 4 * s + 3; ++c) if (c >= 0 && c < NCMP) imp += ps[c];
    const bool forced = (s == 0) || (s == tb) || (s == tb - 1), valid = s <= tb;
    const float score = forced ? INFINITY : (valid ? imp : -INFINITY);
    int rank = 0;
    for (int j = 0; j < 64; ++j) { const float sj = __shfl(score, j); rank += (sj > score) || (sj == score && j < s); }
    const bool sel = rank < 16 && score > -INFINITY;
    const u64 mask = __ballot(sel);
    if (lane == 0) WSP(u64, WS_SELM)[(b * 2 + g) * SEQ + t] = mask;
}
template <bool WIN>
__global__ void __launch_bounds__(256) k_sparseattn(P p) {
    __shared__ float sq[4][128]; __shared__ float sp[4][1024];
    const int wid = threadIdx.x >> 6, lane = threadIdx.x & 63;
    const int w = blockIdx.x * 4 + wid, b = w >> 13, g = (w >> 12) & 1, t = w & 4095;
    const size_t row = (size_t)b * SEQ + t;
    const bf16_t* proj = WSP(bf16_t, WS_PROJ);
    const bf16_t* pr = proj + row * PLD;
    const int kcol = (WIN ? C_KW : C_KS) + g * 128, vcol = (WIN ? C_VW : C_VS) + g * 128;
    const u64 mask = WIN ? 0ull : WSP(u64, WS_SELM)[(b * 2 + g) * SEQ + t];
    const int nch = WIN ? 8 : __popcll(mask);
    int base[16];
    { u64 mm = mask;
#pragma unroll
      for (int jj = 0; jj < 16; ++jj) { if (WIN) base[jj] = t - 511 + jj * 64; else { const int bi = mm ? __ffsll((long long)mm) - 1 : 0; base[jj] = bi * 64; mm &= mm - 1; } } }
    float* q = sq[wid]; float* pp = sp[wid];
    for (int r = 0; r < 4; ++r) {
        const int hq = g * 4 + r;
        q[lane] = bf2f(pr[C_NQ + hq * 128 + lane]); q[lane + 64] = bf2f(pr[C_NQ + hq * 128 + 64 + lane]);
        __builtin_amdgcn_wave_barrier();
        float s[16]; float m = -INFINITY;
#pragma unroll
        for (int jj = 0; jj < 16; ++jj) {
            s[jj] = -INFINITY;
            if (jj < nch) { const int pos = base[jj] + lane;
                if (pos >= 0 && pos <= t) { const bf16_t* kr = proj + ((size_t)b * SEQ + pos) * PLD + kcol; float a = 0.f; for (int d = 0; d < 128; ++d) a += q[d] * bf2f(kr[d]); s[jj] = a * ATT_SCALE; } }
            m = fmaxf(m, s[jj]);
        }
        m = wave_max(m);
        float sum = 0.f;
#pragma unroll
        for (int jj = 0; jj < 16; ++jj) { s[jj] = (s[jj] > -INFINITY) ? __expf(s[jj] - m) : 0.f; sum += s[jj]; }
        sum = wave_sum(sum);
        const float inv = 1.f / fmaxf(sum, 1e-30f);
#pragma unroll
        for (int jj = 0; jj < 16; ++jj) pp[jj * 64 + lane] = s[jj] * inv;
        __builtin_amdgcn_wave_barrier();
        float o0 = 0.f, o1 = 0.f;
#pragma unroll
        for (int jj = 0; jj < 16; ++jj) {
            if (jj < nch) {
                for (int l = 0; l < 64; ++l) {
                    const float pv = pp[jj * 64 + l];
                    int pos = base[jj] + l; pos = pos < 0 ? 0 : (pos > SEQ - 1 ? SEQ - 1 : pos);
                    const bf16_t* vr = proj + ((size_t)b * SEQ + pos) * PLD + vcol;
                    o0 += pv * bf2f(vr[lane]); o1 += pv * bf2f(vr[64 + lane]);
                }
            }
        }
        float* oo = WSP(float, WIN ? WS_OWIN : WS_OSEL) + row * DM + hq * 128;
        oo[lane] = o0; oo[lane + 64] = o1;
        __builtin_amdgcn_wave_barrier();
    }
}
__global__ void __launch_bounds__(256) k_ynsa(P p) {
    const size_t idx = (size_t)blockIdx.x * 256 + threadIdx.x; const size_t row = idx >> 10; const int col = (int)(idx & 1023), hq = col >> 7;
    const bf16_t* pr = WSP(bf16_t, WS_PROJ) + row * PLD + C_NG + hq * 3;
    const float g0 = sigmoidf_(bf2f(pr[0])), g1 = sigmoidf_(bf2f(pr[1])), g2 = sigmoidf_(bf2f(pr[2]));
    WSP(bf16_t, WS_YNSA)[idx] = f2bf(g0 * WSP(float, WS_OCMP)[idx] + g1 * WSP(float, WS_OSEL)[idx] + g2 * WSP(float, WS_OWIN)[idx]);
}

__global__ void __launch_bounds__(256) k_route(P p) {
    __shared__ float su[4][1024];
    const int wid = threadIdx.x >> 6, lane = threadIdx.x & 63, row = blockIdx.x * 4 + wid, b = row / SEQ;
    const float* hr = WSP(float, WS_H1) + (size_t)row * DM; const float* mod = WSP(float, WS_MOD) + b * 6144;
    float v[16]; float ss = 0.f;
#pragma unroll
    for (int i = 0; i < 16; ++i) { v[i] = hr[lane + 64 * i]; ss += v[i] * v[i]; }
    const float rstd = rsqrtf(wave_sum(ss) * (1.f / DM) + RMS_EPS);
    bf16_t* u = WSP(bf16_t, WS_U2) + (size_t)row * DM; float* uu = su[wid];
#pragma unroll
    for (int i = 0; i < 16; ++i) { const int col = lane + 64 * i; const float val = v[i] * rstd * p.norm2_g[col] * (1.f + mod[4096 + col]) + mod[3072 + col]; uu[col] = val; u[col] = f2bf(val); }
    __builtin_amdgcn_wave_barrier();
    const int e = lane & 31, kh = lane >> 5;
    float acc = 0.f;
    for (int k = kh * 512; k < kh * 512 + 512; ++k) acc += uu[k] * p.router_w[k * 32 + e];
    acc += __shfl_xor(acc, 32);
    float logit = acc + p.router_b[e];
    int rank = 0;
    for (int j = 0; j < 32; ++j) { const float lj = __shfl(logit, j); rank += (lj > logit) || (lj == logit && j < e); }
    const float mx = wave_max(logit);
    const bool sel = rank < 4;
    const float ex = sel ? __expf(logit - mx) : 0.f;
    float sum = ex; for (int o = 1; o < 32; o <<= 1) sum += __shfl_xor(sum, o);
    if (sel && lane < 32) {
        WSP(int, WS_TOPE)[row * 4 + rank] = e; WSP(float, WS_TOPW)[row * 4 + rank] = ex / sum;
        atomicAdd(WSP(int, WS_CTL) + CT_CNT + e, 1);
    }
}
__global__ void k_offsets(P p) {
    if (threadIdx.x != 0) return;
    int* ctl = WSP(int, WS_CTL); int ps = 0;
    for (int e = 0; e < NEXP; ++e) { ctl[CT_PSTART + e] = ps; const int nb = (ctl[CT_CNT + e] + MOEB - 1) / MOEB; for (int i = 0; i < nb; ++i) ctl[CT_BLKE + ps / MOEB + i] = e; ps += nb * MOEB; }
    ctl[CT_PSTART + NEXP] = ps; ctl[CT_PTOT] = ps;
}
__global__ void __launch_bounds__(256) k_assign(P p) {
    const int idx = blockIdx.x * 256 + threadIdx.x;
    int* ctl = WSP(int, WS_CTL);
    const int e = WSP(int, WS_TOPE)[idx];
    const int pos = ctl[CT_PSTART + e] + atomicAdd(ctl + CT_FILL + e, 1);
    WSP(int, WS_ROWTOK)[pos] = idx >> 2; WSP(int, WS_SLOTOF)[idx] = pos;
}
__global__ void __launch_bounds__(256) k_final(P p) {
    const int row = blockIdx.x * 4 + (threadIdx.x >> 6), lane = threadIdx.x & 63, b = row / SEQ;
    const float* hr = WSP(float, WS_H1) + (size_t)row * DM; const float* mod = WSP(float, WS_MOD) + b * 6144;
    const int* so = WSP(int, WS_SLOTOF) + row * 4; const float* tw = WSP(float, WS_TOPW) + row * 4;
    const bf16_t* ys = WSP(bf16_t, WS_YSLOT);
    float v[16]; float ss = 0.f;
#pragma unroll
    for (int i = 0; i < 16; ++i) {
        const int col = lane + 64 * i; float m = 0.f;
        for (int k = 0; k < 4; ++k) m += tw[k] * bf2f(ys[(size_t)so[k] * DM + col]);
        v[i] = hr[col] + mod[5120 + col] * m; ss += v[i] * v[i];
    }
    const float rstd = rsqrtf(wave_sum(ss) * (1.f / DM) + RMS_EPS);
#pragma unroll
    for (int i = 0; i < 16; ++i) { const int col = lane + 64 * i; p.out[(size_t)row * DM + col] = v[i] * rstd * p.final_g[col]; }
}

namespace pg8 {
#define PG8_LAS __attribute__((address_space(3)))
typedef unsigned short bf16_t;
typedef short bf16x8 __attribute__((ext_vector_type(8)));
typedef float f32x4 __attribute__((ext_vector_type(4)));
typedef unsigned u32x4 __attribute__((ext_vector_type(4)));
constexpr int BM = 256, BK = 64, HALF = 128, HTB = HALF * BK * 2  , STAGE_BYTES = 8 * HTB, NXCD = 8, WGM = 8;

__host__ __device__ __forceinline__ int lds_byte(int r, int c) { const int st = (r >> 4) * 2 + (c >> 5), rr = r & 15, cc = c & 31, ob = rr * 64 + cc * 2; return st * 1024 + (ob ^ (((ob >> 9) & 1) << 5)); }
__host__ __device__ __forceinline__ void stage_rc(int b, int& R, int& C) { const int st = b / 1024, sb = b % 1024, swz = sb ^ (((sb >> 9) & 1) << 5); R = (st >> 1) * 16 + swz / 64; C = (st & 1) * 32 + (swz % 64) / 2; }
__host__ __device__ __forceinline__ int perm32(int rho) { const int n = rho >> 4, i = rho & 15; return 8 * (i >> 2) + 4 * n + (i & 3); }

struct Unit { int pm, pn, e; };
struct Gemm { const bf16_t* A; const bf16_t* Bt; int M, N, K; };

struct StaticOrder {
    int nM, nN, nwg, G, c;
    __host__ __device__ void init(int M, int N, int G_, int c_) { nM = M / BM; nN = N / BM; nwg = nM * nN; G = G_; c = c_; }
    __host__ __device__ bool next(int i, Unit& u) const {
        const long L = (long)i * G + c; if (L >= nwg) return false;
        int wgid = (int)L; { const int q = nwg / NXCD, r = nwg % NXCD, xcd = wgid % NXCD, off = wgid / NXCD; wgid = (xcd < r ? xcd * (q + 1) : r * (q + 1) + (xcd - r) * q) + off; }
        const int nig = WGM * nN, gid = wgid / nig, fm = gid * WGM, gsz = (nM - fm) < WGM ? (nM - fm) : WGM;
        u.pm = fm + ((wgid % nig) % gsz); u.pn = (wgid % nig) / gsz; u.e = 0; return true;
    }
    __device__ __forceinline__ void a_ready(const Unit&) const {}
    __device__ __forceinline__ void done(const Unit&) const {}
    __device__ __forceinline__ const char* abase(const Gemm& g, const Unit& u, size_t tstep) const { return (const char*)g.A + (size_t)u.pm * tstep; }
    __device__ __forceinline__ const char* bbase(const Gemm& g, const Unit& u, size_t tstep) const { return (const char*)g.Bt + (size_t)u.pn * tstep; }
};

template <class Epi, class Sched, bool ALIGN_EPI = false, bool SP2 = false>
__device__ __forceinline__ void gemm_phase(PG8_LAS unsigned char* lds, const Gemm g, const Sched& S, const Epi& E) {
    const int tid = threadIdx.x, wid = __builtin_amdgcn_readfirstlane(tid >> 6), lane = tid & 63, wr = wid >> 2, wc = wid & 3, fr = lane & 15, fq = lane >> 4;
    const int K = g.K, nt = K / BK;
    unsigned voffA[2], voffB[2];
#pragma unroll
    for (int i = 0; i < 2; ++i) { int R, C; stage_rc(tid * 16 + i * 8192, R, C); const int Rb = Epi::PERM ? ((R & ~31) + perm32(R & 31)) : R;
        voffA[i] = (unsigned)(R * K + C) * 2u; voffB[i] = (unsigned)(Rb * K + C) * 2u; }
    const size_t kstep = (size_t)(BK * 2);
    const size_t hstep = (size_t)HALF * K * 2;
    const size_t tstep = 2 * hstep;
    const unsigned ldsw = (unsigned)wid * 1024u;
    const int aoff = lds_byte(wr * 64 + fr, fq * 8), boff = lds_byte(wc * 32 + fr, fq * 8);
#define PG8_SA(b, h) (((b) * 2 + (h)) * HTB)
#define PG8_SB(b, h) ((4 + (b) * 2 + (h)) * HTB)
#define PG8_STAGE(bufoff, gbase, voff) do { _Pragma("unroll") for (int _i = 0; _i < 2; ++_i) \
        __builtin_amdgcn_global_load_lds((const unsigned*)((const char*)(gbase) + (voff)[_i]), (PG8_LAS unsigned*)(lds + (bufoff) + ldsw + _i * 8192), 16, 0, 0); } while (0)
#define PG8_LDA(dst, b, h) do { _Pragma("unroll") for (int m = 0; m < 4; ++m) _Pragma("unroll") for (int k = 0; k < 2; ++k) dst[m][k] = *(const PG8_LAS bf16x8*)(lds + PG8_SA(b, h) + aoff + m * 2048 + k * 1024); } while (0)
#define PG8_LDB(dst, b, h) do { _Pragma("unroll") for (int n = 0; n < 2; ++n) _Pragma("unroll") for (int k = 0; k < 2; ++k) dst[n][k] = *(const PG8_LAS bf16x8*)(lds + PG8_SB(b, h) + boff + n * 2048 + k * 1024); } while (0)
#define PG8_MMA(ai, bj, At, Bt) do { __builtin_amdgcn_s_setprio(1); _Pragma("unroll") for (int m = 0; m < 4; ++m) _Pragma("unroll") for (int n = 0; n < 2; ++n) _Pragma("unroll") for (int k = 0; k < 2; ++k) \
        acc[ai][bj][m][n] = __builtin_amdgcn_mfma_f32_16x16x32_bf16(Bt[n][k], At[m][k], acc[ai][bj][m][n], 0, 0, 0); __builtin_amdgcn_s_setprio(0); } while (0)
#define PG8_WAIT_V(n) asm volatile("s_waitcnt vmcnt(" #n ")" ::: "memory")
#define PG8_WAIT_L(n) asm volatile("s_waitcnt lgkmcnt(" #n ")" ::: "memory")
#define PG8_BAR __builtin_amdgcn_s_barrier()
#define PG8_SCHED __builtin_amdgcn_sched_barrier(0)
    Unit cur, nxt; int ui = 0;
    if (!S.next(0, cur)) return;
    f32x4 acc[2][2][4][2];
#pragma unroll
    for (int a = 0; a < 2; ++a)
#pragma unroll
        for (int b = 0; b < 2; ++b)
#pragma unroll
            for (int m = 0; m < 4; ++m)
#pragma unroll
                for (int n = 0; n < 2; ++n) acc[a][b][m][n] = (f32x4){0.f, 0.f, 0.f, 0.f};
    bf16x8 At[4][2], B0[2][2], B1[2][2];
    const char* cA = S.abase(g, cur, tstep); const char* cB = S.bbase(g, cur, tstep);
    S.a_ready(cur);
    if constexpr (SP2) {
        PG8_STAGE(PG8_SB(0, 0), cB, voffB); PG8_STAGE(PG8_SB(0, 1), cB + hstep, voffB); PG8_STAGE(PG8_SA(0, 0), cA, voffA); PG8_STAGE(PG8_SA(0, 1), cA + hstep, voffA);
        if (wr == 1) PG8_BAR;
        PG8_WAIT_V(2); PG8_BAR;
        PG8_STAGE(PG8_SB(1, 0), cB + kstep, voffB); PG8_STAGE(PG8_SA(1, 0), cA + kstep, voffA); PG8_STAGE(PG8_SB(1, 1), cB + hstep + kstep, voffB);
        PG8_WAIT_V(6); PG8_BAR;
    } else {
        PG8_STAGE(PG8_SB(0, 0), cB, voffB); PG8_STAGE(PG8_SA(0, 0), cA, voffA); PG8_STAGE(PG8_SB(0, 1), cB + hstep, voffB); PG8_STAGE(PG8_SA(0, 1), cA + hstep, voffA);
        if (wr == 1) PG8_BAR;
        PG8_WAIT_V(4); PG8_BAR;
        PG8_STAGE(PG8_SB(1, 0), cB + kstep, voffB); PG8_STAGE(PG8_SA(1, 0), cA + kstep, voffA); PG8_STAGE(PG8_SB(1, 1), cB + hstep + kstep, voffB);
        PG8_WAIT_V(6); PG8_BAR;
    }
    for (;;) {
        const bool has_next = S.next(ui + 1, nxt);
        const char* nA = has_next ? S.abase(g, nxt, tstep) : cA; const char* nB = has_next ? S.bbase(g, nxt, tstep) : cB;
        for (int t = 0; t < nt; t += 2) {
            const bool last = (t == nt - 2);
            const char* a1 = cA + (size_t)(t + 1) * kstep;
            const char* a2 = last ? nA : cA + (size_t)(t + 2) * kstep; const char* b2 = last ? nB : cB + (size_t)(t + 2) * kstep;
            const char* a3 = a2 + kstep; const char* b3 = b2 + kstep;
            if (last && has_next) S.a_ready(nxt);
            if constexpr (SP2) {
            PG8_LDB(B0, 0, 0); PG8_LDB(B1, 0, 1); PG8_SCHED; PG8_LDA(At, 0, 0); PG8_STAGE(PG8_SA(1, 1), a1 + hstep, voffA);
            PG8_WAIT_V(8); PG8_WAIT_L(0); PG8_BAR; PG8_MMA(0, 0, At, B0); PG8_MMA(0, 1, At, B1); PG8_BAR; PG8_SCHED;
            PG8_LDA(At, 0, 1); PG8_STAGE(PG8_SB(0, 0), b2, voffB); PG8_STAGE(PG8_SB(0, 1), b2 + hstep, voffB); PG8_STAGE(PG8_SA(0, 0), a2, voffA);
            PG8_WAIT_V(8); PG8_WAIT_L(0); PG8_BAR; PG8_MMA(1, 0, At, B0); PG8_MMA(1, 1, At, B1); PG8_BAR; PG8_SCHED;
            PG8_LDB(B0, 1, 0); PG8_LDB(B1, 1, 1); PG8_SCHED; PG8_LDA(At, 1, 0); PG8_STAGE(PG8_SA(0, 1), a2 + hstep, voffA);
            PG8_WAIT_V(8); PG8_WAIT_L(0); PG8_BAR; PG8_MMA(0, 0, At, B0); PG8_MMA(0, 1, At, B1); PG8_BAR; PG8_SCHED;
            PG8_LDA(At, 1, 1); PG8_STAGE(PG8_SB(1, 0), b3, voffB); PG8_STAGE(PG8_SB(1, 1), b3 + hstep, voffB); PG8_STAGE(PG8_SA(1, 0), a3, voffA);
            PG8_WAIT_V(8); PG8_WAIT_L(0); PG8_BAR; PG8_MMA(1, 0, At, B0); PG8_MMA(1, 1, At, B1); PG8_BAR; PG8_SCHED;
            } else {
            PG8_LDB(B0, 0, 0); PG8_SCHED; PG8_LDA(At, 0, 0); PG8_STAGE(PG8_SA(1, 1), a1 + hstep, voffA);
            PG8_WAIT_L(8); PG8_BAR; PG8_WAIT_L(0); PG8_MMA(0, 0, At, B0); PG8_BAR; PG8_SCHED;
            PG8_LDB(B1, 0, 1); PG8_STAGE(PG8_SB(0, 0), b2, voffB);
            PG8_BAR; PG8_WAIT_L(0); PG8_MMA(0, 1, At, B1); PG8_BAR;
            PG8_LDA(At, 0, 1); PG8_STAGE(PG8_SA(0, 0), a2, voffA);
            PG8_BAR; PG8_WAIT_L(0); PG8_MMA(1, 0, At, B0); PG8_BAR; PG8_SCHED;
            PG8_STAGE(PG8_SB(0, 1), b2 + hstep, voffB);
            PG8_WAIT_V(6); PG8_BAR; PG8_MMA(1, 1, At, B1); PG8_BAR;
            PG8_LDB(B0, 1, 0); PG8_SCHED; PG8_LDA(At, 1, 0); PG8_STAGE(PG8_SA(0, 1), a2 + hstep, voffA);
            PG8_WAIT_L(8); PG8_BAR; PG8_WAIT_L(0); PG8_MMA(0, 0, At, B0); PG8_BAR; PG8_SCHED;
            PG8_LDB(B1, 1, 1); PG8_STAGE(PG8_SB(1, 0), b3, voffB);
            PG8_BAR; PG8_WAIT_L(0); PG8_MMA(0, 1, At, B1); PG8_BAR;
            PG8_LDA(At, 1, 1); PG8_STAGE(PG8_SA(1, 0), a3, voffA);
            PG8_BAR; PG8_WAIT_L(0); PG8_MMA(1, 0, At, B0); PG8_BAR; PG8_SCHED;
            PG8_STAGE(PG8_SB(1, 1), b3 + hstep, voffB);
            PG8_WAIT_V(6); PG8_BAR; PG8_MMA(1, 1, At, B1); PG8_BAR;
            }
        }
        if constexpr (ALIGN_EPI) { if (wr == 0) PG8_BAR; }
        if constexpr (!Epi::AFTER_DRAIN) { E(acc, cur, wr, wc, fr, fq); S.done(cur); }
        if (!has_next) break;
#pragma unroll
        for (int a = 0; a < 2; ++a)
#pragma unroll
            for (int b = 0; b < 2; ++b)
#pragma unroll
                for (int m = 0; m < 4; ++m)
#pragma unroll
                    for (int n = 0; n < 2; ++n) acc[a][b][m][n] = (f32x4){0.f, 0.f, 0.f, 0.f};
        cur = nxt; cA = nA; cB = nB; ++ui;
        if constexpr (ALIGN_EPI) { if (wr == 1) PG8_BAR; }
    }
    PG8_WAIT_V(0);
    if constexpr (!ALIGN_EPI) { if (wr == 0) PG8_BAR; }
    PG8_BAR;
    if constexpr (Epi::AFTER_DRAIN) { E.fused(acc, cur, wr, wc, fr, fq, lds, wid, lane); S.done(cur); }
#undef PG8_SA
#undef PG8_SB
#undef PG8_STAGE
#undef PG8_LDA
#undef PG8_LDB
#undef PG8_MMA
#undef PG8_WAIT_V
#undef PG8_WAIT_L
#undef PG8_BAR
#undef PG8_SCHED
}
}

#define LAS __attribute__((address_space(3)))
#define GAS __attribute__((address_space(1)))
typedef float f32x4 __attribute__((ext_vector_type(4)));
typedef unsigned u32x4 __attribute__((ext_vector_type(4)));
typedef unsigned u32x2 __attribute__((ext_vector_type(2)));
typedef short bf16x8 __attribute__((ext_vector_type(8)));
constexpr int NTHR = 512, NWAVES = 8;
constexpr int MK_LDS_BYTES = 147456;
constexpr int LDS_MISC_OFF = 131072;

__device__ __forceinline__ unsigned cvt_pk_bf16(float lo, float hi) { unsigned r; asm volatile("v_cvt_pk_bf16_f32 %0, %1, %2" : "=v"(r) : "v"(lo), "v"(hi)); return r; }

struct EpiProj {
    static constexpr bool PERM = true, AFTER_DRAIN = false;
    bf16_t* O; int ldc;
    __device__ __forceinline__ void operator()(const pg8::f32x4 (&acc)[2][2][4][2], const pg8::Unit& u, int wr, int wc, int fr, int fq) const {
        const int row0 = u.pm * 256 + wr * 64 + fr, col0 = u.pn * 256 + wc * 32 + 8 * fq;
#pragma unroll
        for (int ai = 0; ai < 2; ++ai)
#pragma unroll
            for (int m = 0; m < 4; ++m) { bf16_t* rowp = O + (size_t)(row0 + ai * 128 + m * 16) * ldc + col0;
#pragma unroll
                for (int bj = 0; bj < 2; ++bj) { const pg8::f32x4 v0 = acc[ai][bj][m][0], v1 = acc[ai][bj][m][1];
                    u32x4 w; w.x = cvt_pk_bf16(v0[0], v0[1]); w.y = cvt_pk_bf16(v0[2], v0[3]); w.z = cvt_pk_bf16(v1[0], v1[1]); w.w = cvt_pk_bf16(v1[2], v1[3]);
                    *(u32x4*)(rowp + bj * 128) = w; } }
    }
};
__device__ __forceinline__ float bflo(unsigned w) { return __uint_as_float(w << 16); }
__device__ __forceinline__ float bfhi(unsigned w) { return __uint_as_float(w & 0xffff0000u); }
template <int STEP> struct EpiMerge {
    static constexpr bool PERM = true, AFTER_DRAIN = false;
    const bf16_t* proj; bf16_t* T1; bf16_t* MG;
    __device__ __forceinline__ void operator()(const pg8::f32x4 (&acc)[2][2][4][2], const pg8::Unit& u, int wr, int wc, int fr, int fq) const {
        const int row0 = u.pm * 256 + wr * 64 + fr, col0 = u.pn * 256 + wc * 32 + 8 * fq;
#pragma unroll
        for (int ai = 0; ai < 2; ++ai)
#pragma unroll
            for (int m = 0; m < 4; ++m) { const size_t row = (size_t)(row0 + ai * 128 + m * 16);
#pragma unroll
                for (int bj = 0; bj < 2; ++bj) { const int col = col0 + bj * 128;
                    const u32x4 g = *(const u32x4*)(proj + row * PLD + C_MG + (STEP == 2 ? 1024 : 0) + col);
                    const pg8::f32x4 v0 = acc[ai][bj][m][0], v1 = acc[ai][bj][m][1];
                    float r[8];
                    r[0] = sigmoidf_(bflo(g.x)) * v0[0]; r[1] = sigmoidf_(bfhi(g.x)) * v0[1]; r[2] = sigmoidf_(bflo(g.y)) * v0[2]; r[3] = sigmoidf_(bfhi(g.y)) * v0[3];
                    r[4] = sigmoidf_(bflo(g.z)) * v1[0]; r[5] = sigmoidf_(bfhi(g.z)) * v1[1]; r[6] = sigmoidf_(bflo(g.w)) * v1[2]; r[7] = sigmoidf_(bfhi(g.w)) * v1[3];
                    if (STEP == 2) { const u32x4 t = *(const u32x4*)(T1 + row * DM + col);
                        r[0] += bflo(t.x); r[1] += bfhi(t.x); r[2] += bflo(t.y); r[3] += bfhi(t.y); r[4] += bflo(t.z); r[5] += bfhi(t.z); r[6] += bflo(t.w); r[7] += bfhi(t.w); }
                    u32x4 w; w.x = cvt_pk_bf16(r[0], r[1]); w.y = cvt_pk_bf16(r[2], r[3]); w.z = cvt_pk_bf16(r[4], r[5]); w.w = cvt_pk_bf16(r[6], r[7]);
                    *(u32x4*)((STEP == 2 ? MG : T1) + row * DM + col) = w; } }
    }
};
struct EpiOut {
    static constexpr bool PERM = false, AFTER_DRAIN = false;
    const float* x; const float* mod; float* h1;
    __device__ __forceinline__ void operator()(const pg8::f32x4 (&acc)[2][2][4][2], const pg8::Unit& u, int wr, int wc, int fr, int fq) const {
        const int row0 = u.pm * 256 + wr * 64 + fr, col0 = u.pn * 256 + wc * 32 + 4 * fq;
        const float* gate = mod + (u.pm * 256 / SEQ) * 6144 + 2048;
#pragma unroll
        for (int bj = 0; bj < 2; ++bj)
#pragma unroll
            for (int n = 0; n < 2; ++n) { const int col = col0 + bj * 128 + n * 16; const pg8::f32x4 gv = *(const pg8::f32x4*)(gate + col);
#pragma unroll
                for (int ai = 0; ai < 2; ++ai)
#pragma unroll
                    for (int m = 0; m < 4; ++m) { const size_t off = (size_t)(row0 + ai * 128 + m * 16) * DM + col;
                        const pg8::f32x4 xv = *(const pg8::f32x4*)(x + off); *(pg8::f32x4*)(h1 + off) = xv + gv * acc[ai][bj][m][n]; } }
    }
};
struct EpiSwiglu {
    static constexpr bool PERM = true, AFTER_DRAIN = false;
    const float* b1; bf16_t* act;
    __device__ __forceinline__ void operator()(const pg8::f32x4 (&acc)[2][2][4][2], const pg8::Unit& u, int wr, int wc, int fr, int fq) const {
        const int row0 = u.pm * 256 + wr * 64 + fr, col0 = u.pn * 128 + wc * 32 + 8 * fq;
        const float* bg = b1 + u.e * 2048 + col0; const float* bu = bg + 1024;
        float gb[8], ub[8];
#pragma unroll
        for (int j = 0; j < 8; ++j) { gb[j] = bg[j]; ub[j] = bu[j]; }
#pragma unroll
        for (int ai = 0; ai < 2; ++ai)
#pragma unroll
            for (int m = 0; m < 4; ++m) { float r[8];
#pragma unroll
                for (int j = 0; j < 8; ++j) { float g = acc[ai][0][m][j >> 2][j & 3] + gb[j], uu = acc[ai][1][m][j >> 2][j & 3] + ub[j];
                    g = fminf(g, 7.f); uu = fminf(fmaxf(uu, -7.f), 7.f); r[j] = g * sigmoidf_(1.702f * g) * (uu + 1.f); }
                u32x4 w; w.x = cvt_pk_bf16(r[0], r[1]); w.y = cvt_pk_bf16(r[2], r[3]); w.z = cvt_pk_bf16(r[4], r[5]); w.w = cvt_pk_bf16(r[6], r[7]);
                *(u32x4*)(act + (size_t)(row0 + ai * 128 + m * 16) * DM + col0) = w; }
    }
};
struct EpiMoe2 {
    static constexpr bool PERM = true, AFTER_DRAIN = false;
    const float* b2; bf16_t* ys;
    __device__ __forceinline__ void operator()(const pg8::f32x4 (&acc)[2][2][4][2], const pg8::Unit& u, int wr, int wc, int fr, int fq) const {
        const int row0 = u.pm * 256 + wr * 64 + fr, col0 = u.pn * 256 + wc * 32 + 8 * fq;
#pragma unroll
        for (int bj = 0; bj < 2; ++bj) { const float* bb = b2 + u.e * 1024 + col0 + bj * 128; float bv[8];
#pragma unroll
            for (int j = 0; j < 8; ++j) bv[j] = bb[j];
#pragma unroll
            for (int ai = 0; ai < 2; ++ai)
#pragma unroll
                for (int m = 0; m < 4; ++m) { const pg8::f32x4 v0 = acc[ai][bj][m][0], v1 = acc[ai][bj][m][1];
                    u32x4 w; w.x = cvt_pk_bf16(v0[0] + bv[0], v0[1] + bv[1]); w.y = cvt_pk_bf16(v0[2] + bv[2], v0[3] + bv[3]); w.z = cvt_pk_bf16(v1[0] + bv[4], v1[1] + bv[5]); w.w = cvt_pk_bf16(v1[2] + bv[6], v1[3] + bv[7]);
                    *(u32x4*)(ys + (size_t)(row0 + ai * 128 + m * 16) * DM + col0 + bj * 128) = w; } }
    }
};
struct MoeOrder {
    int ntile, nN, G, c; const int* blk_e; size_t estride;
    __device__ __forceinline__ bool next(int i, pg8::Unit& u) const { const int L = i * G + c; if (L >= ntile * nN) return false; u.pm = L / nN; u.pn = L % nN; u.e = blk_e[u.pm]; return true; }
    __device__ __forceinline__ void a_ready(const pg8::Unit&) const {}
    __device__ __forceinline__ void done(const pg8::Unit&) const {}
    __device__ __forceinline__ const char* abase(const pg8::Gemm& g, const pg8::Unit& u, size_t tstep) const { return (const char*)g.A + (size_t)u.pm * tstep; }
    __device__ __forceinline__ const char* bbase(const pg8::Gemm& g, const pg8::Unit& u, size_t tstep) const { return (const char*)g.Bt + (size_t)u.e * estride + (size_t)u.pn * tstep; }
};

constexpr int CW_BAR = 4096;
#define XB_TMO      128
#define XB_XCNT(j)  (256  + 64 * (j))
#define XB_XSUB(j)  (1280 + 64 * (j))
#define XB_XGEN(j)  (2304 + 64 * (j))
#define XB_TOP      3328
#define XB_TOPGEN   3392
#define XCD_BAR_WORDS 3456
#define XB_SPIN_CAP (1u << 18)
__device__ __forceinline__ unsigned xb_ld(unsigned* p)              { return __hip_atomic_load(p, __ATOMIC_RELAXED, __HIP_MEMORY_SCOPE_AGENT); }
__device__ __forceinline__ unsigned xb_add(unsigned* p, unsigned v) { return __hip_atomic_fetch_add(p, v, __ATOMIC_RELAXED, __HIP_MEMORY_SCOPE_AGENT); }
__device__ __forceinline__ unsigned xb_xcc_id() { return (unsigned)__builtin_amdgcn_s_getreg((3 << 11) | 20) & 0xFu; }
#define XB_SPIN(cond, bar) do { unsigned _sp = 0; while (cond) { __builtin_amdgcn_s_sleep(1); \
    if ((++_sp & 255u) == 0u) { if (xb_ld(&(bar)[XB_TMO])) break; if (_sp > XB_SPIN_CAP) { atomicAdd(&(bar)[XB_TMO], 1u); break; } } } } while (0)
struct XcdBarrier { unsigned* bar; unsigned x; volatile LAS unsigned* st; };
__device__ __forceinline__ XcdBarrier xcd_barrier_post(unsigned* bar, volatile LAS unsigned* st) {
    XcdBarrier b; b.bar = bar; b.x = xb_xcc_id(); b.st = st;
    if (threadIdx.x == 0) (void)xb_add(&bar[XB_XCNT(b.x)], 1u);
    return b;
}
__device__ __forceinline__ void xcd_barrier_complete(unsigned* bar, unsigned x, unsigned& nloc, unsigned& nx) {
    const unsigned G = gridDim.x * gridDim.y * gridDim.z;
    unsigned sum, cnt, mine, sp = 0u;
    for (;;) {
        sum = 0u; cnt = 0u; mine = 0u;
#pragma unroll
        for (unsigned j = 0; j < 16; ++j) { const unsigned c = xb_ld(&bar[XB_XCNT(j)]); sum += c; cnt += (c > 0u) ? 1u : 0u; mine = (j == x) ? c : mine; }
        if (sum == G) break;
        __builtin_amdgcn_s_sleep(1);
        if ((++sp & 255u) == 0u) { if (xb_ld(&bar[XB_TMO])) break; if (sp > XB_SPIN_CAP) { atomicAdd(&bar[XB_TMO], 1u); break; } }
    }
    nloc = mine > 0u ? mine : 1u; nx = cnt > 0u ? cnt : 1u;
}
__device__ __forceinline__ void xcd_barrier(const XcdBarrier& b) {
    asm volatile("s_waitcnt vmcnt(0)" ::: "memory");
    __syncthreads();
    if (threadIdx.x == 0) {
        unsigned* bar = b.bar;
        __builtin_amdgcn_s_waitcnt(0);
        unsigned nloc = b.st[0], nx = b.st[1];
        if (nloc == 0u) { xcd_barrier_complete(bar, b.x, nloc, nx); b.st[0] = nloc; b.st[1] = nx; }
        const unsigned old = xb_add(&bar[XB_XSUB(b.x)], 1u);
        const unsigned gen = old / nloc;
        if (old + 1u == (gen + 1u) * nloc) {
            __builtin_amdgcn_fence(__ATOMIC_RELEASE, "agent");
            asm volatile("s_waitcnt vmcnt(0)" ::: "memory");
            const unsigned og = xb_add(&bar[XB_TOP], 1u);
            const unsigned tg = og / nx;
            if (og + 1u == (tg + 1u) * nx) xb_add(&bar[XB_TOPGEN], 1u);
            else XB_SPIN(xb_ld(&bar[XB_TOPGEN]) == tg, bar);
            __builtin_amdgcn_fence(__ATOMIC_ACQUIRE, "agent");
            xb_add(&bar[XB_XGEN(b.x)], 1u);
            asm volatile("s_waitcnt vmcnt(0)" ::: "memory");
        } else {
            XB_SPIN(xb_ld(&bar[XB_XGEN(b.x)]) == gen, bar);
            __builtin_amdgcn_fence(__ATOMIC_ACQUIRE, "agent");
            asm volatile("s_waitcnt vmcnt(0)" ::: "memory");
        }
    }
    __syncthreads();
}

__device__ __forceinline__ void ph_mod(const P& p, LAS unsigned char* lds, int bid, int nblk) {
    LAS float* sc = (LAS float*)lds;
    LAS float* red = (LAS float*)(lds + 16384);
    const int tid = threadIdx.x;
    for (int i = tid; i < 4096; i += NTHR) sc[i] = siluf_(p.c[i]);
    __syncthreads();
    for (int cb = bid; cb < 256; cb += nblk) {
        const int cq = tid % 6, kr = tid / 6;
        float acc[4][4];
#pragma unroll
        for (int b = 0; b < 4; ++b)
#pragma unroll
            for (int j = 0; j < 4; ++j) acc[b][j] = 0.f;
        if (kr < 85)
            for (int k = kr; k < 1024; k += 85) {
                const f32x4 w = *(const f32x4*)(p.w_ada + (size_t)k * 6144 + cb * 24 + cq * 4);
#pragma unroll
                for (int b = 0; b < 4; ++b) { const float s = sc[b * 1024 + k]; acc[b][0] += s * w[0]; acc[b][1] += s * w[1]; acc[b][2] += s * w[2]; acc[b][3] += s * w[3]; }
            }
#pragma unroll
        for (int b = 0; b < 4; ++b)
#pragma unroll
            for (int j = 0; j < 4; ++j) red[tid * 16 + b * 4 + j] = acc[b][j];
        __syncthreads();
        if (tid < 96) {
            const int b = tid / 24, col = tid % 24, q = col >> 2, j = col & 3; float s = 0.f;
            for (int r = 0; r < 85; ++r) s += red[(r * 6 + q) * 16 + b * 4 + j];
            WSP(float, WS_MOD)[b * 6144 + cb * 24 + col] = s + p.b_ada[cb * 24 + col];
        }
        __syncthreads();
    }
}
template <class RowMap>
__device__ __forceinline__ void conv_tile(const float* src, int ldw, int k0, int n0, int N, bf16_t* dst, int dK, const RowMap& rowmap, LAS float* T) {
    const int tid = threadIdx.x, wid = tid >> 6, lane = tid & 63;
#pragma unroll
    for (int r = 0; r < 8; ++r) {
        const int k = 8 * wid + r, n = 4 * lane;
        f32x4 v = (f32x4){0.f, 0.f, 0.f, 0.f};
        if (n0 + n < N) v = *(const f32x4*)(src + (size_t)(k0 + k) * ldw + n0 + n);
        *(LAS f32x4*)(T + k * 260 + (n ^ (wid << 2))) = v;
    }
    __syncthreads();
    const int c = tid & 7;
#pragma unroll
    for (int pass = 0; pass < 4; ++pass) {
        const int n = (tid >> 3) + 64 * pass;
        if (n0 + n < N) {
            float f[8];
#pragma unroll
            for (int i = 0; i < 8; ++i) f[i] = T[(8 * c + i) * 260 + (n ^ (c << 2))];
            u32x4 w; w.x = cvt_pk_bf16(f[0], f[1]); w.y = cvt_pk_bf16(f[2], f[3]); w.z = cvt_pk_bf16(f[4], f[5]); w.w = cvt_pk_bf16(f[6], f[7]);
            *(u32x4*)(dst + (size_t)rowmap(n0 + n) * dK + k0 + 8 * c) = w;
        }
    }
    __syncthreads();
}
struct RowId { __device__ __forceinline__ int operator()(int n) const { return n; } };
struct RowWin { __device__ __forceinline__ int operator()(int n) const {
    if (n < 3072) return n; if (n < 3088) return n + 4608; if (n < 5648) return n - 16; if (n < 5672) return n + 2048; return n - 40; } };
struct RowW1 { __device__ __forceinline__ int operator()(int n) const { const int h = n >> 10, r = n & 1023; return (r >> 7) * 256 + h * 128 + (r & 127); } };
struct RowOff { int off; __device__ __forceinline__ int operator()(int n) const { return n + off; } };
__device__ __forceinline__ void ph_convert(const P& p, LAS unsigned char* lds, int bid, int nblk) {
    LAS float* T = (LAS float*)lds;
    constexpr int I_WIN = 16 * 31, I_SQ = 16 * 4, I_W1 = 32 * 128, I_W2 = 32 * 64, I_C1 = 2 * 2 * 32, I_C2 = 2 * 4;
    constexpr int NITEMS = I_WIN + 3 * I_SQ + I_W1 + I_W2 + I_C1 + I_C2 + 1;
    for (int it = bid; it < NITEMS; it += nblk) {
        int r = it;
        if (r < I_W1) { const int e = r >> 7, t = r & 127, kt = t >> 3, ntile = t & 7;
            conv_tile(p.moe_w1 + (size_t)e * 1024 * 2048, 2048, kt * 64, ntile * 256, 2048, WSP(bf16_t, WS_W1T) + (size_t)e * 2048 * 1024, 1024, RowW1{}, T); continue; } r -= I_W1;
        if (r < I_W2) { const int e = r >> 6, t = r & 63, kt = t >> 2, ntile = t & 3;
            conv_tile(p.moe_w2 + (size_t)e * 1024 * 1024, 1024, kt * 64, ntile * 256, 1024, WSP(bf16_t, WS_W2T) + (size_t)e * 1024 * 1024, 1024, RowId{}, T); continue; } r -= I_W2;
        if (r < I_WIN) { const int kt = r / 31, ntile = r % 31; conv_tile(p.w_in, IN_COLS, kt * 64, ntile * 256, IN_COLS, WSP(bf16_t, WS_WINT), 1024, RowWin{}, T); continue; } r -= I_WIN;
        if (r < I_SQ) { conv_tile(p.proj_gla, 1024, (r >> 2) * 64, (r & 3) * 256, 1024, WSP(bf16_t, WS_PGLAT), 1024, RowId{}, T); continue; } r -= I_SQ;
        if (r < I_SQ) { conv_tile(p.proj_nsa, 1024, (r >> 2) * 64, (r & 3) * 256, 1024, WSP(bf16_t, WS_PNSAT), 1024, RowId{}, T); continue; } r -= I_SQ;
        if (r < I_SQ) { conv_tile(p.w_out, 1024, (r >> 2) * 64, (r & 3) * 256, 1024, WSP(bf16_t, WS_WOUTT), 1024, RowId{}, T); continue; } r -= I_SQ;
        if (r < I_C1) { const int which = r >> 6, half = (r >> 5) & 1, kt = r & 31;
            conv_tile(p.cmp_w1 + ((size_t)which * 4096 + half * 2048) * 256, 256, kt * 64, 0, 256, WSP(bf16_t, WS_CW1T) + (size_t)which * 512 * 2048, 2048, RowOff{half * 256}, T); continue; } r -= I_C1;
        if (r < I_C2) { const int which = r >> 2, kt = r & 3;
            conv_tile(p.cmp_w2 + (size_t)which * 256 * 128, 128, kt * 64, 0, 128, WSP(bf16_t, WS_CW2T) + (size_t)which * 128 * 256, 256, RowId{}, T); continue; }
        { u32x4* z = (u32x4*)(WSP(bf16_t, WS_WINT) + (size_t)IN_COLS * 1024); const int n16 = (PLD - IN_COLS) * 1024 * 2 / 16;
          for (int i = threadIdx.x; i < n16; i += NTHR) z[i] = (u32x4){0u, 0u, 0u, 0u}; }
    }
}
__device__ __forceinline__ void ph_u1(const P& p, int bid, int nblk) {
    const int lane = threadIdx.x & 63, gw = bid * NWAVES + (threadIdx.x >> 6), NGW = nblk * NWAVES;
    for (int row = gw; row < NTOK; row += NGW) {
        const f32x4* xr = (const f32x4*)(p.x + (size_t)row * DM) + lane; const float* mod = WSP(float, WS_MOD) + (row / SEQ) * 6144;
        f32x4 v[4]; float ss = 0.f;
#pragma unroll
        for (int j = 0; j < 4; ++j) { v[j] = xr[64 * j]; ss += (v[j][0] * v[j][0] + v[j][1] * v[j][1]) + (v[j][2] * v[j][2] + v[j][3] * v[j][3]); }
        const float rstd = rsqrtf(wave_sum(ss) * (1.f / DM) + RMS_EPS);
        u32x2* o = (u32x2*)(WSP(bf16_t, WS_U1) + (size_t)row * DM) + lane;
#pragma unroll
        for (int j = 0; j < 4; ++j) { const int col = 4 * lane + 256 * j;
            const f32x4 g = *(const f32x4*)(p.norm1_g + col), sc = *(const f32x4*)(mod + 1024 + col), sh = *(const f32x4*)(mod + col);
            float r[4];
#pragma unroll
            for (int i = 0; i < 4; ++i) r[i] = v[j][i] * rstd * g[i] * (1.f + sc[i]) + sh[i];
            u32x2 w; w.x = cvt_pk_bf16(r[0], r[1]); w.y = cvt_pk_bf16(r[2], r[3]); o[64 * j] = w; }
    }
}

template <class F, bool DUAL>
__device__ __forceinline__ void sgemm_tile_dev(F f, const P& p, int m0, int n0, LAS float* sm) {
    LAS float* As = sm; LAS float* Bs = sm + 16 * 68; LAS float* Bs2 = sm + 32 * 68;
    const int tid = threadIdx.x, tx = tid & 15, ty = (tid >> 4) & 15; const bool act = tid < 256;
    f.init(p, m0);
    float acc[4][4], acc2[4][4];
#pragma unroll
    for (int i = 0; i < 4; ++i)
#pragma unroll
        for (int j = 0; j < 4; ++j) { acc[i][j] = 0.f; acc2[i][j] = 0.f; }
    const int K = f.K;
    for (int k0 = 0; k0 < K; k0 += 16) {
        if (act) {
            { const int r = tid >> 2, kq = (tid & 3) * 4;
#pragma unroll
              for (int i = 0; i < 4; ++i) As[(kq + i) * 68 + r] = f.a(p, m0 + r, k0 + kq + i); }
            { const int kk = tid >> 4, cc = (tid & 15) * 4;
#pragma unroll
              for (int i = 0; i < 4; ++i) { Bs[kk * 68 + cc + i] = f.b(p, k0 + kk, n0 + cc + i); if (DUAL) Bs2[kk * 68 + cc + i] = f.b2(p, k0 + kk, n0 + cc + i); } }
        }
        __syncthreads();
        if (act) {
#pragma unroll
            for (int kk = 0; kk < 16; ++kk) {
                float a[4], b[4], b2[4];
#pragma unroll
                for (int i = 0; i < 4; ++i) { a[i] = As[kk * 68 + ty * 4 + i]; b[i] = Bs[kk * 68 + tx * 4 + i]; b2[i] = DUAL ? Bs2[kk * 68 + tx * 4 + i] : 0.f; }
#pragma unroll
                for (int i = 0; i < 4; ++i)
#pragma unroll
                    for (int j = 0; j < 4; ++j) { acc[i][j] += a[i] * b[j]; if (DUAL) acc2[i][j] += a[i] * b2[j]; }
            }
        }
        __syncthreads();
    }
    if (act) {
#pragma unroll
        for (int i = 0; i < 4; ++i)
#pragma unroll
            for (int j = 0; j < 4; ++j) f.store(p, m0 + ty * 4 + i, n0 + tx * 4 + j, acc[i][j], acc2[i][j]);
    }
}
__device__ __forceinline__ void ph_loga_naive(const P& p, int bid, int nblk) {
    for (size_t idx = (size_t)bid * NTHR + threadIdx.x; idx < (size_t)NTOK * 512; idx += (size_t)nblk * NTHR) {
        const size_t row = idx >> 9; const int j = (int)(idx & 511);
        const bf16_t* pr = WSP(bf16_t, WS_PROJ) + row * PLD + C_GA;
        float xx = p.gla_ba[j];
#pragma unroll
        for (int r = 0; r < 16; ++r) xx += bf2f(pr[r]) * p.gla_wa2[r * 512 + j];
        const float ls = fminf(xx, 0.f) - log1pf(__expf(-fabsf(xx)));
        WSP(float, WS_LOGA)[idx] = ls * (1.f / 16.f);
    }
}
__device__ __forceinline__ void ph_gla_naive(const P& p, int bid, int nblk) {
    const int tid = threadIdx.x;
    if (tid >= 256) return;
    for (int blk = bid; blk < 256; blk += nblk) {
        const int b = blk >> 6, h = (blk >> 4) & 3, vg = blk & 15, vl = tid >> 4, kg = tid & 15;
        const int vcol = h * 256 + vg * 16 + vl;
        float S[8];
#pragma unroll
        for (int i = 0; i < 8; ++i) S[i] = 0.f;
        const bf16_t* proj = WSP(bf16_t, WS_PROJ); const float* loga = WSP(float, WS_LOGA); float* og = WSP(float, WS_OGLA);
        for (int t = 0; t < SEQ; ++t) {
            const size_t row = (size_t)b * SEQ + t;
            const bf16_t* pr = proj + row * PLD;
            const float vv = bf2f(pr[C_GV + vcol]);
            float part = 0.f;
#pragma unroll
            for (int i = 0; i < 8; ++i) {
                const int d = h * 128 + kg * 8 + i;
                const float a = __expf(loga[row * 512 + d]);
                S[i] = a * S[i] + bf2f(pr[C_GK + d]) * vv;
                part += bf2f(pr[C_GQ + d]) * S[i];
            }
            part += __shfl_xor(part, 1); part += __shfl_xor(part, 2); part += __shfl_xor(part, 4); part += __shfl_xor(part, 8);
            if (kg == 0) og[row * DM + vcol] = part * 0.08838834764831845f;
        }
    }
}
__device__ __forceinline__ void ph_ygla_naive(const P& p, int bid, int nblk) {
    const int lane = threadIdx.x & 63, gw = bid * NWAVES + (threadIdx.x >> 6), NGW = nblk * NWAVES;
    for (int w = gw; w < NTOK * 4; w += NGW) {
        const int row = w >> 2, h = w & 3;
        const float* o = WSP(float, WS_OGLA) + (size_t)row * DM + h * 256;
        float v[4]; float ss = 0.f;
#pragma unroll
        for (int i = 0; i < 4; ++i) { v[i] = o[lane + 64 * i]; ss += v[i] * v[i]; }
        const float rstd = rsqrtf(wave_sum(ss) * (1.f / 256.f) + RMS_EPS);
        const bf16_t* pr = WSP(bf16_t, WS_PROJ) + (size_t)row * PLD + C_GR + h * 256;
        bf16_t* y = WSP(bf16_t, WS_YGLA) + (size_t)row * DM + h * 256;
#pragma unroll
        for (int i = 0; i < 4; ++i) { const int dv = lane + 64 * i; y[dv] = f2bf(v[i] * rstd * p.gla_norm_g[dv] * siluf_(bf2f(pr[dv]))); }
    }
}
template <bool WIN>
__device__ __forceinline__ void sparse_attend(const P& p, int b, int g, int t, int hq, u64 mask, LAS float* q, LAS float* pp, int lane, float& o0, float& o1) {
    const bf16_t* proj = WSP(bf16_t, WS_PROJ);
    const int kcol = (WIN ? C_KW : C_KS) + g * 128, vcol = (WIN ? C_VW : C_VS) + g * 128;
    const int nch = WIN ? 8 : __popcll(mask);
    int base[16];
    { u64 mm = mask;
#pragma unroll
      for (int jj = 0; jj < 16; ++jj) { if (WIN) base[jj] = t - 511 + jj * 64; else { const int bi = mm ? __ffsll((long long)mm) - 1 : 0; base[jj] = bi * 64; mm &= mm - 1; } } }
    float s[16]; float m = -INFINITY;
#pragma unroll
    for (int jj = 0; jj < 16; ++jj) {
        s[jj] = -INFINITY;
        if (jj < nch) { const int pos = base[jj] + lane;
            if (pos >= 0 && pos <= t) { const bf16_t* kr = proj + ((size_t)b * SEQ + pos) * PLD + kcol; float a = 0.f; for (int d = 0; d < 128; ++d) a += q[d] * bf2f(kr[d]); s[jj] = a * ATT_SCALE; } }
        m = fmaxf(m, s[jj]);
    }
    m = wave_max(m);
    float sum = 0.f;
#pragma unroll
    for (int jj = 0; jj < 16; ++jj) { s[jj] = (s[jj] > -INFINITY) ? __expf(s[jj] - m) : 0.f; sum += s[jj]; }
    sum = wave_sum(sum);
    const float inv = 1.f / fmaxf(sum, 1e-30f);
#pragma unroll
    for (int jj = 0; jj < 16; ++jj) pp[jj * 64 + lane] = s[jj] * inv;
    __builtin_amdgcn_wave_barrier();
    o0 = 0.f; o1 = 0.f;
#pragma unroll
    for (int jj = 0; jj < 16; ++jj) {
        if (jj < nch) {
            for (int l = 0; l < 64; ++l) {
                const float pv = pp[jj * 64 + l];
                int pos = base[jj] + l; pos = pos < 0 ? 0 : (pos > SEQ - 1 ? SEQ - 1 : pos);
                const bf16_t* vr = proj + ((size_t)b * SEQ + pos) * PLD + vcol;
                o0 += pv * bf2f(vr[lane]); o1 += pv * bf2f(vr[64 + lane]);
            }
        }
    }
    __builtin_amdgcn_wave_barrier();
}
__device__ __forceinline__ void ph_nsa_naive(const P& p, LAS unsigned char* lds, int bid, int nblk) {
    const int wid = threadIdx.x >> 6, lane = threadIdx.x & 63, gw = bid * NWAVES + wid, NGW = nblk * NWAVES;
    LAS float* wl = (LAS float*)lds + wid * 1920;
    LAS float* q = wl; LAS float* pp = wl + 128; LAS float* ps = wl + 1152; LAS float* oc = wl + 1408;
    for (int w = gw; w < BATCH * 2 * SEQ; w += NGW) {
        const int b = w >> 13, g = (w >> 12) & 1, t = w & 4095;
        const size_t row = (size_t)b * SEQ + t;
        const bf16_t* pr = WSP(bf16_t, WS_PROJ) + row * PLD;
        const bf16_t* kc = WSP(bf16_t, WS_KCVC) + (((size_t)0 * 4 + b) * 2 + g) * 256 * 128;
        const bf16_t* vc = WSP(bf16_t, WS_KCVC) + (((size_t)1 * 4 + b) * 2 + g) * 256 * 128;
        const int ncv = t >= 31 ? (t - 31) / 16 + 1 : 0;
        for (int i = 0; i < 4; ++i) ps[lane + 64 * i] = 0.f;
        for (int r = 0; r < 4; ++r) {
            const int hq = g * 4 + r;
            q[lane] = bf2f(pr[C_NQ + hq * 128 + lane]); q[lane + 64] = bf2f(pr[C_NQ + hq * 128 + 64 + lane]);
            __builtin_amdgcn_wave_barrier();
            float s[4]; float m = -INFINITY;
            for (int i = 0; i < 4; ++i) {
                const int c = lane + 64 * i; s[i] = -INFINITY;
                if (c < ncv) { float a = 0.f; for (int d = 0; d < 128; ++d) a += q[d] * bf2f(kc[c * 128 + d]); s[i] = a * ATT_SCALE; }
                m = fmaxf(m, s[i]);
            }
            m = wave_max(m);
            float e[4]; float sum = 0.f;
            for (int i = 0; i < 4; ++i) { const int c = lane + 64 * i; e[i] = (c < ncv) ? __expf(s[i] - m) : 0.f; sum += e[i]; }
            sum = wave_sum(sum);
            const float inv = 1.f / fmaxf(sum, 1e-30f);
            for (int i = 0; i < 4; ++i) { const int c = lane + 64 * i; const float pv = e[i] * inv; pp[c] = pv; ps[c] += pv; }
            __builtin_amdgcn_wave_barrier();
            float o0 = 0.f, o1 = 0.f;
            for (int c = 0; c < ncv; ++c) { const float pv = pp[c]; o0 += pv * bf2f(vc[c * 128 + lane]); o1 += pv * bf2f(vc[c * 128 + 64 + lane]); }
            oc[r * 128 + lane] = o0; oc[r * 128 + 64 + lane] = o1;
            __builtin_amdgcn_wave_barrier();
        }
        const int s = lane, tb = t >> 6;
        float imp = 0.f;
        for (int c = 4 * s - 1; c <= 4 * s + 3; ++c) if (c >= 0 && c < NCMP) imp += ps[c];
        const bool forced = (s == 0) || (s == tb) || (s == tb - 1), valid = s <= tb;
        const float score = forced ? INFINITY : (valid ? imp : -INFINITY);
        int rank = 0;
        for (int j = 0; j < 64; ++j) { const float sj = __shfl(score, j); rank += (sj > score) || (sj == score && j < s); }
        const bool sel = rank < 16 && score > -INFINITY;
        const u64 mask = __ballot(sel);
        for (int r = 0; r < 4; ++r) {
            const int hq = g * 4 + r;
            q[lane] = bf2f(pr[C_NQ + hq * 128 + lane]); q[lane + 64] = bf2f(pr[C_NQ + hq * 128 + 64 + lane]);
            __builtin_amdgcn_wave_barrier();
            float s0, s1, w0, w1;
            sparse_attend<false>(p, b, g, t, hq, mask, q, pp, lane, s0, s1);
            sparse_attend<true>(p, b, g, t, hq, 0ull, q, pp, lane, w0, w1);
            const float g0 = sigmoidf_(bf2f(pr[C_NG + hq * 3 + 0])), g1 = sigmoidf_(bf2f(pr[C_NG + hq * 3 + 1])), g2 = sigmoidf_(bf2f(pr[C_NG + hq * 3 + 2]));
            bf16_t* y = WSP(bf16_t, WS_YNSA) + row * DM + hq * 128;
            y[lane] = f2bf(g0 * oc[r * 128 + lane] + g1 * s0 + g2 * w0);
            y[lane + 64] = f2bf(g0 * oc[r * 128 + 64 + lane] + g1 * s1 + g2 * w1);
            __builtin_amdgcn_wave_barrier();
        }
    }
}
__device__ __forceinline__ void ph_route(const P& p, LAS unsigned char* lds, int bid, int nblk) {
    const int wid = threadIdx.x >> 6, lane = threadIdx.x & 63, gw = bid * NWAVES + wid, NGW = nblk * NWAVES;
    LAS float* uu = (LAS float*)lds + wid * 1024;
    for (int row = gw; row < NTOK; row += NGW) {
        const float* hr = WSP(float, WS_H1) + (size_t)row * DM; const float* mod = WSP(float, WS_MOD) + (row / SEQ) * 6144;
        float v[16]; float ss = 0.f;
#pragma unroll
        for (int i = 0; i < 16; ++i) { v[i] = hr[lane + 64 * i]; ss += v[i] * v[i]; }
        const float rstd = rsqrtf(wave_sum(ss) * (1.f / DM) + RMS_EPS);
        bf16_t* u = WSP(bf16_t, WS_U2) + (size_t)row * DM;
#pragma unroll
        for (int i = 0; i < 16; ++i) { const int col = lane + 64 * i; const float val = v[i] * rstd * p.norm2_g[col] * (1.f + mod[4096 + col]) + mod[3072 + col]; uu[col] = val; u[col] = f2bf(val); }
        __builtin_amdgcn_wave_barrier();
        const int e = lane & 31, kh = lane >> 5;
        float acc = 0.f;
        for (int k = kh * 512; k < kh * 512 + 512; ++k) acc += uu[k] * p.router_w[k * 32 + e];
        acc += __shfl_xor(acc, 32);
        const float logit = acc + p.router_b[e];
        int rank = 0;
        for (int j = 0; j < 32; ++j) { const float lj = __shfl(logit, j); rank += (lj > logit) || (lj == logit && j < e); }
        const float mx = wave_max(logit);
        const bool sel = rank < 4;
        const float ex = sel ? __expf(logit - mx) : 0.f;
        float sum = ex; for (int o = 1; o < 32; o <<= 1) sum += __shfl_xor(sum, o);
        if (sel && lane < 32) {
            WSP(int, WS_TOPE)[row * 4 + rank] = e; WSP(float, WS_TOPW)[row * 4 + rank] = ex / sum;
            atomicAdd(WSP(int, WS_CTL) + CT_CNT + e, 1);
        }
        __builtin_amdgcn_wave_barrier();
    }
}
__device__ __forceinline__ void ph_assign(const P& p, LAS unsigned char* lds, int bid, int nblk) {
    LAS int* pst = (LAS int*)lds;
    int* ctl = WSP(int, WS_CTL);
    if (threadIdx.x == 0) {
        int ps = 0;
        for (int e = 0; e < NEXP; ++e) { pst[e] = ps; const int nb = (ctl[CT_CNT + e] + MOEB - 1) / MOEB;
            if (bid == 0) for (int i = 0; i < nb; ++i) ctl[CT_BLKE + ps / MOEB + i] = e;
            ps += nb * MOEB; }
        pst[NEXP] = ps; if (bid == 0) ctl[CT_PTOT] = ps;
    }
    __syncthreads();
    const int wid = threadIdx.x >> 6, lane = threadIdx.x & 63, gw = bid * NWAVES + wid, NGW = nblk * NWAVES;
    for (int idx = gw; idx < NTOK * 4; idx += NGW) {
        const int e = WSP(int, WS_TOPE)[idx];
        int pos = 0;
        if (lane == 0) pos = pst[e] + atomicAdd(ctl + CT_FILL + e, 1);
        pos = __shfl(pos, 0);
        if (lane == 0) WSP(int, WS_SLOTOF)[idx] = pos;
        const u32x4* s = (const u32x4*)(WSP(bf16_t, WS_U2) + (size_t)(idx >> 2) * DM); u32x4* d = (u32x4*)(WSP(bf16_t, WS_XS) + (size_t)pos * DM);
        d[lane] = s[lane]; d[lane + 64] = s[lane + 64];
    }
}
__device__ __forceinline__ void ph_final(const P& p, int bid, int nblk) {
    const int lane = threadIdx.x & 63, gw = bid * NWAVES + (threadIdx.x >> 6), NGW = nblk * NWAVES;
    for (int row = gw; row < NTOK; row += NGW) {
        const float* hr = WSP(float, WS_H1) + (size_t)row * DM; const float* mod = WSP(float, WS_MOD) + (row / SEQ) * 6144;
        const int* so = WSP(int, WS_SLOTOF) + row * 4; const float* tw = WSP(float, WS_TOPW) + row * 4;
        const bf16_t* ys = WSP(bf16_t, WS_YSLOT);
        const int s0 = so[0], s1 = so[1], s2 = so[2], s3 = so[3]; const float w0 = tw[0], w1 = tw[1], w2 = tw[2], w3 = tw[3];
        float v[16]; float ss = 0.f;
#pragma unroll
        for (int i = 0; i < 16; ++i) {
            const int col = lane + 64 * i;
            const float m = w0 * bf2f(ys[(size_t)s0 * DM + col]) + w1 * bf2f(ys[(size_t)s1 * DM + col]) + w2 * bf2f(ys[(size_t)s2 * DM + col]) + w3 * bf2f(ys[(size_t)s3 * DM + col]);
            v[i] = hr[col] + mod[5120 + col] * m; ss += v[i] * v[i];
        }
        const float rstd = rsqrtf(wave_sum(ss) * (1.f / DM) + RMS_EPS);
#pragma unroll
        for (int i = 0; i < 16; ++i) { const int col = lane + 64 * i; p.out[(size_t)row * DM + col] = v[i] * rstd * p.final_g[col]; }
    }
}

constexpr size_t WS_QE = 735 * MiB;
constexpr size_t WS_KDT = 751 * MiB;
constexpr size_t WS_AM = 767 * MiB;
constexpr size_t WS_DEC = 775 * MiB;
typedef short s16x4 __attribute__((ext_vector_type(4)));
__device__ __forceinline__ s16x4 lds_tr16(LAS const void* ptr) { return __builtin_bit_cast(s16x4, __builtin_amdgcn_ds_read_tr16_b64_v4i16((LAS s16x4*)ptr)); }
__device__ __forceinline__ bf16x8 cat8(s16x4 a, s16x4 b) { return (bf16x8){a[0], a[1], a[2], a[3], b[0], b[1], b[2], b[3]}; }

__device__ __forceinline__ void ph_gla_g1(const P& p, LAS unsigned char* lds, int bid, int nblk) {
    const int tid = threadIdx.x, wid = tid >> 6, lane = tid & 63, fr = lane & 15, fq = lane >> 4;
    LAS float* gaL = (LAS float*)lds;
    LAS float* segL = (LAS float*)(lds + 4096);
    LAS bf16_t* qeL = (LAS bf16_t*)(lds + 8192);
    LAS bf16_t* keL = (LAS bf16_t*)(lds + 8192 + 17408);
    const bf16_t* proj = WSP(bf16_t, WS_PROJ);
    for (int item = bid; item < 1024; item += nblk) {
        const int b = item >> 8, h = (item >> 6) & 3, n = item & 63;
        const size_t r0 = (size_t)b * SEQ + n * 64;
        if (tid < 128) { const int tok = tid >> 1, half = tid & 1;
            const u32x4 v = *(const u32x4*)(proj + (r0 + tok) * PLD + C_GA + half * 8);
            LAS float* d = gaL + tok * 16 + half * 8;
            d[0] = bflo(v.x); d[1] = bfhi(v.x); d[2] = bflo(v.y); d[3] = bfhi(v.y); d[4] = bflo(v.z); d[5] = bfhi(v.z); d[6] = bflo(v.w); d[7] = bfhi(v.w); }
        __syncthreads();
        const int d = tid & 127, seg = tid >> 7;
        float w[16];
#pragma unroll
        for (int r = 0; r < 16; ++r) w[r] = p.gla_wa2[r * 512 + h * 128 + d];
        const float ba = p.gla_ba[h * 128 + d];
        float bc[16]; float run = 0.f;
#pragma unroll
        for (int i = 0; i < 16; ++i) {
            const LAS float* g = gaL + (seg * 16 + i) * 16; float xx = ba;
#pragma unroll
            for (int r = 0; r < 16; ++r) xx += g[r] * w[r];
            const float ls = fminf(xx, 0.f) - log1pf(__expf(-fabsf(xx)));
            run += ls * (1.f / 16.f); bc[i] = run;
        }
        segL[seg * 128 + d] = run;
        __syncthreads();
        float off = 0.f, blast = 0.f;
#pragma unroll
        for (int s = 0; s < 4; ++s) { const float v = segL[s * 128 + d]; blast += v; if (s < seg) off += v; }
        bf16_t* QE = WSP(bf16_t, WS_QE) + (size_t)item * 8192; bf16_t* KDT = WSP(bf16_t, WS_KDT) + (size_t)item * 8192;
        float kd[16];
#pragma unroll
        for (int i = 0; i < 16; ++i) {
            const int tok = seg * 16 + i; const float bcv = bc[i] + off;
            const bf16_t* pr = proj + (r0 + tok) * PLD + h * 128 + d;
            const float q = bf2f(pr[C_GQ]), k = bf2f(pr[C_GK]);
            const float e = __expf(bcv);
            const bf16_t qe = f2bf(q * 0.08838834764831845f * e), ke = f2bf(k * __expf(-bcv));
            kd[i] = k * __expf(blast - bcv);
            qeL[tok * 136 + d] = qe; keL[tok * 136 + d] = ke; QE[tok * 128 + d] = qe;
        }
        { u32x4 w0, w1; w0.x = cvt_pk_bf16(kd[0], kd[1]); w0.y = cvt_pk_bf16(kd[2], kd[3]); w0.z = cvt_pk_bf16(kd[4], kd[5]); w0.w = cvt_pk_bf16(kd[6], kd[7]);
          w1.x = cvt_pk_bf16(kd[8], kd[9]); w1.y = cvt_pk_bf16(kd[10], kd[11]); w1.z = cvt_pk_bf16(kd[12], kd[13]); w1.w = cvt_pk_bf16(kd[14], kd[15]);
          u32x4* dst = (u32x4*)(KDT + d * 64 + seg * 16); dst[0] = w0; dst[1] = w1; }
        if (seg == 0) WSP(float, WS_DEC)[(size_t)item * 128 + d] = __expf(blast);
        __syncthreads();
        bf16_t* AM = WSP(bf16_t, WS_AM) + (size_t)item * 4096;
#pragma unroll
        for (int tt = 0; tt < 2; ++tt) {
            const int id = wid * 2 + tt, ti = id >> 2, tj = id & 3;
            f32x4 acc = (f32x4){0.f, 0.f, 0.f, 0.f};
            if (tj <= ti) {
#pragma unroll
                for (int s = 0; s < 4; ++s) {
                    const bf16x8 af = *(const LAS bf16x8*)(qeL + (16 * ti + fr) * 136 + 32 * s + 8 * fq);
                    const bf16x8 bf = *(const LAS bf16x8*)(keL + (16 * tj + fr) * 136 + 32 * s + 8 * fq);
                    acc = __builtin_amdgcn_mfma_f32_16x16x32_bf16(af, bf, acc, 0, 0, 0);
                }
            }
            const int j = 16 * tj + fr;
#pragma unroll
            for (int r = 0; r < 4; ++r) { const int i = 16 * ti + 4 * fq + r; AM[i * 64 + j] = f2bf(j <= i ? acc[r] : 0.f); }
        }
        __syncthreads();
    }
}

__device__ __forceinline__ void ph_gla_g2(const P& p, LAS unsigned char* lds, int bid, int nblk) {
    const int tid = threadIdx.x, wid = __builtin_amdgcn_readfirstlane(tid >> 6), lane = tid & 63, fr = lane & 15, fq = lane >> 4;
    LAS bf16_t* VL = (LAS bf16_t*)lds;
    LAS bf16_t* ST = (LAS bf16_t*)(lds + 4096);
    const bf16_t* proj = WSP(bf16_t, WS_PROJ);
    for (int it = bid; it < 256; it += nblk) {
        const int bh = (it & 7) + 8 * ((it >> 3) & 1), slice = it >> 4, b = bh >> 2, h = bh & 3;
        for (int i = tid; i < 16 * 136 / 2; i += NTHR) ((LAS unsigned*)ST)[i] = 0u;
        f32x4 S = (f32x4){0.f, 0.f, 0.f, 0.f};
        const int item0 = (b * 4 + h) * 64;
        const size_t r0 = (size_t)b * SEQ;
        const int vcol = C_GV + h * 256 + slice * 16;
        bf16x8 kdt[2] = {}, am[2] = {}, qe[4] = {}; f32x4 dec; u32x4 vreg = (u32x4){0u, 0u, 0u, 0u};
        {
            const bf16_t* KDT = WSP(bf16_t, WS_KDT) + (size_t)item0 * 8192; const bf16_t* AMp = WSP(bf16_t, WS_AM) + (size_t)item0 * 4096; const bf16_t* QE = WSP(bf16_t, WS_QE) + (size_t)item0 * 8192;
#pragma unroll
            for (int s = 0; s < 2; ++s) kdt[s] = *(const bf16x8*)(KDT + (16 * wid + fr) * 64 + 32 * s + 8 * fq);
            if (wid < 4) {
#pragma unroll
                for (int s = 0; s < 2; ++s) am[s] = *(const bf16x8*)(AMp + (16 * wid + fr) * 64 + 32 * s + 8 * fq);
#pragma unroll
                for (int s = 0; s < 4; ++s) qe[s] = *(const bf16x8*)(QE + (16 * wid + fr) * 128 + 32 * s + 8 * fq);
            }
            dec = *(const f32x4*)(WSP(float, WS_DEC) + (size_t)item0 * 128 + 16 * wid + 4 * fq);
            if (tid < 128) vreg = *(const u32x4*)(proj + (r0 + (tid >> 1)) * PLD + vcol + (tid & 1) * 8);
        }
        for (int n = 0; n < 64; ++n) {
            LAS bf16_t* Vb = VL + (n & 1) * 1024;
            if (tid < 128) *(LAS u32x4*)(Vb + (tid >> 1) * 16 + (tid & 1) * 8) = vreg;
            bf16x8 ckdt[2], cam[2], cqe[4]; const f32x4 cdec = dec;
#pragma unroll
            for (int s = 0; s < 2; ++s) { ckdt[s] = kdt[s]; cam[s] = am[s]; }
#pragma unroll
            for (int s = 0; s < 4; ++s) cqe[s] = qe[s];
            if (n + 1 < 64) {
                const int itn = item0 + n + 1;
                const bf16_t* KDT = WSP(bf16_t, WS_KDT) + (size_t)itn * 8192; const bf16_t* AMp = WSP(bf16_t, WS_AM) + (size_t)itn * 4096; const bf16_t* QE = WSP(bf16_t, WS_QE) + (size_t)itn * 8192;
#pragma unroll
                for (int s = 0; s < 2; ++s) kdt[s] = *(const bf16x8*)(KDT + (16 * wid + fr) * 64 + 32 * s + 8 * fq);
                if (wid < 4) {
#pragma unroll
                    for (int s = 0; s < 2; ++s) am[s] = *(const bf16x8*)(AMp + (16 * wid + fr) * 64 + 32 * s + 8 * fq);
#pragma unroll
                    for (int s = 0; s < 4; ++s) qe[s] = *(const bf16x8*)(QE + (16 * wid + fr) * 128 + 32 * s + 8 * fq);
                }
                dec = *(const f32x4*)(WSP(float, WS_DEC) + (size_t)itn * 128 + 16 * wid + 4 * fq);
                if (tid < 128) vreg = *(const u32x4*)(proj + (r0 + (n + 1) * 64 + (tid >> 1)) * PLD + vcol + (tid & 1) * 8);
            }
            __syncthreads();
            bf16x8 vb[2];
#pragma unroll
            for (int ks = 0; ks < 2; ++ks) {
                const int q = (lane & 15) >> 2, pp = lane & 3;
                const s16x4 lo = lds_tr16(Vb + (32 * ks + 8 * fq + q) * 16 + 4 * pp);
                const s16x4 hi = lds_tr16(Vb + (32 * ks + 8 * fq + 4 + q) * 16 + 4 * pp);
                vb[ks] = cat8(lo, hi);
            }
            f32x4 cs = (f32x4){0.f, 0.f, 0.f, 0.f};
            cs = __builtin_amdgcn_mfma_f32_16x16x32_bf16(ckdt[0], vb[0], cs, 0, 0, 0);
            cs = __builtin_amdgcn_mfma_f32_16x16x32_bf16(ckdt[1], vb[1], cs, 0, 0, 0);
            if (wid < 4) {
                f32x4 o = (f32x4){0.f, 0.f, 0.f, 0.f};
                o = __builtin_amdgcn_mfma_f32_16x16x32_bf16(cam[0], vb[0], o, 0, 0, 0);
                o = __builtin_amdgcn_mfma_f32_16x16x32_bf16(cam[1], vb[1], o, 0, 0, 0);
#pragma unroll
                for (int s = 0; s < 4; ++s) { const bf16x8 sb = *(const LAS bf16x8*)(ST + fr * 136 + 32 * s + 8 * fq); o = __builtin_amdgcn_mfma_f32_16x16x32_bf16(cqe[s], sb, o, 0, 0, 0); }
                float* og = WSP(float, WS_OGLA) + (r0 + n * 64 + 16 * wid + 4 * fq) * DM + h * 256 + slice * 16 + fr;
#pragma unroll
                for (int r = 0; r < 4; ++r) og[(size_t)r * DM] = o[r];
            }
            S = cdec * S + cs;
            __syncthreads();
            { u32x2 w; w.x = cvt_pk_bf16(S[0], S[1]); w.y = cvt_pk_bf16(S[2], S[3]); *(LAS u32x2*)(ST + fr * 136 + 16 * wid + 4 * fq) = w; }
        }
        __syncthreads();
    }
}
constexpr size_t WS_NSCR = 776 * MiB;
typedef float f32x16 __attribute__((ext_vector_type(16)));
constexpr int NSA_KV0 = 0, NSA_IMP = 65536, NSA_MASK = 81920, NSA_UNI = 82432, NSA_WSF = 82944;
constexpr float NSA_NEG = -1e30f;
__device__ __forceinline__ unsigned offb(unsigned row, unsigned ch) { return 2048u * (row >> 3) + 512u * (ch >> 2) + 64u * (row & 7u) + 16u * ((ch & 3u) ^ ((row >> 2) & 3u)); }
__device__ __forceinline__ int crow16(int r, int hi) { return (r & 3) + 8 * (r >> 2) + 4 * hi; }
struct TileRegs { u32x4 k[2], v[2]; };
template <bool LOADV>
__device__ __forceinline__ void nsa_tile_load(TileRegs& R, const bf16_t* kb, const bf16_t* vb, size_t pitch) {
    unsigned tx = threadIdx.x; asm volatile("" : "+v"(tx));
#pragma unroll
    for (int i = 0; i < 2; ++i) { const int c = tx + NTHR * i, row = c >> 4, ch = c & 15;
        R.k[i] = *(const u32x4*)(kb + (size_t)row * pitch + ch * 8);
        if (LOADV) R.v[i] = *(const u32x4*)(vb + (size_t)row * pitch + ch * 8); }
}
template <bool LOADV>
__device__ __forceinline__ void nsa_tile_store(const TileRegs& R, LAS unsigned char* buf) {
#pragma unroll
    for (int i = 0; i < 2; ++i) { const int c = threadIdx.x + NTHR * i, row = c >> 4, ch = c & 15;
        *(LAS u32x4*)(buf + offb(row, ch)) = R.k[i];
        if (LOADV) *(LAS u32x4*)(buf + 16384 + offb(row, ch)) = R.v[i]; }
}
struct NsaCtx {
    int lane, q32, hi, tl6, tb, ncv; unsigned mlo, mhi; float invl;
    LAS float* wsf; LAS float* impRow;
    unsigned kb[2], vb[2];
};
template <int MODE>
__device__ __forceinline__ void nsa_tile(LAS const unsigned char* Kt, const bf16x8 (&qr)[8], f32x16 (&o)[4], float& m, float& lp, const NsaCtx& cx, int j  ) {
    const int q32 = cx.q32, hi = cx.hi;
    f32x16 p0, p1;
#pragma unroll
    for (int r = 0; r < 16; ++r) { p0[r] = 0.f; p1[r] = 0.f; }
    {
        bf16x8 kc0 = *(const LAS bf16x8*)(Kt + cx.kb[0]), kc1 = *(const LAS bf16x8*)(Kt + cx.kb[0] + 8192);
#pragma unroll
        for (int s = 0; s < 8; ++s) {
            bf16x8 kn0 = kc0, kn1 = kc1;
            if (s + 1 < 8) { kn0 = *(const LAS bf16x8*)(Kt + cx.kb[(s + 1) & 1] + 512 * ((s + 1) >> 1)); kn1 = *(const LAS bf16x8*)(Kt + cx.kb[(s + 1) & 1] + 512 * ((s + 1) >> 1) + 8192); }
            asm volatile("" ::: "memory");
            p0 = __builtin_amdgcn_mfma_f32_32x32x16_bf16(kc0, qr[s], p0, 0, 0, 0);
            p1 = __builtin_amdgcn_mfma_f32_32x32x16_bf16(kc1, qr[s], p1, 0, 0, 0);
            kc0 = kn0; kc1 = kn1;
        }
    }
    const float SC = 0.08838834764831845f * 1.4426950408889634f;
    const bool selbit = (MODE == 2) ? ((((j < 32) ? (cx.mlo >> j) : (cx.mhi >> (j - 32))) & 1u) != 0u) : true;
    float tmax = NSA_NEG;
#pragma unroll
    for (int r = 0; r < 16; ++r) {
        const int kk0 = crow16(r, hi), kk1 = kk0 + 32;
        bool v0, v1;
        if (MODE <= 1) { v0 = (64 * j + kk0) < cx.ncv; v1 = (64 * j + kk1) < cx.ncv; }
        else if (MODE == 2) { v0 = selbit && (j < cx.tb || kk0 <= cx.tl6); v1 = selbit && (j < cx.tb || kk1 <= cx.tl6); }
        else { v0 = (j != cx.tb || kk0 <= cx.tl6) && (j != cx.tb - 8 || kk0 > cx.tl6); v1 = (j != cx.tb || kk1 <= cx.tl6) && (j != cx.tb - 8 || kk1 > cx.tl6); }
        p0[r] = v0 ? p0[r] * SC : NSA_NEG; p1[r] = v1 ? p1[r] * SC : NSA_NEG;
        tmax = fmaxf(tmax, fmaxf(p0[r], p1[r]));
    }
    if (MODE != 1) {
        tmax = fmaxf(tmax, __shfl_xor(tmax, 32));
        const float m_new = fmaxf(m, tmax);
        const float alpha = __builtin_amdgcn_exp2f(m - m_new);
        m = m_new;
        float ps = 0.f;
#pragma unroll
        for (int r = 0; r < 16; ++r) {
            p0[r] = (p0[r] > 0.5f * NSA_NEG) ? __builtin_amdgcn_exp2f(p0[r] - m_new) : 0.f; p1[r] = (p1[r] > 0.5f * NSA_NEG) ? __builtin_amdgcn_exp2f(p1[r] - m_new) : 0.f;
            ps += p0[r] + p1[r];
        }
        lp = lp * alpha + ps;
        if (MODE != 0) {
            if (__any(alpha != 1.f)) {
                if (hi == 0) cx.wsf[q32] = alpha;
                __builtin_amdgcn_wave_barrier();
#pragma unroll
                for (int r = 0; r < 16; ++r) { const float a = cx.wsf[crow16(r, hi)];
#pragma unroll
                    for (int c = 0; c < 4; ++c) o[c][r] *= a; }
                __builtin_amdgcn_wave_barrier();
            }
        }
    } else {
#pragma unroll
        for (int r = 0; r < 16; ++r) {
            p0[r] = (p0[r] > 0.5f * NSA_NEG) ? __builtin_amdgcn_exp2f(p0[r] - m) * cx.invl : 0.f; p1[r] = (p1[r] > 0.5f * NSA_NEG) ? __builtin_amdgcn_exp2f(p1[r] - m) * cx.invl : 0.f;
        }
#pragma unroll
        for (int kb = 0; kb < 2; ++kb)
#pragma unroll
            for (int gq = 0; gq < 4; ++gq) {
                float s4, e1;
                if (kb == 0) { e1 = p0[4 * gq + 3]; s4 = (p0[4 * gq] + p0[4 * gq + 1]) + (p0[4 * gq + 2] + e1); }
                else { e1 = p1[4 * gq + 3]; s4 = (p1[4 * gq] + p1[4 * gq + 1]) + (p1[4 * gq + 2] + e1); }
                s4 += __shfl_xor(s4, 1); s4 += __shfl_xor(s4, 2); e1 += __shfl_xor(e1, 1); e1 += __shfl_xor(e1, 2);
                const int sblk = (64 * j + 32 * kb + 8 * gq + 4 * hi) >> 2;
                if ((q32 & 3) == 0) { __hip_atomic_fetch_add(cx.impRow + sblk, s4, __ATOMIC_RELAXED, __HIP_MEMORY_SCOPE_WORKGROUP); if (sblk + 1 < 64) __hip_atomic_fetch_add(cx.impRow + sblk + 1, e1, __ATOMIC_RELAXED, __HIP_MEMORY_SCOPE_WORKGROUP); }
            }
    }
    if (MODE != 0) {
        LAS const unsigned char* Vt = Kt + 16384;
        u32x4 pw[4];
        pw[0] = (u32x4){cvt_pk_bf16(p0[0], p0[1]), cvt_pk_bf16(p0[2], p0[3]), cvt_pk_bf16(p0[4], p0[5]), cvt_pk_bf16(p0[6], p0[7])};
        pw[1] = (u32x4){cvt_pk_bf16(p0[8], p0[9]), cvt_pk_bf16(p0[10], p0[11]), cvt_pk_bf16(p0[12], p0[13]), cvt_pk_bf16(p0[14], p0[15])};
        pw[2] = (u32x4){cvt_pk_bf16(p1[0], p1[1]), cvt_pk_bf16(p1[2], p1[3]), cvt_pk_bf16(p1[4], p1[5]), cvt_pk_bf16(p1[6], p1[7])};
        pw[3] = (u32x4){cvt_pk_bf16(p1[8], p1[9]), cvt_pk_bf16(p1[10], p1[11]), cvt_pk_bf16(p1[12], p1[13]), cvt_pk_bf16(p1[14], p1[15])};
        s16x4 lo = lds_tr16(Vt + cx.vb[0]), hh = lds_tr16(Vt + cx.vb[1] + 2048);
#pragma unroll
        for (int it = 0; it < 16; ++it) {
            const int ks = it >> 2, c = it & 3, ks2 = (it + 1) >> 2, c2 = (it + 1) & 3;
            s16x4 lo2 = lo, hh2 = hh;
            if (it + 1 < 16) { lo2 = lds_tr16(Vt + cx.vb[0] + 2048 * (2 * ks2) + 512 * c2); hh2 = lds_tr16(Vt + cx.vb[1] + 2048 * (2 * ks2 + 1) + 512 * c2); }
            asm volatile("" ::: "memory");
            o[c] = __builtin_amdgcn_mfma_f32_32x32x16_bf16(__builtin_bit_cast(bf16x8, pw[ks]), cat8(lo, hh), o[c], 0, 0, 0);
            lo = lo2; hh = hh2;
        }
    }
}
template <int STAGE  >
__device__ __forceinline__ void nsa_flush(const f32x16 (&o)[4], float sc, const NsaCtx& cx, float* scr, bf16_t* yrow0  ) {
    if (cx.hi == 0) cx.wsf[cx.q32] = sc;
    __builtin_amdgcn_wave_barrier();
    unsigned lofs = (unsigned)(cx.hi * 512 + cx.q32), yofs = (unsigned)(cx.hi * 1024 + cx.q32);
    asm volatile("" : "+v"(lofs), "+v"(yofs));
    float* sp0 = scr + lofs; bf16_t* yp0 = yrow0 + yofs;
#pragma unroll
    for (int r = 0; r < 16; ++r) {
        const float a = cx.wsf[crow16(r, cx.hi)];
#pragma unroll
        for (int c = 0; c < 4; ++c) {
            float* sp = sp0 + crow16(r, 0) * 128 + 32 * c;
            float v = o[c][r] * a;
            if (STAGE >= 1) v += *sp;
            if (STAGE <= 1) *sp = v;
            else yp0[(2 * (r >> 2)) * DM + (r & 3) * 128 + 32 * c] = f2bf(v);
        }
    }
    __builtin_amdgcn_wave_barrier();
}
__device__ __forceinline__ void ph_nsa(const P& p, LAS unsigned char* lds, int bid, int nblk) {
    const int tid = threadIdx.x, wid = __builtin_amdgcn_readfirstlane(tid >> 6), lane = tid & 63;
    const bf16_t* proj = WSP(bf16_t, WS_PROJ);
    LAS float* impL = (LAS float*)(lds + NSA_IMP);
    LAS unsigned* maskL = (LAS unsigned*)(lds + NSA_MASK);
    LAS unsigned* uniL = (LAS unsigned*)(lds + NSA_UNI);
    NsaCtx cx; cx.lane = lane; cx.q32 = lane & 31; cx.hi = lane >> 5; cx.wsf = (LAS float*)(lds + NSA_WSF) + wid * 64;
    float* scr = WSP(float, WS_NSCR) + (size_t)bid * 32768 + wid * 4096;
    { const unsigned q32 = cx.q32, hi = cx.hi, blk = (lane >> 4) & 1, qq = (lane & 15) >> 2, pq = lane & 3;
      cx.kb[0] = 2048u * (q32 >> 3) + 64u * (q32 & 7u) + 16u * ((0u + hi) ^ ((q32 >> 2) & 3u));
      cx.kb[1] = 2048u * (q32 >> 3) + 64u * (q32 & 7u) + 16u * ((2u + hi) ^ ((q32 >> 2) & 3u));
      cx.vb[0] = 64u * (4u * hi + qq) + 16u * ((2u * blk + (pq >> 1)) ^ ((0u + hi) & 3u)) + 8u * (pq & 1u);
      cx.vb[1] = 64u * (4u * hi + qq) + 16u * ((2u * blk + (pq >> 1)) ^ ((2u + hi) & 3u)) + 8u * (pq & 1u); }
    for (int k2 = 0; k2 < 2; ++k2) {
        for (int ub = bid; ub < 256; ub += nblk) {
            const int idx = k2 == 0 ? ub : 511 - ub;
            const int tb = 63 - (idx >> 3), bg = idx & 7, b = bg >> 1, g = bg & 1;
            const int tokw = 64 * tb + 8 * wid;
            const int t = tokw + (cx.q32 >> 2), hq = 4 * g + (cx.q32 & 3);
            const size_t rowq = (size_t)b * SEQ + t;
            cx.tb = tb; cx.tl6 = t & 63; cx.ncv = t >= 31 ? (t - 31) / 16 + 1 : 0;
            cx.impRow = impL + (8 * wid + (cx.q32 >> 2)) * 64;
            for (int i = tid; i < 4096; i += NTHR) impL[i] = 0.f;
            bf16x8 qr[8];
#pragma unroll
            for (int s = 0; s < 8; ++s) qr[s] = *(const bf16x8*)(proj + rowq * PLD + C_NQ + hq * 128 + 16 * s + 8 * cx.hi);
            const bf16_t* gp = proj + rowq * PLD + C_NG + hq * 3;
            const float gate0 = sigmoidf_(bf2f(gp[0])), gate1 = sigmoidf_(bf2f(gp[1])), gate2 = sigmoidf_(bf2f(gp[2]));
            bf16_t* yrow0 = WSP(bf16_t, WS_YNSA) + ((size_t)b * SEQ + tokw) * DM + 4 * g * 128;
            f32x16 o[4]; float m, lp; TileRegs R;
#define NSA_RESET() do { _Pragma("unroll") for (int c_ = 0; c_ < 4; ++c_) _Pragma("unroll") for (int r_ = 0; r_ < 16; ++r_) o[c_][r_] = 0.f; m = NSA_NEG; lp = 0.f; } while (0)
            const int ntc = (4 * tb + 3 + 63) >> 6;
            const bf16_t* kc = WSP(bf16_t, WS_KCVC) + (((size_t)0 * 4 + b) * 2 + g) * 256 * 128;
            const bf16_t* vc = WSP(bf16_t, WS_KCVC) + (((size_t)1 * 4 + b) * 2 + g) * 256 * 128;
            NSA_RESET();
            __syncthreads();
            nsa_tile_load<false>(R, kc, vc, 128); nsa_tile_store<false>(R, lds + NSA_KV0); __syncthreads();
            for (int i = 0; i < ntc; ++i) {
                if (i + 1 < ntc) nsa_tile_load<false>(R, kc + (size_t)(i + 1) * 64 * 128, vc, 128);
                nsa_tile<0>(lds + NSA_KV0 + (i & 1) * 32768, qr, o, m, lp, cx, i);
                if (i + 1 < ntc) nsa_tile_store<false>(R, lds + NSA_KV0 + ((i + 1) & 1) * 32768);
                __syncthreads();
            }
            { const float lt = lp + __shfl_xor(lp, 32); cx.invl = lt > 0.f ? 1.f / lt : 0.f; }
            nsa_tile_load<true>(R, kc, vc, 128); nsa_tile_store<true>(R, lds + NSA_KV0); __syncthreads();
            for (int i = 0; i < ntc; ++i) {
                if (i + 1 < ntc) nsa_tile_load<true>(R, kc + (size_t)(i + 1) * 64 * 128, vc + (size_t)(i + 1) * 64 * 128, 128);
                nsa_tile<1>(lds + NSA_KV0 + (i & 1) * 32768, qr, o, m, lp, cx, i);
                if (i + 1 < ntc) nsa_tile_store<true>(R, lds + NSA_KV0 + ((i + 1) & 1) * 32768);
                __syncthreads();
            }
            nsa_flush<0>(o, gate0, cx, scr, yrow0);
            unsigned ulo = 0u, uhi = 0u;
            for (int tl = 0; tl < 8; ++tl) {
                const int tt = tokw + tl, tbb = tt >> 6, s = lane;
                const float imp = impL[(8 * wid + tl) * 64 + s];
                const bool forced = (s == 0) || (s == tbb) || (s == tbb - 1), valid = s <= tbb;
                const float score = forced ? INFINITY : (valid ? imp : -INFINITY);
                int rank = 0;
                for (int jj = 0; jj < 64; ++jj) { const float sj = __shfl(score, jj); rank += (sj > score) || (sj == score && jj < s); }
                const u64 mk = __ballot(rank < 16 && score > -INFINITY);
                if (lane == 0) { maskL[(8 * wid + tl) * 2] = (unsigned)mk; maskL[(8 * wid + tl) * 2 + 1] = (unsigned)(mk >> 32); }
                ulo |= (unsigned)mk; uhi |= (unsigned)(mk >> 32);
            }
            if (lane == 0) { uniL[wid * 2] = ulo; uniL[wid * 2 + 1] = uhi; }
            __syncthreads();
            cx.mlo = maskL[(8 * wid + (cx.q32 >> 2)) * 2]; cx.mhi = maskL[(8 * wid + (cx.q32 >> 2)) * 2 + 1];
            u64 um = 0ull;
#pragma unroll
            for (int w8 = 0; w8 < 8; ++w8) um |= (u64)uniL[w8 * 2] | ((u64)uniL[w8 * 2 + 1] << 32);
            um = ((u64)__builtin_amdgcn_readfirstlane((unsigned)um)) | ((u64)__builtin_amdgcn_readfirstlane((unsigned)(um >> 32)) << 32);
            NSA_RESET();
            {
                const bf16_t* kbase = proj + (size_t)b * SEQ * PLD + C_KS + g * 128; const bf16_t* vbase = proj + (size_t)b * SEQ * PLD + C_VS + g * 128;
                u64 rem = um; int jcur = __ffsll((long long)rem) - 1; rem &= rem - 1; int i = 0;
                nsa_tile_load<true>(R, kbase + (size_t)jcur * 64 * PLD, vbase + (size_t)jcur * 64 * PLD, PLD); nsa_tile_store<true>(R, lds + NSA_KV0); __syncthreads();
                for (;;) {
                    const bool more = rem != 0ull; const int jn = more ? __ffsll((long long)rem) - 1 : 0; rem &= rem - 1;
                    if (more) nsa_tile_load<true>(R, kbase + (size_t)jn * 64 * PLD, vbase + (size_t)jn * 64 * PLD, PLD);
                    nsa_tile<2>(lds + NSA_KV0 + (i & 1) * 32768, qr, o, m, lp, cx, jcur);
                    if (more) nsa_tile_store<true>(R, lds + NSA_KV0 + ((i + 1) & 1) * 32768);
                    __syncthreads();
                    if (!more) break;
                    jcur = jn; ++i;
                }
                const float lt = lp + __shfl_xor(lp, 32);
                nsa_flush<1>(o, lt > 0.f ? gate1 / lt : 0.f, cx, scr, yrow0);
            }
            NSA_RESET();
            {
                const bf16_t* kbase = proj + (size_t)b * SEQ * PLD + C_KW + g * 128; const bf16_t* vbase = proj + (size_t)b * SEQ * PLD + C_VW + g * 128;
                const int j0 = tb >= 8 ? tb - 8 : 0, nt = tb - j0 + 1;
                nsa_tile_load<true>(R, kbase + (size_t)j0 * 64 * PLD, vbase + (size_t)j0 * 64 * PLD, PLD); nsa_tile_store<true>(R, lds + NSA_KV0); __syncthreads();
                for (int i = 0; i < nt; ++i) {
                    if (i + 1 < nt) nsa_tile_load<true>(R, kbase + (size_t)(j0 + i + 1) * 64 * PLD, vbase + (size_t)(j0 + i + 1) * 64 * PLD, PLD);
                    nsa_tile<3>(lds + NSA_KV0 + (i & 1) * 32768, qr, o, m, lp, cx, j0 + i);
                    if (i + 1 < nt) nsa_tile_store<true>(R, lds + NSA_KV0 + ((i + 1) & 1) * 32768);
                    __syncthreads();
                }
                const float lt = lp + __shfl_xor(lp, 32);
                nsa_flush<2>(o, lt > 0.f ? gate2 / lt : 0.f, cx, scr, yrow0);
            }
#undef NSA_RESET
        }
    }
}
enum { PH_MOD = 0, PH_U1, PH_INPROJ, PH_G3, PH_G4, PH_NSA, PH_MERGE, PH_OUT, PH_ROUTE, PH_ASSIGN, PH_MOE1, PH_MOE2, PH_FINAL, PH_END };
struct Args { P p; int ph_lo, ph_hi; };
__global__ void __launch_bounds__(NTHR, 2) mega(Args a) {
    extern __shared__ __attribute__((aligned(16))) unsigned char lds_raw[];
    LAS unsigned char* lds = (LAS unsigned char*)lds_raw;
    const P& p = a.p;
    const int bid = blockIdx.x, nblk = gridDim.x;
    volatile LAS unsigned* MISC = (volatile LAS unsigned*)(lds + LDS_MISC_OFF);
    for (int u = threadIdx.x; u < (MK_LDS_BYTES - LDS_MISC_OFF) / 4; u += NTHR) ((LAS unsigned*)(lds + LDS_MISC_OFF))[u] = 0u;
    __syncthreads();
    const bool multi = (a.ph_hi - a.ph_lo) > 1;
    XcdBarrier bar; bar.bar = WSP(unsigned, WS_CTL) + CW_BAR; bar.x = 0; bar.st = nullptr;
    if (multi) bar = xcd_barrier_post(WSP(unsigned, WS_CTL) + CW_BAR, MISC + 8);
#define IN(k) (a.ph_lo <= (k) && (k) < a.ph_hi)
#define SEAM(k) do { if (IN(k) && IN((k) + 1)) xcd_barrier(bar); } while (0)
    if (IN(PH_MOD)) { ph_mod(p, lds, bid, nblk); ph_convert(p, lds, bid, nblk); }
    SEAM(PH_MOD);
    if (IN(PH_U1)) ph_u1(p, bid, nblk);
    SEAM(PH_U1);
    if (IN(PH_INPROJ)) {
        pg8::Gemm g{WSP(bf16_t, WS_U1), WSP(bf16_t, WS_WINT), NTOK, PLD, 1024}; pg8::StaticOrder S; S.init(NTOK, PLD, nblk, bid);
        EpiProj E{WSP(bf16_t, WS_PROJ), PLD};
        pg8::gemm_phase<EpiProj, pg8::StaticOrder, true, true>(lds, g, S, E);
    }
    SEAM(PH_INPROJ);
    if (IN(PH_G3)) {
        ph_gla_g1(p, lds, bid, nblk);
        for (int it = bid; it < 256; it += nblk) { const int which = it >> 7, rt = (it >> 2) & 31, ct = it & 3; sgemm_tile_dev<F_cmp1, false>(F_cmp1{4096, which}, p, rt * 64, ct * 64, (LAS float*)lds); }
    }
    SEAM(PH_G3);
    if (IN(PH_G4)) {
        for (int it = bid; it < 128; it += nblk) { const int which = it >> 6, rt = (it >> 1) & 31, ct = it & 1; sgemm_tile_dev<F_cmp2, false>(F_cmp2{256, which}, p, rt * 64, ct * 64, (LAS float*)lds); }
        ph_gla_g2(p, lds, bid, nblk);
    }
    SEAM(PH_G4);
    if (IN(PH_NSA)) { ph_ygla_naive(p, bid, nblk); ph_nsa(p, lds, bid, nblk); }
    SEAM(PH_NSA);
    if (IN(PH_MERGE)) {
        pg8::StaticOrder S; S.init(NTOK, 1024, nblk, bid);
        { pg8::Gemm g{WSP(bf16_t, WS_YGLA), WSP(bf16_t, WS_PGLAT), NTOK, 1024, 1024}; EpiMerge<1> E{WSP(bf16_t, WS_PROJ), WSP(bf16_t, WS_T1), WSP(bf16_t, WS_MERG)};
          pg8::gemm_phase<EpiMerge<1>, pg8::StaticOrder, true, true>(lds, g, S, E); }
        asm volatile("s_waitcnt vmcnt(0)" ::: "memory"); __syncthreads();
        { pg8::Gemm g{WSP(bf16_t, WS_YNSA), WSP(bf16_t, WS_PNSAT), NTOK, 1024, 1024}; EpiMerge<2> E{WSP(bf16_t, WS_PROJ), WSP(bf16_t, WS_T1), WSP(bf16_t, WS_MERG)};
          pg8::gemm_phase<EpiMerge<2>, pg8::StaticOrder, true, true>(lds, g, S, E); }
    }
    SEAM(PH_MERGE);
    if (IN(PH_OUT)) {
        pg8::Gemm g{WSP(bf16_t, WS_MERG), WSP(bf16_t, WS_WOUTT), NTOK, 1024, 1024}; pg8::StaticOrder S; S.init(NTOK, 1024, nblk, bid);
        EpiOut E{p.x, WSP(float, WS_MOD), WSP(float, WS_H1)};
        pg8::gemm_phase<EpiOut, pg8::StaticOrder, true, true>(lds, g, S, E);
    }
    SEAM(PH_OUT);
    if (IN(PH_ROUTE)) ph_route(p, lds, bid, nblk);
    SEAM(PH_ROUTE);
    if (IN(PH_ASSIGN)) ph_assign(p, lds, bid, nblk);
    SEAM(PH_ASSIGN);
    if (IN(PH_MOE1)) {
        const int* ctl = WSP(int, WS_CTL);
        pg8::Gemm g{WSP(bf16_t, WS_XS), WSP(bf16_t, WS_W1T), PROWS, 2048, 1024};
        MoeOrder S{ctl[CT_PTOT] / 256, 8, nblk, bid, ctl + CT_BLKE, (size_t)2048 * 1024 * 2};
        EpiSwiglu E{p.moe_b1, WSP(bf16_t, WS_ACT)};
        pg8::gemm_phase<EpiSwiglu, MoeOrder, true, true>(lds, g, S, E);
    }
    SEAM(PH_MOE1);
    if (IN(PH_MOE2)) {
        const int* ctl = WSP(int, WS_CTL);
        pg8::Gemm g{WSP(bf16_t, WS_ACT), WSP(bf16_t, WS_W2T), PROWS, 1024, 1024};
        MoeOrder S{ctl[CT_PTOT] / 256, 4, nblk, bid, ctl + CT_BLKE, (size_t)1024 * 1024 * 2};
        EpiMoe2 E{p.moe_b2, WSP(bf16_t, WS_YSLOT)};
        pg8::gemm_phase<EpiMoe2, MoeOrder, true, true>(lds, g, S, E);
    }
    SEAM(PH_MOE2);
    if (IN(PH_FINAL)) ph_final(p, bid, nblk);
#undef IN
#undef SEAM
}

extern "C" void kernel_launch(void* const* d_in, const int* in_sizes, int n_in, void* d_out, int out_size, void* d_ws, size_t ws_size, hipStream_t stream) {
    static bool attr_done = false;
    if (!attr_done) { (void)hipFuncSetAttribute((const void*)mega, hipFuncAttributeMaxDynamicSharedMemorySize, MK_LDS_BYTES); attr_done = true; }
    Args a{};
    const float** pp = (const float**)&a.p;
    for (int i = 0; i < 23; ++i) pp[i] = (const float*)d_in[i];
    a.p.out = (float*)d_out; a.p.ws = (unsigned char*)d_ws;
    (void)hipMemsetAsync((char*)d_ws + WS_CTL, 0, 65536, stream);
    a.ph_lo = 0; a.ph_hi = PH_END;
    hipLaunchKernelGGL(mega, dim3(256), dim3(NTHR), MK_LDS_BYTES, stream, a);
}
```

```cpp
#include <hip/hip_runtime.h>
#include <stdint.h>
#include <math.h>

typedef unsigned short bf16_t;
typedef unsigned long long u64;

constexpr int BATCH = 4, SEQ = 4096, DM = 1024, NTOK = BATCH * SEQ;
constexpr int IN_COLS = 7720, PLD = 7936;
constexpr int C_GQ = 0, C_GK = 512, C_GV = 1024, C_GR = 2048, C_NQ = 3072, C_KC = 4096, C_VC = 4352, C_KS = 4608, C_VS = 4864,
              C_KW = 5120, C_VW = 5376, C_MG = 5632, C_GA = 7680, C_NG = 7696;
constexpr int NCMP = 255, NSEL = 64, NEXP = 32, TOPK = 4, MOEB = 256;
constexpr int PROWS = NTOK * TOPK + NEXP * MOEB;
constexpr float RMS_EPS = 1e-5f;

__host__ __device__ inline int orig_col(int j) {
    if (j < 3072) return j;
    if (j < 5632) return j + 16;
    if (j < 7680) return j + 40;
    if (j < 7696) return j - 4608;
    return j - 2048;
}

constexpr size_t MiB = 1u << 20;
constexpr size_t WS_CTL = 0;
constexpr size_t WS_MOD = 1 * MiB;
constexpr size_t WS_W1T = 2 * MiB;
constexpr size_t WS_W2T = 130 * MiB;
constexpr size_t WS_WINT = 194 * MiB;
constexpr size_t WS_PGLAT = 210 * MiB, WS_PNSAT = 212 * MiB, WS_WOUTT = 214 * MiB;
constexpr size_t WS_CW1T = 216 * MiB;
constexpr size_t WS_CW2T = 220 * MiB;
constexpr size_t WS_H1 = 221 * MiB;
constexpr size_t WS_U2 = 285 * MiB;
constexpr size_t WS_TOPE = 317 * MiB;
constexpr size_t WS_TOPW = 317 * MiB + 512 * 1024;
constexpr size_t WS_ROWTOK = 318 * MiB;
constexpr size_t WS_SLOTOF = 318 * MiB + 512 * 1024;
constexpr size_t WS_U1 = 320 * MiB;
constexpr size_t WS_PROJ = 352 * MiB;
constexpr size_t WS_LOGA = 600 * MiB;
constexpr size_t WS_OGLA = 632 * MiB;
constexpr size_t WS_YGLA = 696 * MiB;
constexpr size_t WS_HID = 728 * MiB;
constexpr size_t WS_KCVC = 732 * MiB;
constexpr size_t WS_SELM = 734 * MiB;
constexpr size_t WS_OCMP = 735 * MiB;
constexpr size_t WS_OSEL = 799 * MiB;
constexpr size_t WS_OWIN = 863 * MiB;
constexpr size_t WS_YNSA = 927 * MiB;
constexpr size_t WS_MERG = 959 * MiB;
constexpr size_t WS_T1 = 991 * MiB;
constexpr size_t WS_TMPF = 600 * MiB;
constexpr size_t WS_XS = 320 * MiB;
constexpr size_t WS_ACT = 464 * MiB;
constexpr size_t WS_YSLOT = 608 * MiB;
constexpr int CT_CNT = 0, CT_FILL = 64, CT_PSTART = 128, CT_PTOT = 192, CT_BLKE = 256;

__device__ __forceinline__ float bf2f(bf16_t v) { return __uint_as_float(((unsigned)v) << 16); }
__device__ __forceinline__ bf16_t f2bf(float f) { unsigned u = __float_as_uint(f); return (bf16_t)((u + 0x7fffu + ((u >> 16) & 1u)) >> 16); }
__device__ __forceinline__ float sigmoidf_(float x) { return 1.f / (1.f + __expf(-x)); }
__device__ __forceinline__ float siluf_(float x) { return x / (1.f + __expf(-x)); }
__device__ __forceinline__ float wave_sum(float v) {
#pragma unroll
    for (int o = 1; o < 64; o <<= 1) v += __shfl_xor(v, o);
    return v;
}
__device__ __forceinline__ float wave_max(float v) {
#pragma unroll
    for (int o = 1; o < 64; o <<= 1) v = fmaxf(v, __shfl_xor(v, o));
    return v;
}

struct P {
    const float *x, *c, *w_ada, *b_ada, *norm1_g, *w_in, *gla_wa2, *gla_ba, *gla_norm_g, *cmp_pe, *cmp_w1, *cmp_w2, *proj_gla, *proj_nsa,
        *w_out, *norm2_g, *router_w, *router_b, *moe_w1, *moe_b1, *moe_w2, *moe_b2, *final_g;
    float* out;
    unsigned char* ws;
};
#define WSP(T, off) ((T*)(p.ws + (off)))

__global__ void __launch_bounds__(256) k_mod(P p) {
    __shared__ float sc[4 * 1024];
    for (int i = threadIdx.x; i < 4096; i += 256) sc[i] = siluf_(p.c[i]);
    __syncthreads();
    const int j = blockIdx.x * 256 + threadIdx.x;
    float a0 = 0, a1 = 0, a2 = 0, a3 = 0;
    for (int k = 0; k < 1024; ++k) { const float w = p.w_ada[(size_t)k * 6144 + j]; a0 += sc[k] * w; a1 += sc[1024 + k] * w; a2 += sc[2048 + k] * w; a3 += sc[3072 + k] * w; }
    float* mod = WSP(float, WS_MOD); const float bb = p.b_ada[j];
    mod[j] = a0 + bb; mod[6144 + j] = a1 + bb; mod[2 * 6144 + j] = a2 + bb; mod[3 * 6144 + j] = a3 + bb;
}

__global__ void __launch_bounds__(256) k_u1(P p) {
    const int row = blockIdx.x * 4 + (threadIdx.x >> 6), lane = threadIdx.x & 63, b = row / SEQ;
    const float* xr = p.x + (size_t)row * DM; const float* mod = WSP(float, WS_MOD) + b * 6144;
    float v[16]; float ss = 0.f;
#pragma unroll
    for (int i = 0; i < 16; ++i) { v[i] = xr[lane + 64 * i]; ss += v[i] * v[i]; }
    const float rstd = rsqrtf(wave_sum(ss) * (1.f / DM) + RMS_EPS);
    bf16_t* u = WSP(bf16_t, WS_U1) + (size_t)row * DM;
#pragma unroll
    for (int i = 0; i < 16; ++i) { const int col = lane + 64 * i; u[col] = f2bf(v[i] * rstd * p.norm1_g[col] * (1.f + mod[1024 + col]) + mod[col]); }
}

template <class F, bool DUAL>
__global__ void __launch_bounds__(256) sgemm_k(F f, P p) {
    __shared__ float As[16][68]; __shared__ float Bs[16][68]; __shared__ float Bs2[16][68];
    const int tid = threadIdx.x, tx = tid & 15, ty = tid >> 4;
    const int m0 = blockIdx.y * 64, n0 = blockIdx.x * 64;
    if (!f.init(p, m0)) return;
    float acc[4][4], acc2[4][4];
#pragma unroll
    for (int i = 0; i < 4; ++i)
#pragma unroll
        for (int j = 0; j < 4; ++j) { acc[i][j] = 0.f; acc2[i][j] = 0.f; }
    const int K = f.K;
    for (int k0 = 0; k0 < K; k0 += 16) {
        { const int r = tid >> 2, kq = (tid & 3) * 4;
#pragma unroll
          for (int i = 0; i < 4; ++i) As[kq + i][r] = f.a(p, m0 + r, k0 + kq + i); }
        { const int kk = tid >> 4, cc = (tid & 15) * 4;
#pragma unroll
          for (int i = 0; i < 4; ++i) { Bs[kk][cc + i] = f.b(p, k0 + kk, n0 + cc + i); if (DUAL) Bs2[kk][cc + i] = f.b2(p, k0 + kk, n0 + cc + i); } }
        __syncthreads();
#pragma unroll
        for (int kk = 0; kk < 16; ++kk) {
            float a[4], b[4], b2[4];
#pragma unroll
            for (int i = 0; i < 4; ++i) { a[i] = As[kk][ty * 4 + i]; b[i] = Bs[kk][tx * 4 + i]; b2[i] = DUAL ? Bs2[kk][tx * 4 + i] : 0.f; }
#pragma unroll
            for (int i = 0; i < 4; ++i)
#pragma unroll
                for (int j = 0; j < 4; ++j) { acc[i][j] += a[i] * b[j]; if (DUAL) acc2[i][j] += a[i] * b2[j]; }
        }
        __syncthreads();
    }
#pragma unroll
    for (int i = 0; i < 4; ++i)
#pragma unroll
        for (int j = 0; j < 4; ++j) f.store(p, m0 + ty * 4 + i, n0 + tx * 4 + j, acc[i][j], acc2[i][j]);
}

struct F_inproj {
    int K;
    __device__ bool init(const P&, int) { return true; }
    __device__ float a(const P& p, int r, int k) const { return bf2f(WSP(bf16_t, WS_U1)[(size_t)r * DM + k]); }
    __device__ float b(const P& p, int k, int c) const { return c < IN_COLS ? p.w_in[(size_t)k * IN_COLS + orig_col(c)] : 0.f; }
    __device__ float b2(const P&, int, int) const { return 0.f; }
    __device__ void store(const P& p, int r, int c, float v, float) const { WSP(bf16_t, WS_PROJ)[(size_t)r * PLD + c] = f2bf(v); }
};
__device__ __forceinline__ float gelu_tanh(float x) { const float u = 0.7978845608028654f * (x + 0.044715f * x * x * x); return 0.5f * x * (1.f + tanhf(u)); }
struct F_cmp1 {
    int K, which;
    __device__ bool init(const P&, int) { return true; }
    __device__ float a(const P& p, int r, int k) const {
        if (r >= 2040) return 0.f;
        const int b = r / 510, g = (r / 255) & 1, c = r % 255, l = k >> 7, d = k & 127;
        const size_t tok = (size_t)b * SEQ + 16 * c + l;
        return bf2f(WSP(bf16_t, WS_PROJ)[tok * PLD + (which ? C_VC : C_KC) + g * 128 + d]) + p.cmp_pe[(which * 32 + l) * 128 + d];
    }
    __device__ float b(const P& p, int k, int c) const { return p.cmp_w1[((size_t)which * 4096 + k) * 256 + c]; }
    __device__ float b2(const P&, int, int) const { return 0.f; }
    __device__ void store(const P& p, int r, int c, float v, float) const { if (r < 2040) WSP(float, WS_HID)[((size_t)which * 2040 + r) * 256 + c] = gelu_tanh(v); }
};
struct F_cmp2 {
    int K, which;
    __device__ bool init(const P&, int) { return true; }
    __device__ float a(const P& p, int r, int k) const { return r < 2040 ? WSP(float, WS_HID)[((size_t)which * 2040 + r) * 256 + k] : 0.f; }
    __device__ float b(const P& p, int k, int c) const { return p.cmp_w2[((size_t)which * 256 + k) * 128 + c]; }
    __device__ float b2(const P&, int, int) const { return 0.f; }
    __device__ void store(const P& p, int r, int c, float v, float) const {
        if (r >= 2040) return;
        const int b = r / 510, g = (r / 255) & 1, cc = r % 255;
        WSP(bf16_t, WS_KCVC)[((((size_t)which * 4 + b) * 2 + g) * 256 + cc) * 128 + c] = f2bf(v);
    }
};
struct F_merge1 {
    int K;
    __device__ bool init(const P&, int) { return true; }
    __device__ float a(const P& p, int r, int k) const { return bf2f(WSP(bf16_t, WS_YGLA)[(size_t)r * DM + k]); }
    __device__ float b(const P& p, int k, int c) const { return p.proj_gla[(size_t)k * DM + c]; }
    __device__ float b2(const P&, int, int) const { return 0.f; }
    __device__ void store(const P& p, int r, int c, float v, float) const {
        const float mg = sigmoidf_(bf2f(WSP(bf16_t, WS_PROJ)[(size_t)r * PLD + C_MG + c]));
        WSP(float, WS_TMPF)[(size_t)r * DM + c] = mg * v;
    }
};
struct F_merge2 {
    int K;
    __device__ bool init(const P&, int) { return true; }
    __device__ float a(const P& p, int r, int k) const { return bf2f(WSP(bf16_t, WS_YNSA)[(size_t)r * DM + k]); }
    __device__ float b(const P& p, int k, int c) const { return p.proj_nsa[(size_t)k * DM + c]; }
    __device__ float b2(const P&, int, int) const { return 0.f; }
    __device__ void store(const P& p, int r, int c, float v, float) const {
        const float mg = sigmoidf_(bf2f(WSP(bf16_t, WS_PROJ)[(size_t)r * PLD + C_MG + 1024 + c]));
        WSP(bf16_t, WS_MERG)[(size_t)r * DM + c] = f2bf(WSP(float, WS_TMPF)[(size_t)r * DM + c] + mg * v);
    }
};
struct F_out {
    int K;
    __device__ bool init(const P&, int) { return true; }
    __device__ float a(const P& p, int r, int k) const { return bf2f(WSP(bf16_t, WS_MERG)[(size_t)r * DM + k]); }
    __device__ float b(const P& p, int k, int c) const { return p.w_out[(size_t)k * DM + c]; }
    __device__ float b2(const P&, int, int) const { return 0.f; }
    __device__ void store(const P& p, int r, int c, float v, float) const {
        const int b = r / SEQ; const float gate1 = WSP(float, WS_MOD)[b * 6144 + 2048 + c];
        WSP(float, WS_H1)[(size_t)r * DM + c] = p.x[(size_t)r * DM + c] + gate1 * v;
    }
};
struct F_moe1 {
    int K; int e;
    __device__ bool init(const P& p, int m0) { const int* ctl = WSP(int, WS_CTL); if (m0 >= ctl[CT_PTOT]) return false; e = ctl[CT_BLKE + m0 / MOEB]; return true; }
    __device__ float a(const P& p, int r, int k) const { const int tok = WSP(int, WS_ROWTOK)[r]; return tok < 0 ? 0.f : bf2f(WSP(bf16_t, WS_U2)[(size_t)tok * DM + k]); }
    __device__ float b(const P& p, int k, int c) const { return p.moe_w1[((size_t)e * DM + k) * 2048 + c]; }
    __device__ float b2(const P& p, int k, int c) const { return p.moe_w1[((size_t)e * DM + k) * 2048 + 1024 + c]; }
    __device__ void store(const P& p, int r, int c, float g, float u) const {
        g += p.moe_b1[e * 2048 + c]; u += p.moe_b1[e * 2048 + 1024 + c];
        g = fminf(g, 7.f); u = fminf(fmaxf(u, -7.f), 7.f);
        WSP(bf16_t, WS_ACT)[(size_t)r * DM + c] = f2bf(g * sigmoidf_(1.702f * g) * (u + 1.f));
    }
};
struct F_moe2 {
    int K; int e;
    __device__ bool init(const P& p, int m0) { const int* ctl = WSP(int, WS_CTL); if (m0 >= ctl[CT_PTOT]) return false; e = ctl[CT_BLKE + m0 / MOEB]; return true; }
    __device__ float a(const P& p, int r, int k) const { return bf2f(WSP(bf16_t, WS_ACT)[(size_t)r * DM + k]); }
    __device__ float b(const P& p, int k, int c) const { return p.moe_w2[((size_t)e * DM + k) * DM + c]; }
    __device__ float b2(const P&, int, int) const { return 0.f; }
    __device__ void store(const P& p, int r, int c, float v, float) const { WSP(bf16_t, WS_YSLOT)[(size_t)r * DM + c] = f2bf(v + p.moe_b2[e * DM + c]); }
};

__global__ void __launch_bounds__(256) k_loga(P p) {
    const int row = blockIdx.x >> 1, j = (blockIdx.x & 1) * 256 + threadIdx.x;
    const bf16_t* pr = WSP(bf16_t, WS_PROJ) + (size_t)row * PLD + C_GA;
    float xx = p.gla_ba[j];
#pragma unroll
    for (int r = 0; r < 16; ++r) xx += bf2f(pr[r]) * p.gla_wa2[r * 512 + j];
    const float ls = fminf(xx, 0.f) - log1pf(__expf(-fabsf(xx)));
    WSP(float, WS_LOGA)[(size_t)row * 512 + j] = ls * (1.f / 16.f);
}
__global__ void __launch_bounds__(256) k_gla(P p) {
    const int blk = blockIdx.x, b = blk >> 6, h = (blk >> 4) & 3, vg = blk & 15;
    const int tid = threadIdx.x, vl = tid >> 4, kg = tid & 15;
    const int vcol = h * 256 + vg * 16 + vl;
    float S[8];
#pragma unroll
    for (int i = 0; i < 8; ++i) S[i] = 0.f;
    const bf16_t* proj = WSP(bf16_t, WS_PROJ); const float* loga = WSP(float, WS_LOGA); float* og = WSP(float, WS_OGLA);
    for (int t = 0; t < SEQ; ++t) {
        const size_t row = (size_t)b * SEQ + t;
        const bf16_t* pr = proj + row * PLD;
        const float vv = bf2f(pr[C_GV + vcol]);
        float part = 0.f;
#pragma unroll
        for (int i = 0; i < 8; ++i) {
            const int d = h * 128 + kg * 8 + i;
            const float a = __expf(loga[row * 512 + d]);
            S[i] = a * S[i] + bf2f(pr[C_GK + d]) * vv;
            part += bf2f(pr[C_GQ + d]) * S[i];
        }
        part += __shfl_xor(part, 1); part += __shfl_xor(part, 2); part += __shfl_xor(part, 4); part += __shfl_xor(part, 8);
        if (kg == 0) og[row * DM + vcol] = part * 0.08838834764831845f;
    }
}
__global__ void __launch_bounds__(256) k_ygla(P p) {
    const int w = blockIdx.x * 4 + (threadIdx.x >> 6), lane = threadIdx.x & 63, row = w >> 2, h = w & 3;
    const float* o = WSP(float, WS_OGLA) + (size_t)row * DM + h * 256;
    float v[4]; float ss = 0.f;
#pragma unroll
    for (int i = 0; i < 4; ++i) { v[i] = o[lane + 64 * i]; ss += v[i] * v[i]; }
    const float rstd = rsqrtf(wave_sum(ss) * (1.f / 256.f) + RMS_EPS);
    const bf16_t* pr = WSP(bf16_t, WS_PROJ) + (size_t)row * PLD + C_GR + h * 256;
    bf16_t* y = WSP(bf16_t, WS_YGLA) + (size_t)row * DM + h * 256;
#pragma unroll
    for (int i = 0; i < 4; ++i) { const int dv = lane + 64 * i; y[dv] = f2bf(v[i] * rstd * p.gla_norm_g[dv] * siluf_(bf2f(pr[dv]))); }
}

constexpr float ATT_SCALE = 0.08838834764831845f;
__global__ void __launch_bounds__(256) k_cmpattn(P p) {
    __shared__ float sq[4][128]; __shared__ float sp[4][256]; __shared__ float sps[4][256];
    const int wid = threadIdx.x >> 6, lane = threadIdx.x & 63;
    const int w = blockIdx.x * 4 + wid, b = w >> 13, g = (w >> 12) & 1, t = w & 4095;
    const size_t row = (size_t)b * SEQ + t;
    const bf16_t* pr = WSP(bf16_t, WS_PROJ) + row * PLD;
    const bf16_t* kc = WSP(bf16_t, WS_KCVC) + (((size_t)0 * 4 + b) * 2 + g) * 256 * 128;
    const bf16_t* vc = WSP(bf16_t, WS_KCVC) + (((size_t)1 * 4 + b) * 2 + g) * 256 * 128;
    const int ncv = t >= 31 ? (t - 31) / 16 + 1 : 0;
    float* q = sq[wid]; float* pp = sp[wid]; float* ps = sps[wid];
    for (int i = 0; i < 4; ++i) ps[lane + 64 * i] = 0.f;
    for (int r = 0; r < 4; ++r) {
        const int hq = g * 4 + r;
        q[lane] = bf2f(pr[C_NQ + hq * 128 + lane]); q[lane + 64] = bf2f(pr[C_NQ + hq * 128 + 64 + lane]);
        __builtin_amdgcn_wave_barrier();
        float s[4]; float m = -INFINITY;
        for (int i = 0; i < 4; ++i) {
            const int c = lane + 64 * i; s[i] = -INFINITY;
            if (c < ncv) { float a = 0.f; for (int d = 0; d < 128; ++d) a += q[d] * bf2f(kc[c * 128 + d]); s[i] = a * ATT_SCALE; }
            m = fmaxf(m, s[i]);
        }
        m = wave_max(m);
        float e[4]; float sum = 0.f;
        for (int i = 0; i < 4; ++i) { const int c = lane + 64 * i; e[i] = (c < ncv) ? __expf(s[i] - m) : 0.f; sum += e[i]; }
        sum = wave_sum(sum);
        const float inv = 1.f / fmaxf(sum, 1e-30f);
        for (int i = 0; i < 4; ++i) { const int c = lane + 64 * i; const float pv = e[i] * inv; pp[c] = pv; ps[c] += pv; }
        __builtin_amdgcn_wave_barrier();
        float o0 = 0.f, o1 = 0.f;
        for (int c = 0; c < ncv; ++c) { const float pv = pp[c]; o0 += pv * bf2f(vc[c * 128 + lane]); o1 += pv * bf2f(vc[c * 128 + 64 + lane]); }
        float* oc = WSP(float, WS_OCMP) + row * DM + hq * 128;
        oc[lane] = o0; oc[lane + 64] = o1;
        __builtin_amdgcn_wave_barrier();
    }
    const int s = lane, tb = t >> 6;
    float imp = 0.f;
    for (int c = 4 * s - 1; c <= 4 * s + 3; ++c) if (c >= 0 && c < NCMP) imp += ps[c];
    const bool forced = (s == 0) || (s == tb) || (s == tb - 1), valid = s <= tb;
    const float score = forced ? INFINITY : (valid ? imp : -INFINITY);
    int rank = 0;
    for (int j = 0; j < 64; ++j) { const float sj = __shfl(score, j); rank += (sj > score) || (sj == score && j < s); }
    const bool sel = rank < 16 && score > -INFINITY;
    const u64 mask = __ballot(sel);
    if (lane == 0) WSP(u64, WS_SELM)[(b * 2 + g) * SEQ + t] = mask;
}
template <bool WIN>
__global__ void __launch_bounds__(256) k_sparseattn(P p) {
    __shared__ float sq[4][128]; __shared__ float sp[4][1024];
    const int wid = threadIdx.x >> 6, lane = threadIdx.x & 63;
    const int w = blockIdx.x * 4 + wid, b = w >> 13, g = (w >> 12) & 1, t = w & 4095;
    const size_t row = (size_t)b * SEQ + t;
    const bf16_t* proj = WSP(bf16_t, WS_PROJ);
    const bf16_t* pr = proj + row * PLD;
    const int kcol = (WIN ? C_KW : C_KS) + g * 128, vcol = (WIN ? C_VW : C_VS) + g * 128;
    const u64 mask = WIN ? 0ull : WSP(u64, WS_SELM)[(b * 2 + g) * SEQ + t];
    const int nch = WIN ? 8 : __popcll(mask);
    int base[16];
    { u64 mm = mask;
#pragma unroll
      for (int jj = 0; jj < 16; ++jj) { if (WIN) base[jj] = t - 511 + jj * 64; else { const int bi = mm ? __ffsll((long long)mm) - 1 : 0; base[jj] = bi * 64; mm &= mm - 1; } } }
    float* q = sq[wid]; float* pp = sp[wid];
    for (int r = 0; r < 4; ++r) {
        const int hq = g * 4 + r;
        q[lane] = bf2f(pr[C_NQ + hq * 128 + lane]); q[lane + 64] = bf2f(pr[C_NQ + hq * 128 + 64 + lane]);
        __builtin_amdgcn_wave_barrier();
        float s[16]; float m = -INFINITY;
#pragma unroll
        for (int jj = 0; jj < 16; ++jj) {
            s[jj] = -INFINITY;
            if (jj < nch) { const int pos = base[jj] + lane;
                if (pos >= 0 && pos <= t) { const bf16_t* kr = proj + ((size_t)b * SEQ + pos) * PLD + kcol; float a = 0.f; for (int d = 0; d < 128; ++d) a += q[d] * bf2f(kr[d]); s[jj] = a * ATT_SCALE; } }
            m = fmaxf(m, s[jj]);
        }
        m = wave_max(m);
        float sum = 0.f;
#pragma unroll
        for (int jj = 0; jj < 16; ++jj) { s[jj] = (s[jj] > -INFINITY) ? __expf(s[jj] - m) : 0.f; sum += s[jj]; }
        sum = wave_sum(sum);
        const float inv = 1.f / fmaxf(sum, 1e-30f);
#pragma unroll
        for (int jj = 0; jj < 16; ++jj) pp[jj * 64 + lane] = s[jj] * inv;
        __builtin_amdgcn_wave_barrier();
        float o0 = 0.f, o1 = 0.f;
#pragma unroll
        for (int jj = 0; jj < 16; ++jj) {
            if (jj < nch) {
                for (int l = 0; l < 64; ++l) {
                    const float pv = pp[jj * 64 + l];
                    int pos = base[jj] + l; pos = pos < 0 ? 0 : (pos > SEQ - 1 ? SEQ - 1 : pos);
                    const bf16_t* vr = proj + ((size_t)b * SEQ + pos) * PLD + vcol;
                    o0 += pv * bf2f(vr[lane]); o1 += pv * bf2f(vr[64 + lane]);
                }
            }
        }
        float* oo = WSP(float, WIN ? WS_OWIN : WS_OSEL) + row * DM + hq * 128;
        oo[lane] = o0; oo[lane + 64] = o1;
        __builtin_amdgcn_wave_barrier();
    }
}
__global__ void __launch_bounds__(256) k_ynsa(P p) {
    const size_t idx = (size_t)blockIdx.x * 256 + threadIdx.x; const size_t row = idx >> 10; const int col = (int)(idx & 1023), hq = col >> 7;
    const bf16_t* pr = WSP(bf16_t, WS_PROJ) + row * PLD + C_NG + hq * 3;
    const float g0 = sigmoidf_(bf2f(pr[0])), g1 = sigmoidf_(bf2f(pr[1])), g2 = sigmoidf_(bf2f(pr[2]));
    WSP(bf16_t, WS_YNSA)[idx] = f2bf(g0 * WSP(float, WS_OCMP)[idx] + g1 * WSP(float, WS_OSEL)[idx] + g2 * WSP(float, WS_OWIN)[idx]);
}

__global__ void __launch_bounds__(256) k_route(P p) {
    __shared__ float su[4][1024];
    const int wid = threadIdx.x >> 6, lane = threadIdx.x & 63, row = blockIdx.x * 4 + wid, b = row / SEQ;
    const float* hr = WSP(float, WS_H1) + (size_t)row * DM; const float* mod = WSP(float, WS_MOD) + b * 6144;
    float v[16]; float ss = 0.f;
#pragma unroll
    for (int i = 0; i < 16; ++i) { v[i] = hr[lane + 64 * i]; ss += v[i] * v[i]; }
    const float rstd = rsqrtf(wave_sum(ss) * (1.f / DM) + RMS_EPS);
    bf16_t* u = WSP(bf16_t, WS_U2) + (size_t)row * DM; float* uu = su[wid];
#pragma unroll
    for (int i = 0; i < 16; ++i) { const int col = lane + 64 * i; const float val = v[i] * rstd * p.norm2_g[col] * (1.f + mod[4096 + col]) + mod[3072 + col]; uu[col] = val; u[col] = f2bf(val); }
    __builtin_amdgcn_wave_barrier();
    const int e = lane & 31, kh = lane >> 5;
    float acc = 0.f;
    for (int k = kh * 512; k < kh * 512 + 512; ++k) acc += uu[k] * p.router_w[k * 32 + e];
    acc += __shfl_xor(acc, 32);
    float logit = acc + p.router_b[e];
    int rank = 0;
    for (int j = 0; j < 32; ++j) { const float lj = __shfl(logit, j); rank += (lj > logit) || (lj == logit && j < e); }
    const float mx = wave_max(logit);
    const bool sel = rank < 4;
    const float ex = sel ? __expf(logit - mx) : 0.f;
    float sum = ex; for (int o = 1; o < 32; o <<= 1) sum += __shfl_xor(sum, o);
    if (sel && lane < 32) {
        WSP(int, WS_TOPE)[row * 4 + rank] = e; WSP(float, WS_TOPW)[row * 4 + rank] = ex / sum;
        atomicAdd(WSP(int, WS_CTL) + CT_CNT + e, 1);
    }
}
__global__ void k_offsets(P p) {
    if (threadIdx.x != 0) return;
    int* ctl = WSP(int, WS_CTL); int ps = 0;
    for (int e = 0; e < NEXP; ++e) { ctl[CT_PSTART + e] = ps; const int nb = (ctl[CT_CNT + e] + MOEB - 1) / MOEB; for (int i = 0; i < nb; ++i) ctl[CT_BLKE + ps / MOEB + i] = e; ps += nb * MOEB; }
    ctl[CT_PSTART + NEXP] = ps; ctl[CT_PTOT] = ps;
}
__global__ void __launch_bounds__(256) k_assign(P p) {
    const int idx = blockIdx.x * 256 + threadIdx.x;
    int* ctl = WSP(int, WS_CTL);
    const int e = WSP(int, WS_TOPE)[idx];
    const int pos = ctl[CT_PSTART + e] + atomicAdd(ctl + CT_FILL + e, 1);
    WSP(int, WS_ROWTOK)[pos] = idx >> 2; WSP(int, WS_SLOTOF)[idx] = pos;
}
__global__ void __launch_bounds__(256) k_final(P p) {
    const int row = blockIdx.x * 4 + (threadIdx.x >> 6), lane = threadIdx.x & 63, b = row / SEQ;
    const float* hr = WSP(float, WS_H1) + (size_t)row * DM; const float* mod = WSP(float, WS_MOD) + b * 6144;
    const int* so = WSP(int, WS_SLOTOF) + row * 4; const float* tw = WSP(float, WS_TOPW) + row * 4;
    const bf16_t* ys = WSP(bf16_t, WS_YSLOT);
    float v[16]; float ss = 0.f;
#pragma unroll
    for (int i = 0; i < 16; ++i) {
        const int col = lane + 64 * i; float m = 0.f;
        for (int k = 0; k < 4; ++k) m += tw[k] * bf2f(ys[(size_t)so[k] * DM + col]);
        v[i] = hr[col] + mod[5120 + col] * m; ss += v[i] * v[i];
    }
    const float rstd = rsqrtf(wave_sum(ss) * (1.f / DM) + RMS_EPS);
#pragma unroll
    for (int i = 0; i < 16; ++i) { const int col = lane + 64 * i; p.out[(size_t)row * DM + col] = v[i] * rstd * p.final_g[col]; }
}

namespace pg8 {
#define PG8_LAS __attribute__((address_space(3)))
typedef unsigned short bf16_t;
typedef short bf16x8 __attribute__((ext_vector_type(8)));
typedef float f32x4 __attribute__((ext_vector_type(4)));
typedef unsigned u32x4 __attribute__((ext_vector_type(4)));
constexpr int BM = 256, BK = 64, HALF = 128, HTB = HALF * BK * 2  , STAGE_BYTES = 8 * HTB, NXCD = 8, WGM = 8;

__host__ __device__ __forceinline__ int lds_byte(int r, int c) { const int st = (r >> 4) * 2 + (c >> 5), rr = r & 15, cc = c & 31, ob = rr * 64 + cc * 2; return st * 1024 + (ob ^ (((ob >> 9) & 1) << 5)); }
__host__ __device__ __forceinline__ void stage_rc(int b, int& R, int& C) { const int st = b / 1024, sb = b % 1024, swz = sb ^ (((sb >> 9) & 1) << 5); R = (st >> 1) * 16 + swz / 64; C = (st & 1) * 32 + (swz % 64) / 2; }
__host__ __device__ __forceinline__ int perm32(int rho) { const int n = rho >> 4, i = rho & 15; return 8 * (i >> 2) + 4 * n + (i & 3); }

struct Unit { int pm, pn, e; };
struct Gemm { const bf16_t* A; const bf16_t* Bt; int M, N, K, ld; };

struct StaticOrder {
    int nM, nN, nwg, G, c;
    __host__ __device__ void init(int M, int N, int G_, int c_) { nM = M / BM; nN = N / BM; nwg = nM * nN; G = G_; c = c_; }
    __host__ __device__ bool next(int i, Unit& u) const {
        const long L = (long)i * G + c; if (L >= nwg) return false;
        int wgid = (int)L; { const int q = nwg / NXCD, r = nwg % NXCD, xcd = wgid % NXCD, off = wgid / NXCD; wgid = (xcd < r ? xcd * (q + 1) : r * (q + 1) + (xcd - r) * q) + off; }
        const int nig = WGM * nN, gid = wgid / nig, fm = gid * WGM, gsz = (nM - fm) < WGM ? (nM - fm) : WGM;
        u.pm = fm + ((wgid % nig) % gsz); u.pn = (wgid % nig) / gsz; u.e = 0; return true;
    }
    __device__ __forceinline__ void a_ready(const Unit&) const {}
    __device__ __forceinline__ void done(const Unit&) const {}
    __device__ __forceinline__ const char* abase(const Gemm& g, const Unit& u, size_t tstep) const { return (const char*)g.A + (size_t)u.pm * tstep; }
    __device__ __forceinline__ const char* bbase(const Gemm& g, const Unit& u, size_t tstep) const { return (const char*)g.Bt + (size_t)u.pn * tstep; }
};

template <class Epi, class Sched, bool ALIGN_EPI = false, bool SP2 = false>
__device__ __forceinline__ void gemm_phase(PG8_LAS unsigned char* lds, const Gemm g, const Sched& S, const Epi& E) {
    int tid_ = threadIdx.x; asm volatile("" : "+v"(tid_));
    const int tid = tid_, wid = __builtin_amdgcn_readfirstlane(tid >> 6), lane = tid & 63, wr = wid >> 2, wc = wid & 3, fr = lane & 15, fq = lane >> 4;
    const int K = g.ld, nt = g.K / BK;
    unsigned voffA[2], voffB[2];
#pragma unroll
    for (int i = 0; i < 2; ++i) { int R, C; stage_rc(tid * 16 + i * 8192, R, C); const int Rb = Epi::PERM ? ((R & ~31) + perm32(R & 31)) : R;
        voffA[i] = (unsigned)(R * K + C) * 2u; voffB[i] = (unsigned)(Rb * K + C) * 2u; }
    const size_t kstep = (size_t)(BK * 2);
    const size_t hstep = (size_t)HALF * K * 2;
    const size_t tstep = 2 * hstep;
    const unsigned ldsw = (unsigned)wid * 1024u;
    const int aoff = lds_byte(wr * 64 + fr, fq * 8), boff = lds_byte(wc * 32 + fr, fq * 8);
#define PG8_SA(b, h) (((b) * 2 + (h)) * HTB)
#define PG8_SB(b, h) ((4 + (b) * 2 + (h)) * HTB)
#define PG8_STAGE(bufoff, gbase, voff) do { _Pragma("unroll") for (int _i = 0; _i < 2; ++_i) \
        __builtin_amdgcn_global_load_lds((const unsigned*)((const char*)(gbase) + (voff)[_i]), (PG8_LAS unsigned*)(lds + (bufoff) + ldsw + _i * 8192), 16, 0, 0); } while (0)
#define PG8_LDA(dst, b, h) do { _Pragma("unroll") for (int m = 0; m < 4; ++m) _Pragma("unroll") for (int k = 0; k < 2; ++k) dst[m][k] = *(const PG8_LAS bf16x8*)(lds + PG8_SA(b, h) + aoff + m * 2048 + k * 1024); } while (0)
#define PG8_LDB(dst, b, h) do { _Pragma("unroll") for (int n = 0; n < 2; ++n) _Pragma("unroll") for (int k = 0; k < 2; ++k) dst[n][k] = *(const PG8_LAS bf16x8*)(lds + PG8_SB(b, h) + boff + n * 2048 + k * 1024); } while (0)
#define PG8_MMA(ai, bj, At, Bt) do { __builtin_amdgcn_s_setprio(1); _Pragma("unroll") for (int m = 0; m < 4; ++m) _Pragma("unroll") for (int n = 0; n < 2; ++n) _Pragma("unroll") for (int k = 0; k < 2; ++k) \
        acc[ai][bj][m][n] = __builtin_amdgcn_mfma_f32_16x16x32_bf16(Bt[n][k], At[m][k], acc[ai][bj][m][n], 0, 0, 0); __builtin_amdgcn_s_setprio(0); } while (0)
#define PG8_WAIT_V(n) asm volatile("s_waitcnt vmcnt(" #n ")" ::: "memory")
#define PG8_WAIT_L(n) asm volatile("s_waitcnt lgkmcnt(" #n ")" ::: "memory")
#define PG8_BAR __builtin_amdgcn_s_barrier()
#define PG8_SCHED __builtin_amdgcn_sched_barrier(0)
    Unit cur, nxt; int ui = 0;
    if (!S.next(0, cur)) return;
    f32x4 acc[2][2][4][2];
#pragma unroll
    for (int a = 0; a < 2; ++a)
#pragma unroll
        for (int b = 0; b < 2; ++b)
#pragma unroll
            for (int m = 0; m < 4; ++m)
#pragma unroll
                for (int n = 0; n < 2; ++n) acc[a][b][m][n] = (f32x4){0.f, 0.f, 0.f, 0.f};
    bf16x8 At[4][2], B0[2][2], B1[2][2];
    const char* cA = S.abase(g, cur, tstep); const char* cB = S.bbase(g, cur, tstep);
    S.a_ready(cur);
    if constexpr (SP2) {
        PG8_STAGE(PG8_SB(0, 0), cB, voffB); PG8_STAGE(PG8_SB(0, 1), cB + hstep, voffB); PG8_STAGE(PG8_SA(0, 0), cA, voffA); PG8_STAGE(PG8_SA(0, 1), cA + hstep, voffA);
        if (wr == 1) PG8_BAR;
        PG8_WAIT_V(2); PG8_BAR;
        PG8_STAGE(PG8_SB(1, 0), cB + kstep, voffB); PG8_STAGE(PG8_SA(1, 0), cA + kstep, voffA); PG8_STAGE(PG8_SB(1, 1), cB + hstep + kstep, voffB);
        PG8_WAIT_V(6); PG8_BAR;
    } else {
        PG8_STAGE(PG8_SB(0, 0), cB, voffB); PG8_STAGE(PG8_SA(0, 0), cA, voffA); PG8_STAGE(PG8_SB(0, 1), cB + hstep, voffB); PG8_STAGE(PG8_SA(0, 1), cA + hstep, voffA);
        if (wr == 1) PG8_BAR;
        PG8_WAIT_V(4); PG8_BAR;
        PG8_STAGE(PG8_SB(1, 0), cB + kstep, voffB); PG8_STAGE(PG8_SA(1, 0), cA + kstep, voffA); PG8_STAGE(PG8_SB(1, 1), cB + hstep + kstep, voffB);
        PG8_WAIT_V(6); PG8_BAR;
    }
    for (;;) {
        const bool has_next = S.next(ui + 1, nxt);
        const char* nA = has_next ? S.abase(g, nxt, tstep) : cA; const char* nB = has_next ? S.bbase(g, nxt, tstep) : cB;
        for (int t = 0; t < nt; t += 2) {
            const bool last = (t == nt - 2);
            const char* a1 = cA + (size_t)(t + 1) * kstep;
            const char* a2 = last ? nA : cA + (size_t)(t + 2) * kstep; const char* b2 = last ? nB : cB + (size_t)(t + 2) * kstep;
            const char* a3 = a2 + kstep; const char* b3 = b2 + kstep;
            if (last && has_next) S.a_ready(nxt);
            if constexpr (SP2) {
            PG8_LDB(B0, 0, 0); PG8_LDB(B1, 0, 1); PG8_SCHED; PG8_LDA(At, 0, 0); PG8_STAGE(PG8_SA(1, 1), a1 + hstep, voffA);
            PG8_WAIT_V(8); PG8_WAIT_L(0); PG8_BAR; PG8_MMA(0, 0, At, B0); PG8_MMA(0, 1, At, B1); PG8_BAR; PG8_SCHED;
            PG8_LDA(At, 0, 1); PG8_STAGE(PG8_SB(0, 0), b2, voffB); PG8_STAGE(PG8_SB(0, 1), b2 + hstep, voffB); PG8_STAGE(PG8_SA(0, 0), a2, voffA);
            PG8_WAIT_V(8); PG8_WAIT_L(0); PG8_BAR; PG8_MMA(1, 0, At, B0); PG8_MMA(1, 1, At, B1); PG8_BAR; PG8_SCHED;
            PG8_LDB(B0, 1, 0); PG8_LDB(B1, 1, 1); PG8_SCHED; PG8_LDA(At, 1, 0); PG8_STAGE(PG8_SA(0, 1), a2 + hstep, voffA);
            PG8_WAIT_V(8); PG8_WAIT_L(0); PG8_BAR; PG8_MMA(0, 0, At, B0); PG8_MMA(0, 1, At, B1); PG8_BAR; PG8_SCHED;
            PG8_LDA(At, 1, 1); PG8_STAGE(PG8_SB(1, 0), b3, voffB); PG8_STAGE(PG8_SB(1, 1), b3 + hstep, voffB); PG8_STAGE(PG8_SA(1, 0), a3, voffA);
            PG8_WAIT_V(8); PG8_WAIT_L(0); PG8_BAR; PG8_MMA(1, 0, At, B0); PG8_MMA(1, 1, At, B1); PG8_BAR; PG8_SCHED;
            } else {
            PG8_LDB(B0, 0, 0); PG8_SCHED; PG8_LDA(At, 0, 0); PG8_STAGE(PG8_SA(1, 1), a1 + hstep, voffA);
            PG8_WAIT_L(8); PG8_BAR; PG8_WAIT_L(0); PG8_MMA(0, 0, At, B0); PG8_BAR; PG8_SCHED;
            PG8_LDB(B1, 0, 1); PG8_STAGE(PG8_SB(0, 0), b2, voffB);
            PG8_BAR; PG8_WAIT_L(0); PG8_MMA(0, 1, At, B1); PG8_BAR;
            PG8_LDA(At, 0, 1); PG8_STAGE(PG8_SA(0, 0), a2, voffA);
            PG8_BAR; PG8_WAIT_L(0); PG8_MMA(1, 0, At, B0); PG8_BAR; PG8_SCHED;
            PG8_STAGE(PG8_SB(0, 1), b2 + hstep, voffB);
            PG8_WAIT_V(6); PG8_BAR; PG8_MMA(1, 1, At, B1); PG8_BAR;
            PG8_LDB(B0, 1, 0); PG8_SCHED; PG8_LDA(At, 1, 0); PG8_STAGE(PG8_SA(0, 1), a2 + hstep, voffA);
            PG8_WAIT_L(8); PG8_BAR; PG8_WAIT_L(0); PG8_MMA(0, 0, At, B0); PG8_BAR; PG8_SCHED;
            PG8_LDB(B1, 1, 1); PG8_STAGE(PG8_SB(1, 0), b3, voffB);
            PG8_BAR; PG8_WAIT_L(0); PG8_MMA(0, 1, At, B1); PG8_BAR;
            PG8_LDA(At, 1, 1); PG8_STAGE(PG8_SA(1, 0), a3, voffA);
            PG8_BAR; PG8_WAIT_L(0); PG8_MMA(1, 0, At, B0); PG8_BAR; PG8_SCHED;
            PG8_STAGE(PG8_SB(1, 1), b3 + hstep, voffB);
            PG8_WAIT_V(6); PG8_BAR; PG8_MMA(1, 1, At, B1); PG8_BAR;
            }
        }
        if constexpr (ALIGN_EPI) { if (wr == 0) PG8_BAR; }
        if constexpr (!Epi::AFTER_DRAIN) { E(acc, cur, wr, wc, fr, fq); S.done(cur); }
        if (!has_next) break;
#pragma unroll
        for (int a = 0; a < 2; ++a)
#pragma unroll
            for (int b = 0; b < 2; ++b)
#pragma unroll
                for (int m = 0; m < 4; ++m)
#pragma unroll
                    for (int n = 0; n < 2; ++n) acc[a][b][m][n] = (f32x4){0.f, 0.f, 0.f, 0.f};
        cur = nxt; cA = nA; cB = nB; ++ui;
        if constexpr (ALIGN_EPI) { if (wr == 1) PG8_BAR; }
    }
    PG8_WAIT_V(0);
    if constexpr (!ALIGN_EPI) { if (wr == 0) PG8_BAR; }
    PG8_BAR;
    if constexpr (Epi::AFTER_DRAIN) { E.fused(acc, cur, wr, wc, fr, fq, lds, wid, lane); S.done(cur); }
#undef PG8_SA
#undef PG8_SB
#undef PG8_STAGE
#undef PG8_LDA
#undef PG8_LDB
#undef PG8_MMA
#undef PG8_WAIT_V
#undef PG8_WAIT_L
#undef PG8_BAR
#undef PG8_SCHED
}
}

#define LAS __attribute__((address_space(3)))
#define GAS __attribute__((address_space(1)))
typedef float f32x4 __attribute__((ext_vector_type(4)));
typedef unsigned u32x4 __attribute__((ext_vector_type(4)));
typedef unsigned u32x2 __attribute__((ext_vector_type(2)));
typedef short bf16x8 __attribute__((ext_vector_type(8)));
constexpr int NTHR = 512, NWAVES = 8;
constexpr int MK_LDS_BYTES = 147456;
constexpr int LDS_MISC_OFF = 131072;

__device__ __forceinline__ unsigned cvt_pk_bf16(float lo, float hi) { unsigned r; asm volatile("v_cvt_pk_bf16_f32 %0, %1, %2" : "=v"(r) : "v"(lo), "v"(hi)); return r; }

struct EpiProj {
    static constexpr bool PERM = true, AFTER_DRAIN = false;
    bf16_t* O; int ldc; bf16_t* kcb;
    __device__ __forceinline__ void operator()(const pg8::f32x4 (&acc)[2][2][4][2], const pg8::Unit& u, int wr, int wc, int fr, int fq) const {
        const int row0 = u.pm * 256 + wr * 64 + fr, col0 = u.pn * 256 + wc * 32 + 8 * fq;
#pragma unroll
        for (int ai = 0; ai < 2; ++ai)
#pragma unroll
            for (int m = 0; m < 4; ++m) { bf16_t* rowp = O + (size_t)(row0 + ai * 128 + m * 16) * ldc + col0;
#pragma unroll
                for (int bj = 0; bj < 2; ++bj) { const pg8::f32x4 v0 = acc[ai][bj][m][0], v1 = acc[ai][bj][m][1];
                    u32x4 w; w.x = cvt_pk_bf16(v0[0], v0[1]); w.y = cvt_pk_bf16(v0[2], v0[3]); w.z = cvt_pk_bf16(v1[0], v1[1]); w.w = cvt_pk_bf16(v1[2], v1[3]);
                    *(u32x4*)(rowp + bj * 128) = w;
                    if (u.pn == 16 || u.pn == 17) { const int row = row0 + ai * 128 + m * 16;
                        *(u32x4*)(kcb + ((((size_t)(u.pn - 16) * 4 + (row >> 12)) * 2 + bj) * 4096 + (row & 4095)) * 128 + wc * 32 + 8 * fq) = w; } } }
    }
};
__device__ __forceinline__ float bflo(unsigned w) { return __uint_as_float(w << 16); }
__device__ __forceinline__ float bfhi(unsigned w) { return __uint_as_float(w & 0xffff0000u); }
template <int STEP> struct EpiMerge {
    static constexpr bool PERM = true, AFTER_DRAIN = false;
    const bf16_t* proj; bf16_t* T1; bf16_t* MG;
    __device__ __forceinline__ void operator()(const pg8::f32x4 (&acc)[2][2][4][2], const pg8::Unit& u, int wr, int wc, int fr, int fq) const {
        const int row0 = u.pm * 256 + wr * 64 + fr, col0 = u.pn * 256 + wc * 32 + 8 * fq;
#pragma unroll
        for (int ai = 0; ai < 2; ++ai)
#pragma unroll
            for (int m = 0; m < 4; ++m) { const size_t row = (size_t)(row0 + ai * 128 + m * 16);
#pragma unroll
                for (int bj = 0; bj < 2; ++bj) { const int col = col0 + bj * 128;
                    const u32x4 g = *(const u32x4*)(proj + row * PLD + C_MG + (STEP == 2 ? 1024 : 0) + col);
                    const pg8::f32x4 v0 = acc[ai][bj][m][0], v1 = acc[ai][bj][m][1];
                    float r[8];
                    r[0] = sigmoidf_(bflo(g.x)) * v0[0]; r[1] = sigmoidf_(bfhi(g.x)) * v0[1]; r[2] = sigmoidf_(bflo(g.y)) * v0[2]; r[3] = sigmoidf_(bfhi(g.y)) * v0[3];
                    r[4] = sigmoidf_(bflo(g.z)) * v1[0]; r[5] = sigmoidf_(bfhi(g.z)) * v1[1]; r[6] = sigmoidf_(bflo(g.w)) * v1[2]; r[7] = sigmoidf_(bfhi(g.w)) * v1[3];
                    if (STEP == 2) { const u32x4 t = *(const u32x4*)(T1 + row * DM + col);
                        r[0] += bflo(t.x); r[1] += bfhi(t.x); r[2] += bflo(t.y); r[3] += bfhi(t.y); r[4] += bflo(t.z); r[5] += bfhi(t.z); r[6] += bflo(t.w); r[7] += bfhi(t.w); }
                    u32x4 w; w.x = cvt_pk_bf16(r[0], r[1]); w.y = cvt_pk_bf16(r[2], r[3]); w.z = cvt_pk_bf16(r[4], r[5]); w.w = cvt_pk_bf16(r[6], r[7]);
                    *(u32x4*)((STEP == 2 ? MG : T1) + row * DM + col) = w; } }
    }
};
struct EpiOut {
    static constexpr bool PERM = false, AFTER_DRAIN = false;
    const float* x; const float* mod; float* h1;
    __device__ __forceinline__ void operator()(const pg8::f32x4 (&acc)[2][2][4][2], const pg8::Unit& u, int wr, int wc, int fr, int fq) const {
        const int row0 = u.pm * 256 + wr * 64 + fr, col0 = u.pn * 256 + wc * 32 + 4 * fq;
        const float* gate = mod + (u.pm * 256 / SEQ) * 6144 + 2048;
#pragma unroll
        for (int bj = 0; bj < 2; ++bj)
#pragma unroll
            for (int n = 0; n < 2; ++n) { const int col = col0 + bj * 128 + n * 16; const pg8::f32x4 gv = *(const pg8::f32x4*)(gate + col);
#pragma unroll
                for (int ai = 0; ai < 2; ++ai)
#pragma unroll
                    for (int m = 0; m < 4; ++m) { const size_t off = (size_t)(row0 + ai * 128 + m * 16) * DM + col;
                        const pg8::f32x4 xv = *(const pg8::f32x4*)(x + off); *(pg8::f32x4*)(h1 + off) = xv + gv * acc[ai][bj][m][n]; } }
    }
};
struct EpiSwiglu {
    static constexpr bool PERM = true, AFTER_DRAIN = false;
    const float* b1; bf16_t* act;
    __device__ __forceinline__ void operator()(const pg8::f32x4 (&acc)[2][2][4][2], const pg8::Unit& u, int wr, int wc, int fr, int fq) const {
        const int row0 = u.pm * 256 + wr * 64 + fr, col0 = u.pn * 128 + wc * 32 + 8 * fq;
        const float* bg = b1 + u.e * 2048 + col0; const float* bu = bg + 1024;
        float gb[8], ub[8];
#pragma unroll
        for (int j = 0; j < 8; ++j) { gb[j] = bg[j]; ub[j] = bu[j]; }
#pragma unroll
        for (int ai = 0; ai < 2; ++ai)
#pragma unroll
            for (int m = 0; m < 4; ++m) { float r[8];
#pragma unroll
                for (int j = 0; j < 8; ++j) { float g = acc[ai][0][m][j >> 2][j & 3] + gb[j], uu = acc[ai][1][m][j >> 2][j & 3] + ub[j];
                    g = fminf(g, 7.f); uu = fminf(fmaxf(uu, -7.f), 7.f); r[j] = g * sigmoidf_(1.702f * g) * (uu + 1.f); }
                u32x4 w; w.x = cvt_pk_bf16(r[0], r[1]); w.y = cvt_pk_bf16(r[2], r[3]); w.z = cvt_pk_bf16(r[4], r[5]); w.w = cvt_pk_bf16(r[6], r[7]);
                *(u32x4*)(act + (size_t)(row0 + ai * 128 + m * 16) * DM + col0) = w; }
    }
};
struct EpiMoe2 {
    static constexpr bool PERM = true, AFTER_DRAIN = false;
    const float* b2; bf16_t* ys;
    __device__ __forceinline__ void operator()(const pg8::f32x4 (&acc)[2][2][4][2], const pg8::Unit& u, int wr, int wc, int fr, int fq) const {
        const int row0 = u.pm * 256 + wr * 64 + fr, col0 = u.pn * 256 + wc * 32 + 8 * fq;
#pragma unroll
        for (int bj = 0; bj < 2; ++bj) { const float* bb = b2 + u.e * 1024 + col0 + bj * 128; float bv[8];
#pragma unroll
            for (int j = 0; j < 8; ++j) bv[j] = bb[j];
#pragma unroll
            for (int ai = 0; ai < 2; ++ai)
#pragma unroll
                for (int m = 0; m < 4; ++m) { const pg8::f32x4 v0 = acc[ai][bj][m][0], v1 = acc[ai][bj][m][1];
                    u32x4 w; w.x = cvt_pk_bf16(v0[0] + bv[0], v0[1] + bv[1]); w.y = cvt_pk_bf16(v0[2] + bv[2], v0[3] + bv[3]); w.z = cvt_pk_bf16(v1[0] + bv[4], v1[1] + bv[5]); w.w = cvt_pk_bf16(v1[2] + bv[6], v1[3] + bv[7]);
                    *(u32x4*)(ys + (size_t)(row0 + ai * 128 + m * 16) * DM + col0 + bj * 128) = w; } }
    }
};
struct MoeOrder {
    int ntile, nN, G, c; const int* blk_e; size_t estride;
    __device__ __forceinline__ bool next(int i, pg8::Unit& u) const { const int L = i * G + c; if (L >= ntile * nN) return false; u.pm = L / nN; u.pn = L % nN; u.e = blk_e[u.pm]; return true; }
    __device__ __forceinline__ void a_ready(const pg8::Unit&) const {}
    __device__ __forceinline__ void done(const pg8::Unit&) const {}
    __device__ __forceinline__ const char* abase(const pg8::Gemm& g, const pg8::Unit& u, size_t tstep) const { return (const char*)g.A + (size_t)u.pm * tstep; }
    __device__ __forceinline__ const char* bbase(const pg8::Gemm& g, const pg8::Unit& u, size_t tstep) const { return (const char*)g.Bt + (size_t)u.e * estride + (size_t)u.pn * tstep; }
};

constexpr int CW_BAR = 4096;
#define XB_TMO      128
#define XB_XCNT(j)  (256  + 64 * (j))
#define XB_XSUB(j)  (1280 + 64 * (j))
#define XB_XGEN(j)  (2304 + 64 * (j))
#define XB_TOP      3328
#define XB_TOPGEN   3392
#define XCD_BAR_WORDS 3456
#define XB_SPIN_CAP (1u << 18)
__device__ __forceinline__ unsigned xb_ld(unsigned* p)              { return __hip_atomic_load(p, __ATOMIC_RELAXED, __HIP_MEMORY_SCOPE_AGENT); }
__device__ __forceinline__ unsigned xb_add(unsigned* p, unsigned v) { return __hip_atomic_fetch_add(p, v, __ATOMIC_RELAXED, __HIP_MEMORY_SCOPE_AGENT); }
__device__ __forceinline__ unsigned xb_xcc_id() { return (unsigned)__builtin_amdgcn_s_getreg((3 << 11) | 20) & 0xFu; }
#define XB_SPIN(cond, bar) do { unsigned _sp = 0; while (cond) { __builtin_amdgcn_s_sleep(1); \
    if ((++_sp & 255u) == 0u) { if (xb_ld(&(bar)[XB_TMO])) break; if (_sp > XB_SPIN_CAP) { atomicAdd(&(bar)[XB_TMO], 1u); break; } } } } while (0)
struct XcdBarrier { unsigned* bar; unsigned x; volatile LAS unsigned* st; };
__device__ __forceinline__ XcdBarrier xcd_barrier_post(unsigned* bar, volatile LAS unsigned* st) {
    XcdBarrier b; b.bar = bar; b.x = xb_xcc_id(); b.st = st;
    if (threadIdx.x == 0) (void)xb_add(&bar[XB_XCNT(b.x)], 1u);
    return b;
}
__device__ __forceinline__ void xcd_barrier_complete(unsigned* bar, unsigned x, unsigned& nloc, unsigned& nx) {
    const unsigned G = gridDim.x * gridDim.y * gridDim.z;
    unsigned sum, cnt, mine, sp = 0u;
    for (;;) {
        sum = 0u; cnt = 0u; mine = 0u;
#pragma unroll
        for (unsigned j = 0; j < 16; ++j) { const unsigned c = xb_ld(&bar[XB_XCNT(j)]); sum += c; cnt += (c > 0u) ? 1u : 0u; mine = (j == x) ? c : mine; }
        if (sum == G) break;
        __builtin_amdgcn_s_sleep(1);
        if ((++sp & 255u) == 0u) { if (xb_ld(&bar[XB_TMO])) break; if (sp > XB_SPIN_CAP) { atomicAdd(&bar[XB_TMO], 1u); break; } }
    }
    nloc = mine > 0u ? mine : 1u; nx = cnt > 0u ? cnt : 1u;
}
__device__ __forceinline__ void xcd_barrier(const XcdBarrier& b) {
    asm volatile("s_waitcnt vmcnt(0)" ::: "memory");
    __syncthreads();
    if (threadIdx.x == 0) {
        unsigned* bar = b.bar;
        __builtin_amdgcn_s_waitcnt(0);
        unsigned nloc = b.st[0], nx = b.st[1];
        if (nloc == 0u) { xcd_barrier_complete(bar, b.x, nloc, nx); b.st[0] = nloc; b.st[1] = nx; }
        const unsigned old = xb_add(&bar[XB_XSUB(b.x)], 1u);
        const unsigned gen = old / nloc;
        if (old + 1u == (gen + 1u) * nloc) {
            __builtin_amdgcn_fence(__ATOMIC_RELEASE, "agent");
            asm volatile("s_waitcnt vmcnt(0)" ::: "memory");
            const unsigned og = xb_add(&bar[XB_TOP], 1u);
            const unsigned tg = og / nx;
            if (og + 1u == (tg + 1u) * nx) xb_add(&bar[XB_TOPGEN], 1u);
            else XB_SPIN(xb_ld(&bar[XB_TOPGEN]) == tg, bar);
            __builtin_amdgcn_fence(__ATOMIC_ACQUIRE, "agent");
            xb_add(&bar[XB_XGEN(b.x)], 1u);
            asm volatile("s_waitcnt vmcnt(0)" ::: "memory");
        } else {
            XB_SPIN(xb_ld(&bar[XB_XGEN(b.x)]) == gen, bar);
            __builtin_amdgcn_fence(__ATOMIC_ACQUIRE, "agent");
            asm volatile("s_waitcnt vmcnt(0)" ::: "memory");
        }
    }
    __syncthreads();
}

__device__ __forceinline__ void ph_mod(const P& p, LAS unsigned char* lds, int bid, int nblk) {
    int tidx_ = threadIdx.x; asm volatile("" : "+v"(tidx_));
    LAS float* sc = (LAS float*)lds;
    LAS float* red = (LAS float*)(lds + 16384);
    const int tid = tidx_;
    for (int i = tid; i < 4096; i += NTHR) sc[i] = siluf_(p.c[i]);
    __syncthreads();
    for (int cb = bid; cb < 256; cb += nblk) {
        const int cq = tid % 6, kr = tid / 6;
        float acc[4][4];
#pragma unroll
        for (int b = 0; b < 4; ++b)
#pragma unroll
            for (int j = 0; j < 4; ++j) acc[b][j] = 0.f;
        if (kr < 85)
            for (int k = kr; k < 1024; k += 85) {
                const f32x4 w = *(const f32x4*)(p.w_ada + (size_t)k * 6144 + cb * 24 + cq * 4);
#pragma unroll
                for (int b = 0; b < 4; ++b) { const float s = sc[b * 1024 + k]; acc[b][0] += s * w[0]; acc[b][1] += s * w[1]; acc[b][2] += s * w[2]; acc[b][3] += s * w[3]; }
            }
#pragma unroll
        for (int b = 0; b < 4; ++b)
#pragma unroll
            for (int j = 0; j < 4; ++j) red[tid * 16 + b * 4 + j] = acc[b][j];
        __syncthreads();
        if (tid < 96) {
            const int b = tid / 24, col = tid % 24, q = col >> 2, j = col & 3; float s = 0.f;
            for (int r = 0; r < 85; ++r) s += red[(r * 6 + q) * 16 + b * 4 + j];
            WSP(float, WS_MOD)[b * 6144 + cb * 24 + col] = s + p.b_ada[cb * 24 + col];
        }
        __syncthreads();
    }
}
template <class RowMap>
__device__ __forceinline__ void conv_tile(const float* src, int ldw, int k0, int n0, int N, bf16_t* dst, int dK, const RowMap& rowmap, LAS float* T) {
    const int tid = threadIdx.x, wid = tid >> 6, lane = tid & 63;
#pragma unroll
    for (int r = 0; r < 8; ++r) {
        const int k = 8 * wid + r, n = 4 * lane;
        f32x4 v = (f32x4){0.f, 0.f, 0.f, 0.f};
        if (n0 + n < N) v = *(const f32x4*)(src + (size_t)(k0 + k) * ldw + n0 + n);
        *(LAS f32x4*)(T + k * 260 + (n ^ (wid << 2))) = v;
    }
    __syncthreads();
    const int c = tid & 7;
#pragma unroll
    for (int pass = 0; pass < 4; ++pass) {
        const int n = (tid >> 3) + 64 * pass;
        if (n0 + n < N) {
            float f[8];
#pragma unroll
            for (int i = 0; i < 8; ++i) f[i] = T[(8 * c + i) * 260 + (n ^ (c << 2))];
            u32x4 w; w.x = cvt_pk_bf16(f[0], f[1]); w.y = cvt_pk_bf16(f[2], f[3]); w.z = cvt_pk_bf16(f[4], f[5]); w.w = cvt_pk_bf16(f[6], f[7]);
            *(u32x4*)(dst + (size_t)rowmap(n0 + n) * dK + k0 + 8 * c) = w;
        }
    }
    __syncthreads();
}
struct RowId { __device__ __forceinline__ int operator()(int n) const { return n; } };
struct RowWin { __device__ __forceinline__ int operator()(int n) const {
    if (n < 3072) return n; if (n < 3088) return n + 4608; if (n < 5648) return n - 16; if (n < 5672) return n + 2048; return n - 40; } };
struct RowW1 { __device__ __forceinline__ int operator()(int n) const { const int h = n >> 10, r = n & 1023; return (r >> 7) * 256 + h * 128 + (r & 127); } };
struct RowOff { int off; __device__ __forceinline__ int operator()(int n) const { return n + off; } };
__device__ __forceinline__ void ph_convert(const P& p, LAS unsigned char* lds, int bid, int nblk) {
    LAS float* T = (LAS float*)lds;
    constexpr int I_WIN = 16 * 31, I_SQ = 16 * 4, I_W1 = 32 * 128, I_W2 = 32 * 64, I_C1 = 2 * 2 * 32, I_C2 = 2 * 4;
    constexpr int NITEMS = I_WIN + 3 * I_SQ + I_W1 + I_W2 + I_C1 + I_C2 + 1;
    for (int it = bid; it < NITEMS; it += nblk) {
        int r = it;
        if (r < I_W1) { const int e = r >> 7, t = r & 127, kt = t >> 3, ntile = t & 7;
            conv_tile(p.moe_w1 + (size_t)e * 1024 * 2048, 2048, kt * 64, ntile * 256, 2048, WSP(bf16_t, WS_W1T) + (size_t)e * 2048 * 1024, 1024, RowW1{}, T); continue; } r -= I_W1;
        if (r < I_W2) { const int e = r >> 6, t = r & 63, kt = t >> 2, ntile = t & 3;
            conv_tile(p.moe_w2 + (size_t)e * 1024 * 1024, 1024, kt * 64, ntile * 256, 1024, WSP(bf16_t, WS_W2T) + (size_t)e * 1024 * 1024, 1024, RowId{}, T); continue; } r -= I_W2;
        if (r < I_WIN) { const int kt = r / 31, ntile = r % 31; conv_tile(p.w_in, IN_COLS, kt * 64, ntile * 256, IN_COLS, WSP(bf16_t, WS_WINT), 1024, RowWin{}, T); continue; } r -= I_WIN;
        if (r < I_SQ) { conv_tile(p.proj_gla, 1024, (r >> 2) * 64, (r & 3) * 256, 1024, WSP(bf16_t, WS_PGLAT), 1024, RowId{}, T); continue; } r -= I_SQ;
        if (r < I_SQ) { conv_tile(p.proj_nsa, 1024, (r >> 2) * 64, (r & 3) * 256, 1024, WSP(bf16_t, WS_PNSAT), 1024, RowId{}, T); continue; } r -= I_SQ;
        if (r < I_SQ) { conv_tile(p.w_out, 1024, (r >> 2) * 64, (r & 3) * 256, 1024, WSP(bf16_t, WS_WOUTT), 1024, RowId{}, T); continue; } r -= I_SQ;
        if (r < I_C1) { const int which = r >> 6, half = (r >> 5) & 1, kt = r & 31;
            conv_tile(p.cmp_w1 + ((size_t)which * 4096 + half * 2048) * 256, 256, kt * 64, 0, 256, WSP(bf16_t, WS_CW1T) + (size_t)which * 512 * 2048, 2048, RowOff{half * 256}, T); continue; } r -= I_C1;
        if (r < I_C2) { const int which = r >> 2, kt = r & 3;
            conv_tile(p.cmp_w2 + (size_t)which * 256 * 128, 128, kt * 64, 0, 128, WSP(bf16_t, WS_CW2T) + (size_t)which * 128 * 256, 256, RowId{}, T); continue; }
        { u32x4* z = (u32x4*)(WSP(bf16_t, WS_WINT) + (size_t)IN_COLS * 1024); const int n16 = (PLD - IN_COLS) * 1024 * 2 / 16;
          for (int i = threadIdx.x; i < n16; i += NTHR) z[i] = (u32x4){0u, 0u, 0u, 0u}; }
    }
}
__device__ __forceinline__ void ph_u1(const P& p, int bid, int nblk) {
    int tidx_ = threadIdx.x; asm volatile("" : "+v"(tidx_));
    const int lane = tidx_ & 63, gw = bid * NWAVES + (tidx_ >> 6), NGW = nblk * NWAVES;
    for (int row = gw; row < NTOK; row += NGW) {
        const f32x4* xr = (const f32x4*)(p.x + (size_t)row * DM) + lane; const float* mod = WSP(float, WS_MOD) + (row / SEQ) * 6144;
        f32x4 v[4]; float ss = 0.f;
#pragma unroll
        for (int j = 0; j < 4; ++j) { v[j] = xr[64 * j]; ss += (v[j][0] * v[j][0] + v[j][1] * v[j][1]) + (v[j][2] * v[j][2] + v[j][3] * v[j][3]); }
        const float rstd = rsqrtf(wave_sum(ss) * (1.f / DM) + RMS_EPS);
        u32x2* o = (u32x2*)(WSP(bf16_t, WS_U1) + (size_t)row * DM) + lane;
#pragma unroll
        for (int j = 0; j < 4; ++j) { const int col = 4 * lane + 256 * j;
            const f32x4 g = *(const f32x4*)(p.norm1_g + col), sc = *(const f32x4*)(mod + 1024 + col), sh = *(const f32x4*)(mod + col);
            float r[4];
#pragma unroll
            for (int i = 0; i < 4; ++i) r[i] = v[j][i] * rstd * g[i] * (1.f + sc[i]) + sh[i];
            u32x2 w; w.x = cvt_pk_bf16(r[0], r[1]); w.y = cvt_pk_bf16(r[2], r[3]); o[64 * j] = w; }
    }
}

template <class F, bool DUAL>
__device__ __forceinline__ void sgemm_tile_dev(F f, const P& p, int m0, int n0, LAS float* sm) {
    LAS float* As = sm; LAS float* Bs = sm + 16 * 68; LAS float* Bs2 = sm + 32 * 68;
    const int tid = threadIdx.x, tx = tid & 15, ty = (tid >> 4) & 15; const bool act = tid < 256;
    f.init(p, m0);
    float acc[4][4], acc2[4][4];
#pragma unroll
    for (int i = 0; i < 4; ++i)
#pragma unroll
        for (int j = 0; j < 4; ++j) { acc[i][j] = 0.f; acc2[i][j] = 0.f; }
    const int K = f.K;
    for (int k0 = 0; k0 < K; k0 += 16) {
        if (act) {
            { const int r = tid >> 2, kq = (tid & 3) * 4;
#pragma unroll
              for (int i = 0; i < 4; ++i) As[(kq + i) * 68 + r] = f.a(p, m0 + r, k0 + kq + i); }
            { const int kk = tid >> 4, cc = (tid & 15) * 4;
#pragma unroll
              for (int i = 0; i < 4; ++i) { Bs[kk * 68 + cc + i] = f.b(p, k0 + kk, n0 + cc + i); if (DUAL) Bs2[kk * 68 + cc + i] = f.b2(p, k0 + kk, n0 + cc + i); } }
        }
        __syncthreads();
        if (act) {
#pragma unroll
            for (int kk = 0; kk < 16; ++kk) {
                float a[4], b[4], b2[4];
#pragma unroll
                for (int i = 0; i < 4; ++i) { a[i] = As[kk * 68 + ty * 4 + i]; b[i] = Bs[kk * 68 + tx * 4 + i]; b2[i] = DUAL ? Bs2[kk * 68 + tx * 4 + i] : 0.f; }
#pragma unroll
                for (int i = 0; i < 4; ++i)
#pragma unroll
                    for (int j = 0; j < 4; ++j) { acc[i][j] += a[i] * b[j]; if (DUAL) acc2[i][j] += a[i] * b2[j]; }
            }
        }
        __syncthreads();
    }
    if (act) {
#pragma unroll
        for (int i = 0; i < 4; ++i)
#pragma unroll
            for (int j = 0; j < 4; ++j) f.store(p, m0 + ty * 4 + i, n0 + tx * 4 + j, acc[i][j], acc2[i][j]);
    }
}
__device__ __forceinline__ void ph_loga_naive(const P& p, int bid, int nblk) {
    for (size_t idx = (size_t)bid * NTHR + threadIdx.x; idx < (size_t)NTOK * 512; idx += (size_t)nblk * NTHR) {
        const size_t row = idx >> 9; const int j = (int)(idx & 511);
        const bf16_t* pr = WSP(bf16_t, WS_PROJ) + row * PLD + C_GA;
        float xx = p.gla_ba[j];
#pragma unroll
        for (int r = 0; r < 16; ++r) xx += bf2f(pr[r]) * p.gla_wa2[r * 512 + j];
        const float ls = fminf(xx, 0.f) - log1pf(__expf(-fabsf(xx)));
        WSP(float, WS_LOGA)[idx] = ls * (1.f / 16.f);
    }
}
__device__ __forceinline__ void ph_gla_naive(const P& p, int bid, int nblk) {
    const int tid = threadIdx.x;
    if (tid >= 256) return;
    for (int blk = bid; blk < 256; blk += nblk) {
        const int b = blk >> 6, h = (blk >> 4) & 3, vg = blk & 15, vl = tid >> 4, kg = tid & 15;
        const int vcol = h * 256 + vg * 16 + vl;
        float S[8];
#pragma unroll
        for (int i = 0; i < 8; ++i) S[i] = 0.f;
        const bf16_t* proj = WSP(bf16_t, WS_PROJ); const float* loga = WSP(float, WS_LOGA); float* og = WSP(float, WS_OGLA);
        for (int t = 0; t < SEQ; ++t) {
            const size_t row = (size_t)b * SEQ + t;
            const bf16_t* pr = proj + row * PLD;
            const float vv = bf2f(pr[C_GV + vcol]);
            float part = 0.f;
#pragma unroll
            for (int i = 0; i < 8; ++i) {
                const int d = h * 128 + kg * 8 + i;
                const float a = __expf(loga[row * 512 + d]);
                S[i] = a * S[i] + bf2f(pr[C_GK + d]) * vv;
                part += bf2f(pr[C_GQ + d]) * S[i];
            }
            part += __shfl_xor(part, 1); part += __shfl_xor(part, 2); part += __shfl_xor(part, 4); part += __shfl_xor(part, 8);
            if (kg == 0) og[row * DM + vcol] = part * 0.08838834764831845f;
        }
    }
}
__device__ __forceinline__ void ph_ygla_naive(const P& p, int bid, int nblk) {
    int tidx_ = threadIdx.x; asm volatile("" : "+v"(tidx_));
    const int lane = tidx_ & 63, gw = bid * NWAVES + (tidx_ >> 6), NGW = nblk * NWAVES;
    for (int w = gw; w < NTOK * 4; w += NGW) {
        const int row = w >> 2, h = w & 3;
        const float* o = WSP(float, WS_OGLA) + (size_t)row * DM + h * 256;
        float v[4]; float ss = 0.f;
#pragma unroll
        for (int i = 0; i < 4; ++i) { v[i] = o[lane + 64 * i]; ss += v[i] * v[i]; }
        const float rstd = rsqrtf(wave_sum(ss) * (1.f / 256.f) + RMS_EPS);
        const bf16_t* pr = WSP(bf16_t, WS_PROJ) + (size_t)row * PLD + C_GR + h * 256;
        bf16_t* y = WSP(bf16_t, WS_YGLA) + (size_t)row * DM + h * 256;
#pragma unroll
        for (int i = 0; i < 4; ++i) { const int dv = lane + 64 * i; y[dv] = f2bf(v[i] * rstd * p.gla_norm_g[dv] * siluf_(bf2f(pr[dv]))); }
    }
}
template <bool WIN>
__device__ __forceinline__ void sparse_attend(const P& p, int b, int g, int t, int hq, u64 mask, LAS float* q, LAS float* pp, int lane, float& o0, float& o1) {
    const bf16_t* proj = WSP(bf16_t, WS_PROJ);
    const int kcol = (WIN ? C_KW : C_KS) + g * 128, vcol = (WIN ? C_VW : C_VS) + g * 128;
    const int nch = WIN ? 8 : __popcll(mask);
    int base[16];
    { u64 mm = mask;
#pragma unroll
      for (int jj = 0; jj < 16; ++jj) { if (WIN) base[jj] = t - 511 + jj * 64; else { const int bi = mm ? __ffsll((long long)mm) - 1 : 0; base[jj] = bi * 64; mm &= mm - 1; } } }
    float s[16]; float m = -INFINITY;
#pragma unroll
    for (int jj = 0; jj < 16; ++jj) {
        s[jj] = -INFINITY;
        if (jj < nch) { const int pos = base[jj] + lane;
            if (pos >= 0 && pos <= t) { const bf16_t* kr = proj + ((size_t)b * SEQ + pos) * PLD + kcol; float a = 0.f; for (int d = 0; d < 128; ++d) a += q[d] * bf2f(kr[d]); s[jj] = a * ATT_SCALE; } }
        m = fmaxf(m, s[jj]);
    }
    m = wave_max(m);
    float sum = 0.f;
#pragma unroll
    for (int jj = 0; jj < 16; ++jj) { s[jj] = (s[jj] > -INFINITY) ? __expf(s[jj] - m) : 0.f; sum += s[jj]; }
    sum = wave_sum(sum);
    const float inv = 1.f / fmaxf(sum, 1e-30f);
#pragma unroll
    for (int jj = 0; jj < 16; ++jj) pp[jj * 64 + lane] = s[jj] * inv;
    __builtin_amdgcn_wave_barrier();
    o0 = 0.f; o1 = 0.f;
#pragma unroll
    for (int jj = 0; jj < 16; ++jj) {
        if (jj < nch) {
            for (int l = 0; l < 64; ++l) {
                const float pv = pp[jj * 64 + l];
                int pos = base[jj] + l; pos = pos < 0 ? 0 : (pos > SEQ - 1 ? SEQ - 1 : pos);
                const bf16_t* vr = proj + ((size_t)b * SEQ + pos) * PLD + vcol;
                o0 += pv * bf2f(vr[lane]); o1 += pv * bf2f(vr[64 + lane]);
            }
        }
    }
    __builtin_amdgcn_wave_barrier();
}
__device__ __forceinline__ void ph_nsa_naive(const P& p, LAS unsigned char* lds, int bid, int nblk) {
    const int wid = threadIdx.x >> 6, lane = threadIdx.x & 63, gw = bid * NWAVES + wid, NGW = nblk * NWAVES;
    LAS float* wl = (LAS float*)lds + wid * 1920;
    LAS float* q = wl; LAS float* pp = wl + 128; LAS float* ps = wl + 1152; LAS float* oc = wl + 1408;
    for (int w = gw; w < BATCH * 2 * SEQ; w += NGW) {
        const int b = w >> 13, g = (w >> 12) & 1, t = w & 4095;
        const size_t row = (size_t)b * SEQ + t;
        const bf16_t* pr = WSP(bf16_t, WS_PROJ) + row * PLD;
        const bf16_t* kc = WSP(bf16_t, WS_KCVC) + (((size_t)0 * 4 + b) * 2 + g) * 256 * 128;
        const bf16_t* vc = WSP(bf16_t, WS_KCVC) + (((size_t)1 * 4 + b) * 2 + g) * 256 * 128;
        const int ncv = t >= 31 ? (t - 31) / 16 + 1 : 0;
        for (int i = 0; i < 4; ++i) ps[lane + 64 * i] = 0.f;
        for (int r = 0; r < 4; ++r) {
            const int hq = g * 4 + r;
            q[lane] = bf2f(pr[C_NQ + hq * 128 + lane]); q[lane + 64] = bf2f(pr[C_NQ + hq * 128 + 64 + lane]);
            __builtin_amdgcn_wave_barrier();
            float s[4]; float m = -INFINITY;
            for (int i = 0; i < 4; ++i) {
                const int c = lane + 64 * i; s[i] = -INFINITY;
                if (c < ncv) { float a = 0.f; for (int d = 0; d < 128; ++d) a += q[d] * bf2f(kc[c * 128 + d]); s[i] = a * ATT_SCALE; }
                m = fmaxf(m, s[i]);
            }
            m = wave_max(m);
            float e[4]; float sum = 0.f;
            for (int i = 0; i < 4; ++i) { const int c = lane + 64 * i; e[i] = (c < ncv) ? __expf(s[i] - m) : 0.f; sum += e[i]; }
            sum = wave_sum(sum);
            const float inv = 1.f / fmaxf(sum, 1e-30f);
            for (int i = 0; i < 4; ++i) { const int c = lane + 64 * i; const float pv = e[i] * inv; pp[c] = pv; ps[c] += pv; }
            __builtin_amdgcn_wave_barrier();
            float o0 = 0.f, o1 = 0.f;
            for (int c = 0; c < ncv; ++c) { const float pv = pp[c]; o0 += pv * bf2f(vc[c * 128 + lane]); o1 += pv * bf2f(vc[c * 128 + 64 + lane]); }
            oc[r * 128 + lane] = o0; oc[r * 128 + 64 + lane] = o1;
            __builtin_amdgcn_wave_barrier();
        }
        const int s = lane, tb = t >> 6;
        float imp = 0.f;
        for (int c = 4 * s - 1; c <= 4 * s + 3; ++c) if (c >= 0 && c < NCMP) imp += ps[c];
        const bool forced = (s == 0) || (s == tb) || (s == tb - 1), valid = s <= tb;
        const float score = forced ? INFINITY : (valid ? imp : -INFINITY);
        int rank = 0;
        for (int j = 0; j < 64; ++j) { const float sj = __shfl(score, j); rank += (sj > score) || (sj == score && j < s); }
        const bool sel = rank < 16 && score > -INFINITY;
        const u64 mask = __ballot(sel);
        for (int r = 0; r < 4; ++r) {
            const int hq = g * 4 + r;
            q[lane] = bf2f(pr[C_NQ + hq * 128 + lane]); q[lane + 64] = bf2f(pr[C_NQ + hq * 128 + 64 + lane]);
            __builtin_amdgcn_wave_barrier();
            float s0, s1, w0, w1;
            sparse_attend<false>(p, b, g, t, hq, mask, q, pp, lane, s0, s1);
            sparse_attend<true>(p, b, g, t, hq, 0ull, q, pp, lane, w0, w1);
            const float g0 = sigmoidf_(bf2f(pr[C_NG + hq * 3 + 0])), g1 = sigmoidf_(bf2f(pr[C_NG + hq * 3 + 1])), g2 = sigmoidf_(bf2f(pr[C_NG + hq * 3 + 2]));
            bf16_t* y = WSP(bf16_t, WS_YNSA) + row * DM + hq * 128;
            y[lane] = f2bf(g0 * oc[r * 128 + lane] + g1 * s0 + g2 * w0);
            y[lane + 64] = f2bf(g0 * oc[r * 128 + 64 + lane] + g1 * s1 + g2 * w1);
            __builtin_amdgcn_wave_barrier();
        }
    }
}
__device__ __forceinline__ void ph_route(const P& p, LAS unsigned char* lds, int bid, int nblk) {
    int tidx_ = threadIdx.x; asm volatile("" : "+v"(tidx_));
    const int wid = tidx_ >> 6, lane = tidx_ & 63, gw = bid * NWAVES + wid, NGW = nblk * NWAVES;
    LAS float* uu = (LAS float*)lds + wid * 4096;
    for (int row4 = gw * 4; row4 < NTOK; row4 += NGW * 4) {
        const float* mod = WSP(float, WS_MOD) + (row4 / SEQ) * 6144;
#pragma unroll
        for (int r = 0; r < 4; ++r) {
            const f32x4* hr = (const f32x4*)(WSP(float, WS_H1) + (size_t)(row4 + r) * DM) + lane;
            f32x4 v[4]; float ss = 0.f;
#pragma unroll
            for (int j = 0; j < 4; ++j) { v[j] = hr[64 * j]; ss += (v[j][0] * v[j][0] + v[j][1] * v[j][1]) + (v[j][2] * v[j][2] + v[j][3] * v[j][3]); }
            const float rstd = rsqrtf(wave_sum(ss) * (1.f / DM) + RMS_EPS);
            u32x2* uo = (u32x2*)(WSP(bf16_t, WS_U2) + (size_t)(row4 + r) * DM) + lane;
#pragma unroll
            for (int j = 0; j < 4; ++j) { const int col = 4 * lane + 256 * j;
                const f32x4 g = *(const f32x4*)(p.norm2_g + col), sc = *(const f32x4*)(mod + 4096 + col), sh = *(const f32x4*)(mod + 3072 + col);
                f32x4 o;
#pragma unroll
                for (int i = 0; i < 4; ++i) o[i] = v[j][i] * rstd * g[i] * (1.f + sc[i]) + sh[i];
                *(LAS f32x4*)(uu + r * 1024 + col) = o;
                u32x2 w; w.x = cvt_pk_bf16(o[0], o[1]); w.y = cvt_pk_bf16(o[2], o[3]); uo[64 * j] = w; }
        }
        __builtin_amdgcn_wave_barrier();
        const int e = lane & 31, kh = lane >> 5;
        float acc[4] = {0.f, 0.f, 0.f, 0.f};
        const float* rw = p.router_w + (size_t)kh * 512 * 32 + e;
        for (int k = 0; k < 512; k += 4) {
            const float w0 = rw[(k + 0) * 32], w1 = rw[(k + 1) * 32], w2 = rw[(k + 2) * 32], w3 = rw[(k + 3) * 32];
#pragma unroll
            for (int r = 0; r < 4; ++r) { const f32x4 u = *(const LAS f32x4*)(uu + r * 1024 + kh * 512 + k); acc[r] += (u[0] * w0 + u[1] * w1) + (u[2] * w2 + u[3] * w3); }
        }
        const float rb = p.router_b[e];
#pragma unroll
        for (int r = 0; r < 4; ++r) {
            const float logit = acc[r] + __shfl_xor(acc[r], 32) + rb;
            int rank = 0;
            for (int j = 0; j < 32; ++j) { const float lj = __shfl(logit, j); rank += (lj > logit) || (lj == logit && j < e); }
            const float mx = wave_max(logit);
            const bool sel = rank < 4;
            const float ex = sel ? __expf(logit - mx) : 0.f;
            float sum = ex; for (int o = 1; o < 32; o <<= 1) sum += __shfl_xor(sum, o);
            if (sel && lane < 32) {
                WSP(int, WS_TOPE)[(row4 + r) * 4 + rank] = e; WSP(float, WS_TOPW)[(row4 + r) * 4 + rank] = ex / sum;
                atomicAdd(WSP(int, WS_CTL) + CT_CNT + e, 1);
            }
        }
        __builtin_amdgcn_wave_barrier();
    }
}
__device__ __forceinline__ void ph_assign(const P& p, LAS unsigned char* lds, int bid, int nblk) {
    int tidx_ = threadIdx.x; asm volatile("" : "+v"(tidx_));
    LAS int* pst = (LAS int*)lds;
    int* ctl = WSP(int, WS_CTL);
    if (tidx_ == 0) {
        int ps = 0;
        for (int e = 0; e < NEXP; ++e) { pst[e] = ps; const int nb = (ctl[CT_CNT + e] + MOEB - 1) / MOEB;
            if (bid == 0) for (int i = 0; i < nb; ++i) ctl[CT_BLKE + ps / MOEB + i] = e;
            ps += nb * MOEB; }
        pst[NEXP] = ps; if (bid == 0) ctl[CT_PTOT] = ps;
    }
    __syncthreads();
    const int wid = tidx_ >> 6, lane = tidx_ & 63, gw = bid * NWAVES + wid, NGW = nblk * NWAVES;
    for (int idx = gw; idx < NTOK * 4; idx += NGW) {
        const int e = WSP(int, WS_TOPE)[idx];
        int pos = 0;
        if (lane == 0) pos = pst[e] + atomicAdd(ctl + CT_FILL + e, 1);
        pos = __shfl(pos, 0);
        if (lane == 0) WSP(int, WS_SLOTOF)[idx] = pos;
        const u32x4* s = (const u32x4*)(WSP(bf16_t, WS_U2) + (size_t)(idx >> 2) * DM); u32x4* d = (u32x4*)(WSP(bf16_t, WS_XS) + (size_t)pos * DM);
        d[lane] = s[lane]; d[lane + 64] = s[lane + 64];
    }
}
__device__ __forceinline__ void ph_final(const P& p, int bid, int nblk) {
    int tidx_ = threadIdx.x; asm volatile("" : "+v"(tidx_));
    const int lane = tidx_ & 63, gw = bid * NWAVES + (tidx_ >> 6), NGW = nblk * NWAVES;
    for (int row = gw; row < NTOK; row += NGW) {
        const float* hr = WSP(float, WS_H1) + (size_t)row * DM; const float* mod = WSP(float, WS_MOD) + (row / SEQ) * 6144;
        const int* so = WSP(int, WS_SLOTOF) + row * 4; const float* tw = WSP(float, WS_TOPW) + row * 4;
        const bf16_t* ys = WSP(bf16_t, WS_YSLOT);
        const int s0 = so[0], s1 = so[1], s2 = so[2], s3 = so[3]; const float w0 = tw[0], w1 = tw[1], w2 = tw[2], w3 = tw[3];
        float v[16]; float ss = 0.f;
#pragma unroll
        for (int i = 0; i < 16; ++i) {
            const int col = lane + 64 * i;
            const float m = w0 * bf2f(ys[(size_t)s0 * DM + col]) + w1 * bf2f(ys[(size_t)s1 * DM + col]) + w2 * bf2f(ys[(size_t)s2 * DM + col]) + w3 * bf2f(ys[(size_t)s3 * DM + col]);
            v[i] = hr[col] + mod[5120 + col] * m; ss += v[i] * v[i];
        }
        const float rstd = rsqrtf(wave_sum(ss) * (1.f / DM) + RMS_EPS);
#pragma unroll
        for (int i = 0; i < 16; ++i) { const int col = lane + 64 * i; p.out[(size_t)row * DM + col] = v[i] * rstd * p.final_g[col]; }
    }
}

constexpr size_t WS_QE = 735 * MiB;
constexpr size_t WS_KDT = 751 * MiB;
constexpr size_t WS_AM = 767 * MiB;
constexpr size_t WS_DEC = 775 * MiB;
typedef short s16x4 __attribute__((ext_vector_type(4)));
__device__ __forceinline__ s16x4 lds_tr16(LAS const void* ptr) { return __builtin_bit_cast(s16x4, __builtin_amdgcn_ds_read_tr16_b64_v4i16((LAS s16x4*)ptr)); }
__device__ __forceinline__ bf16x8 cat8(s16x4 a, s16x4 b) { return (bf16x8){a[0], a[1], a[2], a[3], b[0], b[1], b[2], b[3]}; }

__device__ __forceinline__ void ph_gla_g1(const P& p, LAS unsigned char* lds, int bid, int nblk) {
    int tidx_ = threadIdx.x; asm volatile("" : "+v"(tidx_));
    const int tid = tidx_, wid = tid >> 6, lane = tid & 63, fr = lane & 15, fq = lane >> 4;
    LAS float* gaL = (LAS float*)lds;
    LAS float* segL = (LAS float*)(lds + 4096);
    LAS bf16_t* qeL = (LAS bf16_t*)(lds + 8192);
    LAS bf16_t* keL = (LAS bf16_t*)(lds + 8192 + 17408);
    const bf16_t* proj = WSP(bf16_t, WS_PROJ);
    for (int item = bid; item < 1024; item += nblk) {
        const int b = item >> 8, h = (item >> 6) & 3, n = item & 63;
        const size_t r0 = (size_t)b * SEQ + n * 64;
        if (tid < 128) { const int tok = tid >> 1, half = tid & 1;
            const u32x4 v = *(const u32x4*)(proj + (r0 + tok) * PLD + C_GA + half * 8);
            LAS float* d = gaL + tok * 16 + half * 8;
            d[0] = bflo(v.x); d[1] = bfhi(v.x); d[2] = bflo(v.y); d[3] = bfhi(v.y); d[4] = bflo(v.z); d[5] = bfhi(v.z); d[6] = bflo(v.w); d[7] = bfhi(v.w); }
        __syncthreads();
        const int d = tid & 127, seg = tid >> 7;
        float w[16];
#pragma unroll
        for (int r = 0; r < 16; ++r) w[r] = p.gla_wa2[r * 512 + h * 128 + d];
        const float ba = p.gla_ba[h * 128 + d];
        float bc[16]; float run = 0.f;
#pragma unroll
        for (int i = 0; i < 16; ++i) {
            const LAS float* g = gaL + (seg * 16 + i) * 16; float xx = ba;
#pragma unroll
            for (int r = 0; r < 16; ++r) xx += g[r] * w[r];
            const float ls = fminf(xx, 0.f) - log1pf(__expf(-fabsf(xx)));
            run += ls * (1.f / 16.f); bc[i] = run;
        }
        segL[seg * 128 + d] = run;
        __syncthreads();
        float off = 0.f, blast = 0.f;
#pragma unroll
        for (int s = 0; s < 4; ++s) { const float v = segL[s * 128 + d]; blast += v; if (s < seg) off += v; }
        bf16_t* QE = WSP(bf16_t, WS_QE) + (size_t)item * 8192; bf16_t* KDT = WSP(bf16_t, WS_KDT) + (size_t)item * 8192;
        float kd[16];
#pragma unroll
        for (int i = 0; i < 16; ++i) {
            const int tok = seg * 16 + i; const float bcv = bc[i] + off;
            const bf16_t* pr = proj + (r0 + tok) * PLD + h * 128 + d;
            const float q = bf2f(pr[C_GQ]), k = bf2f(pr[C_GK]);
            const float e = __expf(bcv);
            const bf16_t qe = f2bf(q * 0.08838834764831845f * e), ke = f2bf(k * __expf(-bcv));
            kd[i] = k * __expf(blast - bcv);
            qeL[tok * 136 + d] = qe; keL[tok * 136 + d] = ke; QE[tok * 128 + d] = qe;
        }
        { u32x4 w0, w1; w0.x = cvt_pk_bf16(kd[0], kd[1]); w0.y = cvt_pk_bf16(kd[2], kd[3]); w0.z = cvt_pk_bf16(kd[4], kd[5]); w0.w = cvt_pk_bf16(kd[6], kd[7]);
          w1.x = cvt_pk_bf16(kd[8], kd[9]); w1.y = cvt_pk_bf16(kd[10], kd[11]); w1.z = cvt_pk_bf16(kd[12], kd[13]); w1.w = cvt_pk_bf16(kd[14], kd[15]);
          u32x4* dst = (u32x4*)(KDT + d * 64 + seg * 16); dst[0] = w0; dst[1] = w1; }
        if (seg == 0) WSP(float, WS_DEC)[(size_t)item * 128 + d] = __expf(blast);
        __syncthreads();
        bf16_t* AM = WSP(bf16_t, WS_AM) + (size_t)item * 4096;
#pragma unroll
        for (int tt = 0; tt < 2; ++tt) {
            const int id = wid * 2 + tt, ti = id >> 2, tj = id & 3;
            f32x4 acc = (f32x4){0.f, 0.f, 0.f, 0.f};
            if (tj <= ti) {
#pragma unroll
                for (int s = 0; s < 4; ++s) {
                    const bf16x8 af = *(const LAS bf16x8*)(qeL + (16 * ti + fr) * 136 + 32 * s + 8 * fq);
                    const bf16x8 bf = *(const LAS bf16x8*)(keL + (16 * tj + fr) * 136 + 32 * s + 8 * fq);
                    acc = __builtin_amdgcn_mfma_f32_16x16x32_bf16(af, bf, acc, 0, 0, 0);
                }
            }
            const int j = 16 * tj + fr;
#pragma unroll
            for (int r = 0; r < 4; ++r) { const int i = 16 * ti + 4 * fq + r; AM[i * 64 + j] = f2bf(j <= i ? acc[r] : 0.f); }
        }
        __syncthreads();
    }
}

__device__ __forceinline__ void ph_gla_g2(const P& p, LAS unsigned char* lds, int bid, int nblk) {
    int tidx_ = threadIdx.x; asm volatile("" : "+v"(tidx_));
    const int tid = tidx_, wid = __builtin_amdgcn_readfirstlane(tid >> 6), lane = tid & 63, fr = lane & 15, fq = lane >> 4;
    LAS bf16_t* VL = (LAS bf16_t*)lds;
    LAS bf16_t* ST = (LAS bf16_t*)(lds + 4096);
    const bf16_t* proj = WSP(bf16_t, WS_PROJ);
    for (int it = bid; it < 256; it += nblk) {
        const int bh = (it & 7) + 8 * ((it >> 3) & 1), slice = it >> 4, b = bh >> 2, h = bh & 3;
        for (int i = tid; i < 16 * 136 / 2; i += NTHR) ((LAS unsigned*)ST)[i] = 0u;
        f32x4 S = (f32x4){0.f, 0.f, 0.f, 0.f};
        const int item0 = (b * 4 + h) * 64;
        const size_t r0 = (size_t)b * SEQ;
        const int vcol = C_GV + h * 256 + slice * 16;
        bf16x8 kdt[2] = {}, am[2] = {}, qe[4] = {}; f32x4 dec; u32x4 vreg = (u32x4){0u, 0u, 0u, 0u};
        {
            const bf16_t* KDT = WSP(bf16_t, WS_KDT) + (size_t)item0 * 8192; const bf16_t* AMp = WSP(bf16_t, WS_AM) + (size_t)item0 * 4096; const bf16_t* QE = WSP(bf16_t, WS_QE) + (size_t)item0 * 8192;
#pragma unroll
            for (int s = 0; s < 2; ++s) kdt[s] = *(const bf16x8*)(KDT + (16 * wid + fr) * 64 + 32 * s + 8 * fq);
            if (wid < 4) {
#pragma unroll
                for (int s = 0; s < 2; ++s) am[s] = *(const bf16x8*)(AMp + (16 * wid + fr) * 64 + 32 * s + 8 * fq);
#pragma unroll
                for (int s = 0; s < 4; ++s) qe[s] = *(const bf16x8*)(QE + (16 * wid + fr) * 128 + 32 * s + 8 * fq);
            }
            dec = *(const f32x4*)(WSP(float, WS_DEC) + (size_t)item0 * 128 + 16 * wid + 4 * fq);
            if (tid < 128) vreg = *(const u32x4*)(proj + (r0 + (tid >> 1)) * PLD + vcol + (tid & 1) * 8);
        }
        for (int n = 0; n < 64; ++n) {
            LAS bf16_t* Vb = VL + (n & 1) * 1024;
            if (tid < 128) *(LAS u32x4*)(Vb + (tid >> 1) * 16 + (tid & 1) * 8) = vreg;
            bf16x8 ckdt[2], cam[2], cqe[4]; const f32x4 cdec = dec;
#pragma unroll
            for (int s = 0; s < 2; ++s) { ckdt[s] = kdt[s]; cam[s] = am[s]; }
#pragma unroll
            for (int s = 0; s < 4; ++s) cqe[s] = qe[s];
            if (n + 1 < 64) {
                const int itn = item0 + n + 1;
                const bf16_t* KDT = WSP(bf16_t, WS_KDT) + (size_t)itn * 8192; const bf16_t* AMp = WSP(bf16_t, WS_AM) + (size_t)itn * 4096; const bf16_t* QE = WSP(bf16_t, WS_QE) + (size_t)itn * 8192;
#pragma unroll
                for (int s = 0; s < 2; ++s) kdt[s] = *(const bf16x8*)(KDT + (16 * wid + fr) * 64 + 32 * s + 8 * fq);
                if (wid < 4) {
#pragma unroll
                    for (int s = 0; s < 2; ++s) am[s] = *(const bf16x8*)(AMp + (16 * wid + fr) * 64 + 32 * s + 8 * fq);
#pragma unroll
                    for (int s = 0; s < 4; ++s) qe[s] = *(const bf16x8*)(QE + (16 * wid + fr) * 128 + 32 * s + 8 * fq);
                }
                dec = *(const f32x4*)(WSP(float, WS_DEC) + (size_t)itn * 128 + 16 * wid + 4 * fq);
                if (tid < 128) vreg = *(const u32x4*)(proj + (r0 + (n + 1) * 64 + (tid >> 1)) * PLD + vcol + (tid & 1) * 8);
            }
            __syncthreads();
            bf16x8 vb[2];
#pragma unroll
            for (int ks = 0; ks < 2; ++ks) {
                const int q = (lane & 15) >> 2, pp = lane & 3;
                const s16x4 lo = lds_tr16(Vb + (32 * ks + 8 * fq + q) * 16 + 4 * pp);
                const s16x4 hi = lds_tr16(Vb + (32 * ks + 8 * fq + 4 + q) * 16 + 4 * pp);
                vb[ks] = cat8(lo, hi);
            }
            f32x4 cs = (f32x4){0.f, 0.f, 0.f, 0.f};
            cs = __builtin_amdgcn_mfma_f32_16x16x32_bf16(ckdt[0], vb[0], cs, 0, 0, 0);
            cs = __builtin_amdgcn_mfma_f32_16x16x32_bf16(ckdt[1], vb[1], cs, 0, 0, 0);
            if (wid < 4) {
                f32x4 o = (f32x4){0.f, 0.f, 0.f, 0.f};
                o = __builtin_amdgcn_mfma_f32_16x16x32_bf16(cam[0], vb[0], o, 0, 0, 0);
                o = __builtin_amdgcn_mfma_f32_16x16x32_bf16(cam[1], vb[1], o, 0, 0, 0);
#pragma unroll
                for (int s = 0; s < 4; ++s) { const bf16x8 sb = *(const LAS bf16x8*)(ST + fr * 136 + 32 * s + 8 * fq); o = __builtin_amdgcn_mfma_f32_16x16x32_bf16(cqe[s], sb, o, 0, 0, 0); }
                float* og = WSP(float, WS_OGLA) + (r0 + n * 64 + 16 * wid + 4 * fq) * DM + h * 256 + slice * 16 + fr;
#pragma unroll
                for (int r = 0; r < 4; ++r) og[(size_t)r * DM] = o[r];
            }
            S = cdec * S + cs;
            __syncthreads();
            { u32x2 w; w.x = cvt_pk_bf16(S[0], S[1]); w.y = cvt_pk_bf16(S[2], S[3]); *(LAS u32x2*)(ST + fr * 136 + 16 * wid + 4 * fq) = w; }
        }
        __syncthreads();
    }
}
constexpr size_t WS_NSCR = 776 * MiB;
typedef float f32x16 __attribute__((ext_vector_type(16)));
constexpr int NSA_KV0 = 0, NSA_IMP = 65536, NSA_MASK = 81920, NSA_UNI = 82432, NSA_WSF = 82944;
constexpr float NSA_NEG = -1e30f;
__device__ __forceinline__ unsigned offb(unsigned row, unsigned ch) { return 2048u * (row >> 3) + 512u * (ch >> 2) + 64u * (row & 7u) + 16u * ((ch & 3u) ^ ((row >> 2) & 3u)); }
__device__ __forceinline__ int crow16(int r, int hi) { return (r & 3) + 8 * (r >> 2) + 4 * hi; }
struct TileRegs { u32x4 k[2], v[2]; };
template <bool LOADV>
__device__ __forceinline__ void nsa_tile_load(TileRegs& R, const bf16_t* kb, const bf16_t* vb, size_t pitch) {
    unsigned tx = threadIdx.x; asm volatile("" : "+v"(tx));
#pragma unroll
    for (int i = 0; i < 2; ++i) { const int c = tx + NTHR * i, row = c >> 4, ch = c & 15;
        R.k[i] = *(const u32x4*)(kb + (size_t)row * pitch + ch * 8);
        if (LOADV) R.v[i] = *(const u32x4*)(vb + (size_t)row * pitch + ch * 8); }
}
template <bool LOADV>
__device__ __forceinline__ void nsa_tile_store(const TileRegs& R, LAS unsigned char* buf) {
#pragma unroll
    for (int i = 0; i < 2; ++i) { const int c = threadIdx.x + NTHR * i, row = c >> 4, ch = c & 15;
        *(LAS u32x4*)(buf + offb(row, ch)) = R.k[i];
        if (LOADV) *(LAS u32x4*)(buf + 16384 + offb(row, ch)) = R.v[i]; }
}
template <bool LOADV>
__device__ __forceinline__ void nsa_tile_glds(LAS unsigned char* buf, const bf16_t* kb, const bf16_t* vb, size_t pitch, int wid) {
    unsigned ln = threadIdx.x & 63u; asm volatile("" : "+v"(ln));
#pragma unroll
    for (int i = 0; i < 2; ++i) {
        const unsigned X = (unsigned)(wid * 1024 + i * 8192) + ln * 16u;
        const unsigned row = ((X >> 11) << 3) | ((X >> 6) & 7u), ch = (((X >> 9) & 3u) << 2) | (((X >> 4) & 3u) ^ ((row >> 2) & 3u));
        __builtin_amdgcn_global_load_lds((const unsigned*)(kb + (size_t)row * pitch + ch * 8), (LAS unsigned*)(buf + wid * 1024 + i * 8192), 16, 0, 0);
        if (LOADV) __builtin_amdgcn_global_load_lds((const unsigned*)(vb + (size_t)row * pitch + ch * 8), (LAS unsigned*)(buf + 16384 + wid * 1024 + i * 8192), 16, 0, 0);
    }
}
#define NSA_SYNC() do { asm volatile("s_waitcnt vmcnt(0)" ::: "memory"); __syncthreads(); } while (0)
struct NsaCtx {
    int lane, q32, hi, tl6, tb, ncv; unsigned mlo, mhi; float invl;
    LAS float* wsf; LAS float* impRow;
    unsigned kb[2], vb[2];
};
template <int MODE>
__device__ __forceinline__ void nsa_tile(LAS const unsigned char* Kt, const bf16x8 (&qr)[8], f32x16 (&o)[4], float& m, float& lp, const NsaCtx& cx, int j  ) {
    const int q32 = cx.q32, hi = cx.hi;
    f32x16 p0, p1;
#pragma unroll
    for (int r = 0; r < 16; ++r) { p0[r] = 0.f; p1[r] = 0.f; }
    {
        bf16x8 kc0 = *(const LAS bf16x8*)(Kt + cx.kb[0]), kc1 = *(const LAS bf16x8*)(Kt + cx.kb[0] + 8192);
#pragma unroll
        for (int s = 0; s < 8; ++s) {
            bf16x8 kn0 = kc0, kn1 = kc1;
            if (s + 1 < 8) { kn0 = *(const LAS bf16x8*)(Kt + cx.kb[(s + 1) & 1] + 512 * ((s + 1) >> 1)); kn1 = *(const LAS bf16x8*)(Kt + cx.kb[(s + 1) & 1] + 512 * ((s + 1) >> 1) + 8192); }
            asm volatile("" ::: "memory");
            p0 = __builtin_amdgcn_mfma_f32_32x32x16_bf16(kc0, qr[s], p0, 0, 0, 0);
            p1 = __builtin_amdgcn_mfma_f32_32x32x16_bf16(kc1, qr[s], p1, 0, 0, 0);
            kc0 = kn0; kc1 = kn1;
        }
    }
    const float SC = 0.08838834764831845f * 1.4426950408889634f;
    const bool selbit = (MODE == 2) ? ((((j < 32) ? (cx.mlo >> j) : (cx.mhi >> (j - 32))) & 1u) != 0u) : true;
    float tmax = NSA_NEG;
#pragma unroll
    for (int r = 0; r < 16; ++r) {
        const int kk0 = crow16(r, hi), kk1 = kk0 + 32;
        bool v0, v1;
        if (MODE <= 1) { v0 = (64 * j + kk0) < cx.ncv; v1 = (64 * j + kk1) < cx.ncv; }
        else if (MODE == 2) { v0 = selbit && (j < cx.tb || kk0 <= cx.tl6); v1 = selbit && (j < cx.tb || kk1 <= cx.tl6); }
        else { v0 = (j != cx.tb || kk0 <= cx.tl6) && (j != cx.tb - 8 || kk0 > cx.tl6); v1 = (j != cx.tb || kk1 <= cx.tl6) && (j != cx.tb - 8 || kk1 > cx.tl6); }
        p0[r] = v0 ? p0[r] * SC : NSA_NEG; p1[r] = v1 ? p1[r] * SC : NSA_NEG;
        tmax = fmaxf(tmax, fmaxf(p0[r], p1[r]));
    }
    if (MODE != 1) {
        tmax = fmaxf(tmax, __shfl_xor(tmax, 32));
        const float m_new = fmaxf(m, tmax);
        const float alpha = __builtin_amdgcn_exp2f(m - m_new);
        m = m_new;
        float ps = 0.f;
#pragma unroll
        for (int r = 0; r < 16; ++r) {
            p0[r] = (p0[r] > 0.5f * NSA_NEG) ? __builtin_amdgcn_exp2f(p0[r] - m_new) : 0.f; p1[r] = (p1[r] > 0.5f * NSA_NEG) ? __builtin_amdgcn_exp2f(p1[r] - m_new) : 0.f;
            ps += p0[r] + p1[r];
        }
        lp = lp * alpha + ps;
        if (MODE != 0) {
            if (__any(alpha != 1.f)) {
                if (hi == 0) cx.wsf[q32] = alpha;
                __builtin_amdgcn_wave_barrier();
#pragma unroll
                for (int r = 0; r < 16; ++r) { const float a = cx.wsf[crow16(r, hi)];
#pragma unroll
                    for (int c = 0; c < 4; ++c) o[c][r] *= a; }
                __builtin_amdgcn_wave_barrier();
            }
        }
    } else {
#pragma unroll
        for (int r = 0; r < 16; ++r) {
            p0[r] = (p0[r] > 0.5f * NSA_NEG) ? __builtin_amdgcn_exp2f(p0[r] - m) * cx.invl : 0.f; p1[r] = (p1[r] > 0.5f * NSA_NEG) ? __builtin_amdgcn_exp2f(p1[r] - m) * cx.invl : 0.f;
        }
#pragma unroll
        for (int kb = 0; kb < 2; ++kb)
#pragma unroll
            for (int gq = 0; gq < 4; ++gq) {
                float s4, e1;
                if (kb == 0) { e1 = p0[4 * gq + 3]; s4 = (p0[4 * gq] + p0[4 * gq + 1]) + (p0[4 * gq + 2] + e1); }
                else { e1 = p1[4 * gq + 3]; s4 = (p1[4 * gq] + p1[4 * gq + 1]) + (p1[4 * gq + 2] + e1); }
                s4 += __shfl_xor(s4, 1); s4 += __shfl_xor(s4, 2); e1 += __shfl_xor(e1, 1); e1 += __shfl_xor(e1, 2);
                const int sblk = (64 * j + 32 * kb + 8 * gq + 4 * hi) >> 2;
                if ((q32 & 3) == 0) { __hip_atomic_fetch_add(cx.impRow + sblk, s4, __ATOMIC_RELAXED, __HIP_MEMORY_SCOPE_WORKGROUP); if (sblk + 1 < 64) __hip_atomic_fetch_add(cx.impRow + sblk + 1, e1, __ATOMIC_RELAXED, __HIP_MEMORY_SCOPE_WORKGROUP); }
            }
    }
    if (MODE != 0) {
        LAS const unsigned char* Vt = Kt + 16384;
        u32x4 pw[4];
        pw[0] = (u32x4){cvt_pk_bf16(p0[0], p0[1]), cvt_pk_bf16(p0[2], p0[3]), cvt_pk_bf16(p0[4], p0[5]), cvt_pk_bf16(p0[6], p0[7])};
        pw[1] = (u32x4){cvt_pk_bf16(p0[8], p0[9]), cvt_pk_bf16(p0[10], p0[11]), cvt_pk_bf16(p0[12], p0[13]), cvt_pk_bf16(p0[14], p0[15])};
        pw[2] = (u32x4){cvt_pk_bf16(p1[0], p1[1]), cvt_pk_bf16(p1[2], p1[3]), cvt_pk_bf16(p1[4], p1[5]), cvt_pk_bf16(p1[6], p1[7])};
        pw[3] = (u32x4){cvt_pk_bf16(p1[8], p1[9]), cvt_pk_bf16(p1[10], p1[11]), cvt_pk_bf16(p1[12], p1[13]), cvt_pk_bf16(p1[14], p1[15])};
        s16x4 lo = lds_tr16(Vt + cx.vb[0]), hh = lds_tr16(Vt + cx.vb[1] + 2048);
#pragma unroll
        for (int it = 0; it < 16; ++it) {
            const int ks = it >> 2, c = it & 3, ks2 = (it + 1) >> 2, c2 = (it + 1) & 3;
            s16x4 lo2 = lo, hh2 = hh;
            if (it + 1 < 16) { lo2 = lds_tr16(Vt + cx.vb[0] + 2048 * (2 * ks2) + 512 * c2); hh2 = lds_tr16(Vt + cx.vb[1] + 2048 * (2 * ks2 + 1) + 512 * c2); }
            asm volatile("" ::: "memory");
            o[c] = __builtin_amdgcn_mfma_f32_32x32x16_bf16(__builtin_bit_cast(bf16x8, pw[ks]), cat8(lo, hh), o[c], 0, 0, 0);
            lo = lo2; hh = hh2;
        }
    }
}
template <int STAGE  >
__device__ __forceinline__ void nsa_flush(const f32x16 (&o)[4], float sc, const NsaCtx& cx, float* scr, bf16_t* yrow0  ) {
    if (cx.hi == 0) cx.wsf[cx.q32] = sc;
    __builtin_amdgcn_wave_barrier();
    unsigned lofs = (unsigned)(cx.hi * 512 + cx.q32), yofs = (unsigned)(cx.hi * 1024 + cx.q32);
    asm volatile("" : "+v"(lofs), "+v"(yofs));
    float* sp0 = scr + lofs; bf16_t* yp0 = yrow0 + yofs;
#pragma unroll
    for (int r = 0; r < 16; ++r) {
        const float a = cx.wsf[crow16(r, cx.hi)];
#pragma unroll
        for (int c = 0; c < 4; ++c) {
            float* sp = sp0 + crow16(r, 0) * 128 + 32 * c;
            float v = o[c][r] * a;
            if (STAGE >= 1) v += *sp;
            if (STAGE <= 1) *sp = v;
            else yp0[(2 * (r >> 2)) * DM + (r & 3) * 128 + 32 * c] = f2bf(v);
        }
    }
    __builtin_amdgcn_wave_barrier();
}
__device__ __forceinline__ void ph_nsa(const P& p, LAS unsigned char* lds, int bid, int nblk) {
    int tidx_ = threadIdx.x; asm volatile("" : "+v"(tidx_));
    const int tid = tidx_, wid = __builtin_amdgcn_readfirstlane(tid >> 6), lane = tid & 63;
    const bf16_t* proj = WSP(bf16_t, WS_PROJ);
    LAS float* impL = (LAS float*)(lds + NSA_IMP);
    LAS unsigned* maskL = (LAS unsigned*)(lds + NSA_MASK);
    LAS unsigned* uniL = (LAS unsigned*)(lds + NSA_UNI);
    NsaCtx cx; cx.lane = lane; cx.q32 = lane & 31; cx.hi = lane >> 5; cx.wsf = (LAS float*)(lds + NSA_WSF) + wid * 64;
    float* scr = WSP(float, WS_NSCR) + (size_t)bid * 32768 + wid * 4096;
    { const unsigned q32 = cx.q32, hi = cx.hi, blk = (lane >> 4) & 1, qq = (lane & 15) >> 2, pq = lane & 3;
      cx.kb[0] = 2048u * (q32 >> 3) + 64u * (q32 & 7u) + 16u * ((0u + hi) ^ ((q32 >> 2) & 3u));
      cx.kb[1] = 2048u * (q32 >> 3) + 64u * (q32 & 7u) + 16u * ((2u + hi) ^ ((q32 >> 2) & 3u));
      cx.vb[0] = 64u * (4u * hi + qq) + 16u * ((2u * blk + (pq >> 1)) ^ ((0u + hi) & 3u)) + 8u * (pq & 1u);
      cx.vb[1] = 64u * (4u * hi + qq) + 16u * ((2u * blk + (pq >> 1)) ^ ((2u + hi) & 3u)) + 8u * (pq & 1u); }
    for (int k2 = 0; k2 < 2; ++k2) {
        for (int ub = bid; ub < 256; ub += nblk) {
            const int idx = k2 == 0 ? ub : 511 - ub;
            const int tb = 63 - (idx >> 3), bg = idx & 7, b = bg >> 1, g = bg & 1;
            const int tokw = 64 * tb + 8 * wid;
            const int t = tokw + (cx.q32 >> 2), hq = 4 * g + (cx.q32 & 3);
            const size_t rowq = (size_t)b * SEQ + t;
            cx.tb = tb; cx.tl6 = t & 63; cx.ncv = t >= 31 ? (t - 31) / 16 + 1 : 0;
            cx.impRow = impL + (8 * wid + (cx.q32 >> 2)) * 64;
            for (int i = tid; i < 4096; i += NTHR) impL[i] = 0.f;
            bf16x8 qr[8];
#pragma unroll
            for (int s = 0; s < 8; ++s) qr[s] = *(const bf16x8*)(proj + rowq * PLD + C_NQ + hq * 128 + 16 * s + 8 * cx.hi);
            const bf16_t* gp = proj + rowq * PLD + C_NG + hq * 3;
            const float gate0 = sigmoidf_(bf2f(gp[0])), gate1 = sigmoidf_(bf2f(gp[1])), gate2 = sigmoidf_(bf2f(gp[2]));
            bf16_t* yrow0 = WSP(bf16_t, WS_YNSA) + ((size_t)b * SEQ + tokw) * DM + 4 * g * 128;
            f32x16 o[4]; float m, lp;
#define NSA_RESET() do { _Pragma("unroll") for (int c_ = 0; c_ < 4; ++c_) _Pragma("unroll") for (int r_ = 0; r_ < 16; ++r_) o[c_][r_] = 0.f; m = NSA_NEG; lp = 0.f; } while (0)
            const int ntc = (4 * tb + 3 + 63) >> 6;
            const bf16_t* kc = WSP(bf16_t, WS_KCVC) + (((size_t)0 * 4 + b) * 2 + g) * 256 * 128;
            const bf16_t* vc = WSP(bf16_t, WS_KCVC) + (((size_t)1 * 4 + b) * 2 + g) * 256 * 128;
            NSA_RESET();
            __syncthreads();
            nsa_tile_glds<false>(lds + NSA_KV0, kc, vc, 128, wid); NSA_SYNC();
            for (int i = 0; i < ntc; ++i) {
                if (i + 1 < ntc) nsa_tile_glds<false>(lds + NSA_KV0 + ((i + 1) & 1) * 32768, kc + (size_t)(i + 1) * 64 * 128, vc, 128, wid);
                nsa_tile<0>(lds + NSA_KV0 + (i & 1) * 32768, qr, o, m, lp, cx, i);
                NSA_SYNC();
            }
            { const float lt = lp + __shfl_xor(lp, 32); cx.invl = lt > 0.f ? 1.f / lt : 0.f; }
            nsa_tile_glds<true>(lds + NSA_KV0, kc, vc, 128, wid); NSA_SYNC();
            for (int i = 0; i < ntc; ++i) {
                if (i + 1 < ntc) nsa_tile_glds<true>(lds + NSA_KV0 + ((i + 1) & 1) * 32768, kc + (size_t)(i + 1) * 64 * 128, vc + (size_t)(i + 1) * 64 * 128, 128, wid);
                nsa_tile<1>(lds + NSA_KV0 + (i & 1) * 32768, qr, o, m, lp, cx, i);
                NSA_SYNC();
            }
            nsa_flush<0>(o, gate0, cx, scr, yrow0);
            unsigned ulo = 0u, uhi = 0u;
            for (int tl = 0; tl < 8; ++tl) {
                const int tt = tokw + tl, tbb = tt >> 6, s = lane;
                const float imp = impL[(8 * wid + tl) * 64 + s];
                const bool forced = (s == 0) || (s == tbb) || (s == tbb - 1), valid = s <= tbb;
                const float score = forced ? INFINITY : (valid ? imp : -INFINITY);
                int rank = 0;
                for (int jj = 0; jj < 64; ++jj) { const float sj = __shfl(score, jj); rank += (sj > score) || (sj == score && jj < s); }
                const u64 mk = __ballot(rank < 16 && score > -INFINITY);
                if (lane == 0) { maskL[(8 * wid + tl) * 2] = (unsigned)mk; maskL[(8 * wid + tl) * 2 + 1] = (unsigned)(mk >> 32); }
                ulo |= (unsigned)mk; uhi |= (unsigned)(mk >> 32);
            }
            if (lane == 0) { uniL[wid * 2] = ulo; uniL[wid * 2 + 1] = uhi; }
            __syncthreads();
            cx.mlo = maskL[(8 * wid + (cx.q32 >> 2)) * 2]; cx.mhi = maskL[(8 * wid + (cx.q32 >> 2)) * 2 + 1];
            u64 um = 0ull;
#pragma unroll
            for (int w8 = 0; w8 < 8; ++w8) um |= (u64)uniL[w8 * 2] | ((u64)uniL[w8 * 2 + 1] << 32);
            um = ((u64)__builtin_amdgcn_readfirstlane((unsigned)um)) | ((u64)__builtin_amdgcn_readfirstlane((unsigned)(um >> 32)) << 32);
            NSA_RESET();
            {
                const bf16_t* kbase = proj + (size_t)b * SEQ * PLD + C_KS + g * 128; const bf16_t* vbase = proj + (size_t)b * SEQ * PLD + C_VS + g * 128;
                u64 rem = um; int jcur = __ffsll((long long)rem) - 1; rem &= rem - 1; int i = 0;
                nsa_tile_glds<true>(lds + NSA_KV0, kbase + (size_t)jcur * 64 * PLD, vbase + (size_t)jcur * 64 * PLD, PLD, wid); NSA_SYNC();
                for (;;) {
                    const bool more = rem != 0ull; const int jn = more ? __ffsll((long long)rem) - 1 : 0; rem &= rem - 1;
                    if (more) nsa_tile_glds<true>(lds + NSA_KV0 + ((i + 1) & 1) * 32768, kbase + (size_t)jn * 64 * PLD, vbase + (size_t)jn * 64 * PLD, PLD, wid);
                    nsa_tile<2>(lds + NSA_KV0 + (i & 1) * 32768, qr, o, m, lp, cx, jcur);
                    NSA_SYNC();
                    if (!more) break;
                    jcur = jn; ++i;
                }
                const float lt = lp + __shfl_xor(lp, 32);
                nsa_flush<1>(o, lt > 0.f ? gate1 / lt : 0.f, cx, scr, yrow0);
            }
            NSA_RESET();
            {
                const bf16_t* kbase = proj + (size_t)b * SEQ * PLD + C_KW + g * 128; const bf16_t* vbase = proj + (size_t)b * SEQ * PLD + C_VW + g * 128;
                const int j0 = tb >= 8 ? tb - 8 : 0, nt = tb - j0 + 1;
                nsa_tile_glds<true>(lds + NSA_KV0, kbase + (size_t)j0 * 64 * PLD, vbase + (size_t)j0 * 64 * PLD, PLD, wid); NSA_SYNC();
                for (int i = 0; i < nt; ++i) {
                    if (i + 1 < nt) nsa_tile_glds<true>(lds + NSA_KV0 + ((i + 1) & 1) * 32768, kbase + (size_t)(j0 + i + 1) * 64 * PLD, vbase + (size_t)(j0 + i + 1) * 64 * PLD, PLD, wid);
                    nsa_tile<3>(lds + NSA_KV0 + (i & 1) * 32768, qr, o, m, lp, cx, j0 + i);
                    NSA_SYNC();
                }
                const float lt = lp + __shfl_xor(lp, 32);
                nsa_flush<2>(o, lt > 0.f ? gate2 / lt : 0.f, cx, scr, yrow0);
            }
#undef NSA_RESET
        }
    }
}
constexpr size_t WS_KCB = 808 * MiB;
constexpr size_t WS_SLAB = 824 * MiB;
constexpr size_t WS_CB1 = 856 * MiB;
struct CmpOrder {
    int G, c;
    __device__ __forceinline__ bool next(int i, pg8::Unit& u) const { const int L = i * G + c; if (L >= 128) return false; u.pm = (L >> 1) & 7; u.pn = L & 1; u.e = L >> 4; return true; }
    __device__ __forceinline__ void a_ready(const pg8::Unit&) const {}
    __device__ __forceinline__ void done(const pg8::Unit&) const {}
    __device__ __forceinline__ const char* abase(const pg8::Gemm& g, const pg8::Unit& u, size_t tstep) const { return (const char*)g.A + (size_t)(u.e >> 2) * 2048 * 2048 * 2 + (size_t)u.pm * tstep + (size_t)(u.e & 3) * 1024; }
    __device__ __forceinline__ const char* bbase(const pg8::Gemm& g, const pg8::Unit& u, size_t tstep) const { return (const char*)g.Bt + (size_t)(u.e >> 2) * 512 * 2048 * 2 + (size_t)u.pn * tstep + (size_t)(u.e & 3) * 1024; }
};
struct EpiSlab {
    static constexpr bool PERM = false, AFTER_DRAIN = false;
    float* slab;
    __device__ __forceinline__ void operator()(const pg8::f32x4 (&acc)[2][2][4][2], const pg8::Unit& u, int wr, int wc, int fr, int fq) const {
        const int row0 = u.pm * 256 + wr * 64 + fr, col0 = u.pn * 256 + wc * 32 + 4 * fq;
        float* base = slab + ((size_t)(u.e & 3) * 2 + (u.e >> 2)) * 2048 * 512;
#pragma unroll
        for (int ai = 0; ai < 2; ++ai)
#pragma unroll
            for (int m = 0; m < 4; ++m)
#pragma unroll
                for (int bj = 0; bj < 2; ++bj)
#pragma unroll
                    for (int n = 0; n < 2; ++n) *(pg8::f32x4*)(base + (size_t)(row0 + ai * 128 + m * 16) * 512 + col0 + bj * 128 + n * 16) = acc[ai][bj][m][n];
    }
};
__device__ __forceinline__ void ph_cmp_bias(const P& p) {
    const int which = threadIdx.x >> 8, n = threadIdx.x & 255;
    const float* pe = p.cmp_pe + which * 4096; const float* w1 = p.cmp_w1 + (size_t)which * 4096 * 256 + n;
    float a0 = 0.f, a1 = 0.f, a2 = 0.f, a3 = 0.f;
    for (int k = 0; k < 4096; k += 4) { a0 += pe[k] * w1[(size_t)k * 256]; a1 += pe[k + 1] * w1[(size_t)(k + 1) * 256]; a2 += pe[k + 2] * w1[(size_t)(k + 2) * 256]; a3 += pe[k + 3] * w1[(size_t)(k + 3) * 256]; }
    WSP(float, WS_CB1)[which * 256 + n] = (a0 + a1) + (a2 + a3);
}
__device__ __forceinline__ void ph_cmp_fin(const P& p, LAS unsigned char* lds, int bid, int nblk) {
    int tidx_ = threadIdx.x; asm volatile("" : "+v"(tidx_));
    const int tid = tidx_, wid = __builtin_amdgcn_readfirstlane(tid >> 6), lane = tid & 63, fr = lane & 15, fq = lane >> 4;
    LAS bf16_t* hidL = (LAS bf16_t*)lds;
    for (int it = bid; it < 64; it += nblk) {
        const int which = it >> 5, bg = (it >> 2) & 7, cb = it & 3;
        const float* slab = WSP(float, WS_SLAB); const float* cb1 = WSP(float, WS_CB1) + which * 256;
        for (int i = 0; i < 32; ++i) {
            const int e = tid + NTHR * i, r = e >> 8, n = e & 255, c = cb * 64 + r;
            const size_t rowA = (size_t)bg * 256 + c, rowB = c < 255 ? rowA + 1 : rowA;
            float v = cb1[n];
#pragma unroll
            for (int s = 0; s < 4; ++s) { const float* sl = slab + ((size_t)s * 2 + which) * 2048 * 512; v += sl[rowA * 512 + n] + sl[rowB * 512 + 256 + n]; }
            hidL[r * 264 + n] = f2bf(gelu_tanh(v));
        }
        __syncthreads();
        const bf16_t* w2t = WSP(bf16_t, WS_CW2T) + (size_t)which * 128 * 256 + (size_t)(16 * wid + fr) * 256 + 8 * fq;
        f32x4 acc[4];
#pragma unroll
        for (int ti = 0; ti < 4; ++ti) acc[ti] = (f32x4){0.f, 0.f, 0.f, 0.f};
#pragma unroll
        for (int s = 0; s < 8; ++s) {
            const bf16x8 bf = *(const bf16x8*)(w2t + 32 * s);
#pragma unroll
            for (int ti = 0; ti < 4; ++ti) { const bf16x8 af = *(const LAS bf16x8*)(hidL + (16 * ti + fr) * 264 + 32 * s + 8 * fq); acc[ti] = __builtin_amdgcn_mfma_f32_16x16x32_bf16(af, bf, acc[ti], 0, 0, 0); }
        }
        bf16_t* out = WSP(bf16_t, WS_KCVC) + (((size_t)which * 8 + bg) * 256) * 128 + 16 * wid + fr;
#pragma unroll
        for (int ti = 0; ti < 4; ++ti)
#pragma unroll
            for (int r = 0; r < 4; ++r) { const int c = cb * 64 + 16 * ti + 4 * fq + r; out[(size_t)c * 128] = c < 255 ? f2bf(acc[ti][r]) : (bf16_t)0; }
        __syncthreads();
    }
}
#ifndef REP_P0
#define REP_P0 1
#endif
#ifndef REP_INPROJ
#define REP_INPROJ 1
#endif
#ifndef REP_G3
#define REP_G3 1
#endif
#ifndef REP_G4
#define REP_G4 1
#endif
#ifndef REP_NSA
#define REP_NSA 1
#endif
#ifndef REP_MERGE
#define REP_MERGE 1
#endif
#ifndef REP_OUT
#define REP_OUT 1
#endif
#ifndef REP_MOE1
#define REP_MOE1 1
#endif
#ifndef REP_MOE2
#define REP_MOE2 1
#endif
#ifndef REP_FINAL
#define REP_FINAL 1
#endif
enum { PH_MOD = 0, PH_U1, PH_INPROJ, PH_G3, PH_G4, PH_NSA, PH_MERGE, PH_OUT, PH_ROUTE, PH_ASSIGN, PH_MOE1, PH_MOE2, PH_FINAL, PH_END };
struct Args { P p; int ph_lo, ph_hi; };
__global__ void __launch_bounds__(NTHR, 2) mega(Args a) {
    extern __shared__ __attribute__((aligned(16))) unsigned char lds_raw[];
    LAS unsigned char* lds = (LAS unsigned char*)lds_raw;
    const P& p = a.p;
    const int bid = blockIdx.x, nblk = gridDim.x;
    volatile LAS unsigned* MISC = (volatile LAS unsigned*)(lds + LDS_MISC_OFF);
    for (int u = threadIdx.x; u < (MK_LDS_BYTES - LDS_MISC_OFF) / 4; u += NTHR) ((LAS unsigned*)(lds + LDS_MISC_OFF))[u] = 0u;
    __syncthreads();
    const bool multi = (a.ph_hi - a.ph_lo) > 1;
    XcdBarrier bar; bar.bar = WSP(unsigned, WS_CTL) + CW_BAR; bar.x = 0; bar.st = nullptr;
    if (multi) bar = xcd_barrier_post(WSP(unsigned, WS_CTL) + CW_BAR, MISC + 8);
#define IN(k) (a.ph_lo <= (k) && (k) < a.ph_hi)
#define SEAM(k) do { if (IN(k) && IN((k) + 1)) xcd_barrier(bar); } while (0)
    for (int rep_ = 0; rep_ < REP_P0; ++rep_)
    if (IN(PH_MOD)) { if (bid == nblk - 1) ph_cmp_bias(p); ph_mod(p, lds, bid, nblk); ph_convert(p, lds, bid, nblk); }
    SEAM(PH_MOD);
    if (IN(PH_U1)) ph_u1(p, bid, nblk);
    SEAM(PH_U1);
    for (int rep_ = 0; rep_ < REP_INPROJ; ++rep_)
    if (IN(PH_INPROJ)) {
        pg8::Gemm g{WSP(bf16_t, WS_U1), WSP(bf16_t, WS_WINT), NTOK, PLD, 1024, 1024}; pg8::StaticOrder S; S.init(NTOK, PLD, nblk, bid);
        EpiProj E{WSP(bf16_t, WS_PROJ), PLD, WSP(bf16_t, WS_KCB)};
        pg8::gemm_phase<EpiProj, pg8::StaticOrder, true, true>(lds, g, S, E);
    }
    SEAM(PH_INPROJ);
    for (int rep_ = 0; rep_ < REP_G3; ++rep_)
    if (IN(PH_G3)) {
        ph_gla_g1(p, lds, bid, nblk);
        { pg8::Gemm g{WSP(bf16_t, WS_KCB), WSP(bf16_t, WS_CW1T), 2048, 512, 512, 2048}; CmpOrder S{nblk, bid}; EpiSlab E{WSP(float, WS_SLAB)};
          pg8::gemm_phase<EpiSlab, CmpOrder, true, true>(lds, g, S, E); }
    }
    SEAM(PH_G3);
    for (int rep_ = 0; rep_ < REP_G4; ++rep_)
    if (IN(PH_G4)) {
        ph_cmp_fin(p, lds, bid, nblk);
        ph_gla_g2(p, lds, bid, nblk);
    }
    SEAM(PH_G4);
    for (int rep_ = 0; rep_ < REP_NSA; ++rep_)
    if (IN(PH_NSA)) { ph_ygla_naive(p, bid, nblk); ph_nsa(p, lds, bid, nblk); }
    SEAM(PH_NSA);
    for (int rep_ = 0; rep_ < REP_MERGE; ++rep_)
    if (IN(PH_MERGE)) {
        pg8::StaticOrder S; S.init(NTOK, 1024, nblk, bid);
        { pg8::Gemm g{WSP(bf16_t, WS_YGLA), WSP(bf16_t, WS_PGLAT), NTOK, 1024, 1024, 1024}; EpiMerge<1> E{WSP(bf16_t, WS_PROJ), WSP(bf16_t, WS_T1), WSP(bf16_t, WS_MERG)};
          pg8::gemm_phase<EpiMerge<1>, pg8::StaticOrder, true, true>(lds, g, S, E); }
        asm volatile("s_waitcnt vmcnt(0)" ::: "memory"); __syncthreads();
        { pg8::Gemm g{WSP(bf16_t, WS_YNSA), WSP(bf16_t, WS_PNSAT), NTOK, 1024, 1024, 1024}; EpiMerge<2> E{WSP(bf16_t, WS_PROJ), WSP(bf16_t, WS_T1), WSP(bf16_t, WS_MERG)};
          pg8::gemm_phase<EpiMerge<2>, pg8::StaticOrder, true, true>(lds, g, S, E); }
    }
    SEAM(PH_MERGE);
    for (int rep_ = 0; rep_ < REP_OUT; ++rep_)
    if (IN(PH_OUT)) {
        pg8::Gemm g{WSP(bf16_t, WS_MERG), WSP(bf16_t, WS_WOUTT), NTOK, 1024, 1024, 1024}; pg8::StaticOrder S; S.init(NTOK, 1024, nblk, bid);
        EpiOut E{p.x, WSP(float, WS_MOD), WSP(float, WS_H1)};
        pg8::gemm_phase<EpiOut, pg8::StaticOrder, true, true>(lds, g, S, E);
    }
    SEAM(PH_OUT);
    if (IN(PH_ROUTE)) ph_route(p, lds, bid, nblk);
    SEAM(PH_ROUTE);
    if (IN(PH_ASSIGN)) ph_assign(p, lds, bid, nblk);
    SEAM(PH_ASSIGN);
    for (int rep_ = 0; rep_ < REP_MOE1; ++rep_)
    if (IN(PH_MOE1)) {
        const int* ctl = WSP(int, WS_CTL);
        pg8::Gemm g{WSP(bf16_t, WS_XS), WSP(bf16_t, WS_W1T), PROWS, 2048, 1024, 1024};
        MoeOrder S{ctl[CT_PTOT] / 256, 8, nblk, bid, ctl + CT_BLKE, (size_t)2048 * 1024 * 2};
        EpiSwiglu E{p.moe_b1, WSP(bf16_t, WS_ACT)};
        pg8::gemm_phase<EpiSwiglu, MoeOrder, true, true>(lds, g, S, E);
    }
    SEAM(PH_MOE1);
    for (int rep_ = 0; rep_ < REP_MOE2; ++rep_)
    if (IN(PH_MOE2)) {
        const int* ctl = WSP(int, WS_CTL);
        pg8::Gemm g{WSP(bf16_t, WS_ACT), WSP(bf16_t, WS_W2T), PROWS, 1024, 1024, 1024};
        MoeOrder S{ctl[CT_PTOT] / 256, 4, nblk, bid, ctl + CT_BLKE, (size_t)1024 * 1024 * 2};
        EpiMoe2 E{p.moe_b2, WSP(bf16_t, WS_YSLOT)};
        pg8::gemm_phase<EpiMoe2, MoeOrder, true, true>(lds, g, S, E);
    }
    SEAM(PH_MOE2);
    for (int rep_ = 0; rep_ < REP_FINAL; ++rep_)
    if (IN(PH_FINAL)) ph_final(p, bid, nblk);
#undef IN
#undef SEAM
}

extern "C" void kernel_launch(void* const* d_in, const int* in_sizes, int n_in, void* d_out, int out_size, void* d_ws, size_t ws_size, hipStream_t stream) {
    static bool attr_done = false;
    if (!attr_done) { (void)hipFuncSetAttribute((const void*)mega, hipFuncAttributeMaxDynamicSharedMemorySize, MK_LDS_BYTES); attr_done = true; }
    Args a{};
    const float** pp = (const float**)&a.p;
    for (int i = 0; i < 23; ++i) pp[i] = (const float*)d_in[i];
    a.p.out = (float*)d_out; a.p.ws = (unsigned char*)d_ws;
    (void)hipMemsetAsync((char*)d_ws + WS_CTL, 0, 65536, stream);
    a.ph_lo = 0; a.ph_hi = PH_END;
    hipLaunchKernelGGL(mega, dim3(256), dim3(NTHR), MK_LDS_BYTES, stream, a);
}
```

```cpp
#include <hip/hip_runtime.h>
#include <stdint.h>
#include <math.h>

typedef unsigned short bf16_t;
typedef unsigned long long u64;

constexpr int BATCH = 4, SEQ = 4096, DM = 1024, NTOK = BATCH * SEQ;
constexpr int IN_COLS = 7720, PLD = 7936;
constexpr int C_GQ = 0, C_GK = 512, C_GV = 1024, C_GR = 2048, C_NQ = 3072, C_KC = 4096, C_VC = 4352, C_KS = 4608, C_VS = 4864,
              C_KW = 5120, C_VW = 5376, C_MG = 5632, C_GA = 7680, C_NG = 7696;
constexpr int NCMP = 255, NSEL = 64, NEXP = 32, TOPK = 4, MOEB = 256;
constexpr int PROWS = NTOK * TOPK + NEXP * MOEB;
constexpr float RMS_EPS = 1e-5f;

__host__ __device__ inline int orig_col(int j) {
    if (j < 3072) return j;
    if (j < 5632) return j + 16;
    if (j < 7680) return j + 40;
    if (j < 7696) return j - 4608;
    return j - 2048;
}

constexpr size_t MiB = 1u << 20;
constexpr size_t WS_CTL = 0;
constexpr size_t WS_MOD = 1 * MiB;
constexpr size_t WS_W1T = 2 * MiB;
constexpr size_t WS_W2T = 130 * MiB;
constexpr size_t WS_WINT = 194 * MiB;
constexpr size_t WS_PGLAT = 210 * MiB, WS_PNSAT = 212 * MiB, WS_WOUTT = 214 * MiB;
constexpr size_t WS_CW1T = 216 * MiB;
constexpr size_t WS_CW2T = 220 * MiB;
constexpr size_t WS_H1 = 221 * MiB;
constexpr size_t WS_U2 = 285 * MiB;
constexpr size_t WS_TOPE = 317 * MiB;
constexpr size_t WS_TOPW = 317 * MiB + 512 * 1024;
constexpr size_t WS_ROWTOK = 318 * MiB;
constexpr size_t WS_SLOTOF = 318 * MiB + 512 * 1024;
constexpr size_t WS_U1 = 320 * MiB;
constexpr size_t WS_PROJ = 352 * MiB;
constexpr size_t WS_MG8 = 600 * MiB;
constexpr size_t WS_OGLA = 632 * MiB;
constexpr size_t WS_YGLA = 696 * MiB;
constexpr size_t WS_HID = 728 * MiB;
constexpr size_t WS_KCVC = 732 * MiB;
constexpr size_t WS_SELM = 734 * MiB;
constexpr size_t WS_OCMP = 735 * MiB;
constexpr size_t WS_OSEL = 799 * MiB;
constexpr size_t WS_OWIN = 863 * MiB;
constexpr size_t WS_YNSA = 927 * MiB;
constexpr size_t WS_MERG = 959 * MiB;
constexpr size_t WS_T1 = 991 * MiB;
constexpr size_t WS_TMPF = 600 * MiB;
constexpr size_t WS_XS = 320 * MiB;
constexpr size_t WS_ACT = 464 * MiB;
constexpr size_t WS_YSLOT = 608 * MiB;
constexpr int CT_CNT = 0, CT_FILL = 64, CT_PSTART = 128, CT_PTOT = 192, CT_CVQ = 200  , CT_BLKE = 256;

__device__ __forceinline__ float bf2f(bf16_t v) { return __uint_as_float(((unsigned)v) << 16); }
__device__ __forceinline__ bf16_t f2bf(float f) { unsigned u = __float_as_uint(f); return (bf16_t)((u + 0x7fffu + ((u >> 16) & 1u)) >> 16); }
__device__ __forceinline__ float sigmoidf_(float x) { return __builtin_amdgcn_rcpf(1.f + __expf(-x)); }
__device__ __forceinline__ float siluf_(float x) { return x * __builtin_amdgcn_rcpf(1.f + __expf(-x)); }
__device__ __forceinline__ float wave_sum(float v) {
#pragma unroll
    for (int o = 1; o < 64; o <<= 1) v += __shfl_xor(v, o);
    return v;
}
__device__ __forceinline__ float wave_max(float v) {
#pragma unroll
    for (int o = 1; o < 64; o <<= 1) v = fmaxf(v, __shfl_xor(v, o));
    return v;
}

struct P {
    const float *x, *c, *w_ada, *b_ada, *norm1_g, *w_in, *gla_wa2, *gla_ba, *gla_norm_g, *cmp_pe, *cmp_w1, *cmp_w2, *proj_gla, *proj_nsa,
        *w_out, *norm2_g, *router_w, *router_b, *moe_w1, *moe_b1, *moe_w2, *moe_b2, *final_g;
    float* out;
    unsigned char* ws;
};
#define WSP(T, off) ((T*)(p.ws + (off)))

__device__ __forceinline__ float gelu_tanh(float x) { const float u = 0.7978845608028654f * (x + 0.044715f * x * x * x); return 0.5f * x * (1.f + tanhf(u)); }
#ifndef EPI_REP
#define EPI_REP 1
#endif
__device__ __forceinline__ int mk_lane_asm() { int l; asm volatile("v_mbcnt_lo_u32_b32 %0, -1, 0\n\tv_mbcnt_hi_u32_b32 %0, -1, %0" : "=v"(l)); return l; }
#define MK_TID (mk_wk * 64 + mk_lane_asm())
namespace pg8 {
#define PG8_LAS __attribute__((address_space(3)))
typedef unsigned short bf16_t;
typedef short bf16x8 __attribute__((ext_vector_type(8)));
typedef float f32x4 __attribute__((ext_vector_type(4)));
typedef unsigned u32x4 __attribute__((ext_vector_type(4)));
constexpr int BM = 256, BK = 64, HALF = 128, HTB = HALF * BK * 2  , STAGE_BYTES = 8 * HTB, NXCD = 8, WGM = 8;

__host__ __device__ __forceinline__ int lds_byte(int r, int c) { const int st = (r >> 4) * 2 + (c >> 5), rr = r & 15, cc = c & 31, ob = rr * 64 + cc * 2; return st * 1024 + (ob ^ (((ob >> 9) & 1) << 5)); }
__host__ __device__ __forceinline__ void stage_rc(int b, int& R, int& C) { const int st = b / 1024, sb = b % 1024, swz = sb ^ (((sb >> 9) & 1) << 5); R = (st >> 1) * 16 + swz / 64; C = (st & 1) * 32 + (swz % 64) / 2; }
__host__ __device__ __forceinline__ int perm32(int rho) { const int n = rho >> 4, i = rho & 15; return 8 * (i >> 2) + 4 * n + (i & 3); }

struct Unit { int pm, pn, e; };
struct Gemm { const bf16_t* A; const bf16_t* Bt; int M, N, K, ld; };

struct StaticOrder {
    int nM, nN, nwg, G, c;
    __host__ __device__ void init(int M, int N, int G_, int c_) { nM = M / BM; nN = N / BM; nwg = nM * nN; G = G_; c = c_; }
    __host__ __device__ bool next(int i, Unit& u) const {
        const long L = (long)i * G + c; if (L >= nwg) return false;
        int wgid = (int)L; { const int q = nwg / NXCD, r = nwg % NXCD, xcd = wgid % NXCD, off = wgid / NXCD; wgid = (xcd < r ? xcd * (q + 1) : r * (q + 1) + (xcd - r) * q) + off; }
        const int nig = WGM * nN, gid = wgid / nig, fm = gid * WGM, gsz = (nM - fm) < WGM ? (nM - fm) : WGM;
        u.pm = fm + ((wgid % nig) % gsz); u.pn = (wgid % nig) / gsz; u.e = 0; return true;
    }
    __device__ __forceinline__ void a_ready(const Unit&) const {}
    __device__ __forceinline__ void done(const Unit&) const {}
    __device__ __forceinline__ const char* abase(const Gemm& g, const Unit& u, size_t tstep) const { return (const char*)g.A + (size_t)u.pm * tstep; }
    __device__ __forceinline__ const char* bbase(const Gemm& g, const Unit& u, size_t tstep) const { return (const char*)g.Bt + (size_t)u.pn * tstep; }
};

template <class Epi, class Sched, bool ALIGN_EPI = false, bool SP2 = false, bool FP8 = false>
__device__ __forceinline__ void gemm_phase(PG8_LAS unsigned char* lds, const Gemm g, const Sched& S, const Epi& E, int mk_wk) {
    int tid_ = MK_TID; asm volatile("" : "+v"(tid_));
    const int tid = tid_, wid = __builtin_amdgcn_readfirstlane(tid >> 6), lane = tid & 63, wr = wid >> 2, wc = wid & 3, fr = lane & 15, fq = lane >> 4;
    const int K = g.ld, nt = g.K / BK;
    unsigned voffA[2], voffB[2];
#pragma unroll
    for (int i = 0; i < 2; ++i) { int R, C; stage_rc(tid * 16 + i * 8192, R, C); const int Rb = Epi::PERM ? ((R & ~31) + perm32(R & 31)) : R;
        voffA[i] = (unsigned)(R * K + C) * 2u; voffB[i] = (unsigned)(Rb * K + C) * 2u; }
    const size_t kstep = (size_t)(BK * 2);
    const size_t hstep = (size_t)HALF * K * 2;
    const size_t tstep = 2 * hstep;
    const unsigned ldsw = (unsigned)wid * 1024u;
    const int aoff = lds_byte(wr * 64 + fr, fq * 8), boff = lds_byte(wc * 32 + fr, fq * 8);
#define PG8_SA(b, h) (((b) * 2 + (h)) * HTB)
#define PG8_SB(b, h) ((4 + (b) * 2 + (h)) * HTB)
#define PG8_STAGE(bufoff, gbase, voff) do { _Pragma("unroll") for (int _i = 0; _i < 2; ++_i) { unsigned vo_ = (voff)[_i]; if constexpr (FP8) asm volatile("" : "+v"(vo_));     \
        __builtin_amdgcn_global_load_lds((const unsigned*)((const char*)(gbase) + vo_), (PG8_LAS unsigned*)(lds + (bufoff) + ldsw + _i * 8192), 16, 0, 0); } } while (0)
#define PG8_LDA(dst, b, h) do { _Pragma("unroll") for (int m = 0; m < 4; ++m) { const v4i_ l0_ = *(const PG8_LAS v4i_*)(lds + PG8_SA(b, h) + aoff + m * 2048), l1_ = *(const PG8_LAS v4i_*)(lds + PG8_SA(b, h) + aoff + m * 2048 + 1024); \
        dst[m] = __builtin_shufflevector(l0_, l1_, 0, 1, 2, 3, 4, 5, 6, 7); } } while (0)
#define PG8_LDB(dst, b, h) do { _Pragma("unroll") for (int n = 0; n < 2; ++n) { const v4i_ l0_ = *(const PG8_LAS v4i_*)(lds + PG8_SB(b, h) + boff + n * 2048), l1_ = *(const PG8_LAS v4i_*)(lds + PG8_SB(b, h) + boff + n * 2048 + 1024); \
        dst[n] = __builtin_shufflevector(l0_, l1_, 0, 1, 2, 3, 4, 5, 6, 7); } } while (0)
#define PG8_MMA(ai, bj, At, Bt) do { __builtin_amdgcn_s_setprio(1); _Pragma("unroll") for (int m = 0; m < 4; ++m) _Pragma("unroll") for (int n = 0; n < 2; ++n) { \
        if constexpr (FP8) acc[ai][bj][m][n] = __builtin_amdgcn_mfma_scale_f32_16x16x128_f8f6f4(Bt[n], At[m], acc[ai][bj][m][n], 0, 0, 0, 0x7a7a7a7a, 0, 0x7f7f7f7f); \
        else { acc[ai][bj][m][n] = __builtin_amdgcn_mfma_f32_16x16x32_bf16(__builtin_bit_cast(bf16x8, __builtin_shufflevector(Bt[n], Bt[n], 0, 1, 2, 3)), __builtin_bit_cast(bf16x8, __builtin_shufflevector(At[m], At[m], 0, 1, 2, 3)), acc[ai][bj][m][n], 0, 0, 0); \
               acc[ai][bj][m][n] = __builtin_amdgcn_mfma_f32_16x16x32_bf16(__builtin_bit_cast(bf16x8, __builtin_shufflevector(Bt[n], Bt[n], 4, 5, 6, 7)), __builtin_bit_cast(bf16x8, __builtin_shufflevector(At[m], At[m], 4, 5, 6, 7)), acc[ai][bj][m][n], 0, 0, 0); } } \
        __builtin_amdgcn_s_setprio(0); } while (0)
#define PG8_WAIT_V(n) asm volatile("s_waitcnt vmcnt(" #n ")" ::: "memory")
#define PG8_WAIT_L(n) asm volatile("s_waitcnt lgkmcnt(" #n ")" ::: "memory")
#define PG8_BAR __builtin_amdgcn_s_barrier()
#define PG8_SCHED __builtin_amdgcn_sched_barrier(0)
    Unit cur, nxt; int ui = 0;
    if (!S.next(0, cur)) return;
    f32x4 acc[2][2][4][2];
#pragma unroll
    for (int a = 0; a < 2; ++a)
#pragma unroll
        for (int b = 0; b < 2; ++b)
#pragma unroll
            for (int m = 0; m < 4; ++m)
#pragma unroll
                for (int n = 0; n < 2; ++n) acc[a][b][m][n] = (f32x4){0.f, 0.f, 0.f, 0.f};
    typedef int v4i_ __attribute__((ext_vector_type(4))); typedef int v8i_ __attribute__((ext_vector_type(8)));
    v8i_ At[4], B0[2], B1[2];
    const char* cA = S.abase(g, cur, tstep); const char* cB = S.bbase(g, cur, tstep);
    S.a_ready(cur);
    if constexpr (SP2) {
        PG8_STAGE(PG8_SB(0, 0), cB, voffB); PG8_STAGE(PG8_SB(0, 1), cB + hstep, voffB); PG8_STAGE(PG8_SA(0, 0), cA, voffA); PG8_STAGE(PG8_SA(0, 1), cA + hstep, voffA);
        if (wr == 1) PG8_BAR;
        PG8_WAIT_V(2); PG8_BAR;
        PG8_STAGE(PG8_SB(1, 0), cB + kstep, voffB); PG8_STAGE(PG8_SA(1, 0), cA + kstep, voffA); PG8_STAGE(PG8_SB(1, 1), cB + hstep + kstep, voffB);
        PG8_WAIT_V(6); PG8_BAR;
    } else {
        PG8_STAGE(PG8_SB(0, 0), cB, voffB); PG8_STAGE(PG8_SA(0, 0), cA, voffA); PG8_STAGE(PG8_SB(0, 1), cB + hstep, voffB); PG8_STAGE(PG8_SA(0, 1), cA + hstep, voffA);
        if (wr == 1) PG8_BAR;
        PG8_WAIT_V(4); PG8_BAR;
        PG8_STAGE(PG8_SB(1, 0), cB + kstep, voffB); PG8_STAGE(PG8_SA(1, 0), cA + kstep, voffA); PG8_STAGE(PG8_SB(1, 1), cB + hstep + kstep, voffB);
        PG8_WAIT_V(6); PG8_BAR;
    }
    for (;;) {
        const bool has_next = S.next(ui + 1, nxt);
        const char* nA = has_next ? S.abase(g, nxt, tstep) : cA; const char* nB = has_next ? S.bbase(g, nxt, tstep) : cB;
#pragma unroll 1
        for (int t = 0; t < nt; t += 2) {
            const bool last = (t == nt - 2);
            const char* a1 = cA + (size_t)(t + 1) * kstep;
            const char* a2 = last ? nA : cA + (size_t)(t + 2) * kstep; const char* b2 = last ? nB : cB + (size_t)(t + 2) * kstep;
            const char* a3 = a2 + kstep; const char* b3 = b2 + kstep;
            if (last && has_next) S.a_ready(nxt);
            if constexpr (SP2) {
            PG8_LDB(B0, 0, 0); PG8_LDB(B1, 0, 1); PG8_SCHED; PG8_LDA(At, 0, 0); PG8_STAGE(PG8_SA(1, 1), a1 + hstep, voffA);
            PG8_WAIT_V(8); PG8_WAIT_L(0); PG8_BAR; PG8_MMA(0, 0, At, B0); PG8_MMA(0, 1, At, B1); PG8_BAR; PG8_SCHED;
            PG8_LDA(At, 0, 1); PG8_STAGE(PG8_SB(0, 0), b2, voffB); PG8_STAGE(PG8_SB(0, 1), b2 + hstep, voffB); PG8_STAGE(PG8_SA(0, 0), a2, voffA);
            PG8_WAIT_V(8); PG8_WAIT_L(0); PG8_BAR; PG8_MMA(1, 0, At, B0); PG8_MMA(1, 1, At, B1); PG8_BAR; PG8_SCHED;
            PG8_LDB(B0, 1, 0); PG8_LDB(B1, 1, 1); PG8_SCHED; PG8_LDA(At, 1, 0); PG8_STAGE(PG8_SA(0, 1), a2 + hstep, voffA);
            PG8_WAIT_V(8); PG8_WAIT_L(0); PG8_BAR; PG8_MMA(0, 0, At, B0); PG8_MMA(0, 1, At, B1); PG8_BAR; PG8_SCHED;
            PG8_LDA(At, 1, 1); PG8_STAGE(PG8_SB(1, 0), b3, voffB); PG8_STAGE(PG8_SB(1, 1), b3 + hstep, voffB); PG8_STAGE(PG8_SA(1, 0), a3, voffA);
            PG8_WAIT_V(8); PG8_WAIT_L(0); PG8_BAR; PG8_MMA(1, 0, At, B0); PG8_MMA(1, 1, At, B1); PG8_BAR; PG8_SCHED;
            } else {
            PG8_LDB(B0, 0, 0); PG8_SCHED; PG8_LDA(At, 0, 0); PG8_STAGE(PG8_SA(1, 1), a1 + hstep, voffA);
            PG8_WAIT_L(8); PG8_BAR; PG8_WAIT_L(0); PG8_MMA(0, 0, At, B0); PG8_BAR; PG8_SCHED;
            PG8_LDB(B1, 0, 1); PG8_STAGE(PG8_SB(0, 0), b2, voffB);
            PG8_BAR; PG8_WAIT_L(0); PG8_MMA(0, 1, At, B1); PG8_BAR;
            PG8_LDA(At, 0, 1); PG8_STAGE(PG8_SA(0, 0), a2, voffA);
            PG8_BAR; PG8_WAIT_L(0); PG8_MMA(1, 0, At, B0); PG8_BAR; PG8_SCHED;
            PG8_STAGE(PG8_SB(0, 1), b2 + hstep, voffB);
            PG8_WAIT_V(6); PG8_BAR; PG8_MMA(1, 1, At, B1); PG8_BAR;
            PG8_LDB(B0, 1, 0); PG8_SCHED; PG8_LDA(At, 1, 0); PG8_STAGE(PG8_SA(0, 1), a2 + hstep, voffA);
            PG8_WAIT_L(8); PG8_BAR; PG8_WAIT_L(0); PG8_MMA(0, 0, At, B0); PG8_BAR; PG8_SCHED;
            PG8_LDB(B1, 1, 1); PG8_STAGE(PG8_SB(1, 0), b3, voffB);
            PG8_BAR; PG8_WAIT_L(0); PG8_MMA(0, 1, At, B1); PG8_BAR;
            PG8_LDA(At, 1, 1); PG8_STAGE(PG8_SA(1, 0), a3, voffA);
            PG8_BAR; PG8_WAIT_L(0); PG8_MMA(1, 0, At, B0); PG8_BAR; PG8_SCHED;
            PG8_STAGE(PG8_SB(1, 1), b3 + hstep, voffB);
            PG8_WAIT_V(6); PG8_BAR; PG8_MMA(1, 1, At, B1); PG8_BAR;
            }
        }
        if constexpr (ALIGN_EPI) { if (wr == 0) PG8_BAR; }
        if constexpr (!Epi::AFTER_DRAIN) { int te_ = MK_TID; asm volatile("" : "+v"(te_));
            for (int er_ = 0; er_ < EPI_REP; ++er_) E(acc, cur, wr, wc, te_ & 15, (te_ >> 4) & 3); S.done(cur); }
        if (!has_next) break;
#pragma unroll
        for (int a = 0; a < 2; ++a)
#pragma unroll
            for (int b = 0; b < 2; ++b)
#pragma unroll
                for (int m = 0; m < 4; ++m)
#pragma unroll
                    for (int n = 0; n < 2; ++n) acc[a][b][m][n] = (f32x4){0.f, 0.f, 0.f, 0.f};
        cur = nxt; cA = nA; cB = nB; ++ui;
        if constexpr (ALIGN_EPI) { if (wr == 1) PG8_BAR; }
    }
    PG8_WAIT_V(0);
    if constexpr (!ALIGN_EPI) { if (wr == 0) PG8_BAR; }
    PG8_BAR;
    if constexpr (Epi::AFTER_DRAIN) { E.fused(acc, cur, wr, wc, fr, fq, lds, wid, lane); S.done(cur); }
#undef PG8_SA
#undef PG8_SB
#undef PG8_STAGE
#undef PG8_LDA
#undef PG8_LDB
#undef PG8_MMA
#undef PG8_WAIT_V
#undef PG8_WAIT_L
#undef PG8_BAR
#undef PG8_SCHED
}
}

#define LAS __attribute__((address_space(3)))
#define GAS __attribute__((address_space(1)))
typedef float f32x4 __attribute__((ext_vector_type(4)));
typedef unsigned u32x4 __attribute__((ext_vector_type(4)));
typedef unsigned u32x2 __attribute__((ext_vector_type(2)));
typedef short bf16x8 __attribute__((ext_vector_type(8)));
constexpr int NTHR = 512, NWAVES = 8;
constexpr int MK_LDS_BYTES = 163840;
constexpr int LDS_MISC_OFF = 163584;

__device__ __forceinline__ unsigned pk4_fp8(float a, float b, float c, float d) { unsigned w = 0u; w = __builtin_amdgcn_cvt_pk_fp8_f32(a, b, w, false); w = __builtin_amdgcn_cvt_pk_fp8_f32(c, d, w, true); return w; }
__device__ __forceinline__ unsigned cvt_pk_bf16(float lo, float hi) { unsigned r; asm volatile("v_cvt_pk_bf16_f32 %0, %1, %2" : "=v"(r) : "v"(lo), "v"(hi)); return r; }

struct EpiProj {
    static constexpr bool PERM = true, AFTER_DRAIN = false;
    bf16_t* O; int ldc; bf16_t* kcb; unsigned char* mg8;
    __device__ __forceinline__ void operator()(const pg8::f32x4 (&acc)[2][2][4][2], const pg8::Unit& u, int wr, int wc, int fr, int fq) const {
        const int row0 = u.pm * 256 + wr * 64 + fr, col0 = u.pn * 256 + wc * 32 + 8 * fq;
#pragma unroll
        for (int ai = 0; ai < 2; ++ai)
#pragma unroll
            for (int m = 0; m < 4; ++m) { bf16_t* rowp = O + (size_t)(row0 + ai * 128 + m * 16) * ldc + col0;
#pragma unroll
                for (int bj = 0; bj < 2; ++bj) { const pg8::f32x4 v0 = acc[ai][bj][m][0], v1 = acc[ai][bj][m][1];
                    u32x4 w; w.x = cvt_pk_bf16(v0[0], v0[1]); w.y = cvt_pk_bf16(v0[2], v0[3]); w.z = cvt_pk_bf16(v1[0], v1[1]); w.w = cvt_pk_bf16(v1[2], v1[3]);
                    if (u.pn >= 22 && u.pn <= 29) {
                        unsigned g0 = 0u, g1 = 0u;
                        g0 = __builtin_amdgcn_cvt_pk_u8_f32(255.f * sigmoidf_(v0[0]), 0, g0); g0 = __builtin_amdgcn_cvt_pk_u8_f32(255.f * sigmoidf_(v0[1]), 1, g0);
                        g0 = __builtin_amdgcn_cvt_pk_u8_f32(255.f * sigmoidf_(v0[2]), 2, g0); g0 = __builtin_amdgcn_cvt_pk_u8_f32(255.f * sigmoidf_(v0[3]), 3, g0);
                        g1 = __builtin_amdgcn_cvt_pk_u8_f32(255.f * sigmoidf_(v1[0]), 0, g1); g1 = __builtin_amdgcn_cvt_pk_u8_f32(255.f * sigmoidf_(v1[1]), 1, g1);
                        g1 = __builtin_amdgcn_cvt_pk_u8_f32(255.f * sigmoidf_(v1[2]), 2, g1); g1 = __builtin_amdgcn_cvt_pk_u8_f32(255.f * sigmoidf_(v1[3]), 3, g1);
                        u32x2 gw; gw.x = g0; gw.y = g1;
                        *(u32x2*)(mg8 + (size_t)(row0 + ai * 128 + m * 16) * 2048 + (u.pn - 22) * 256 + wc * 32 + 8 * fq + bj * 128) = gw; }
                    else if (u.pn >= 16 && u.pn <= 21) { const int row = row0 + ai * 128 + m * 16;
                        *(u32x4*)(kcb + ((((size_t)(u.pn - 16) * 4 + (row >> 12)) * 2 + bj) * 4096 + (row & 4095)) * 128 + wc * 32 + 8 * fq) = w; }
                    else *(u32x4*)(rowp + bj * 128) = w; } }
    }
};
__device__ __forceinline__ float bflo(unsigned w) { return __uint_as_float(w << 16); }
__device__ __forceinline__ float bfhi(unsigned w) { return __uint_as_float(w & 0xffff0000u); }
template <int STEP> struct EpiMerge {
    static constexpr bool PERM = true, AFTER_DRAIN = false;
    const unsigned char* mg8; bf16_t* T1; bf16_t* MG;
    __device__ __forceinline__ void operator()(const pg8::f32x4 (&acc)[2][2][4][2], const pg8::Unit& u, int wr, int wc, int fr, int fq) const {
        const int row0 = u.pm * 256 + wr * 64 + fr, col0 = u.pn * 256 + wc * 32 + 8 * fq;
#pragma unroll
        for (int ai = 0; ai < 2; ++ai)
#pragma unroll
            for (int m = 0; m < 4; ++m) { const size_t row = (size_t)(row0 + ai * 128 + m * 16);
#pragma unroll
                for (int bj = 0; bj < 2; ++bj) { const int col = col0 + bj * 128;
                    const u32x2 g = *(const u32x2*)(mg8 + row * 2048 + (STEP == 2 ? 1024 : 0) + col);
                    const pg8::f32x4 v0 = acc[ai][bj][m][0] * (1.f / 255.f), v1 = acc[ai][bj][m][1] * (1.f / 255.f);
                    float r[8];
                    r[0] = (float)((g.x >> 0) & 0xffu) * v0[0]; r[1] = (float)((g.x >> 8) & 0xffu) * v0[1]; r[2] = (float)((g.x >> 16) & 0xffu) * v0[2]; r[3] = (float)((g.x >> 24) & 0xffu) * v0[3];
                    r[4] = (float)((g.y >> 0) & 0xffu) * v1[0]; r[5] = (float)((g.y >> 8) & 0xffu) * v1[1]; r[6] = (float)((g.y >> 16) & 0xffu) * v1[2]; r[7] = (float)((g.y >> 24) & 0xffu) * v1[3];
                    if (STEP == 2) { const u32x4 t = *(const u32x4*)(T1 + row * DM + col);
                        r[0] += bflo(t.x); r[1] += bfhi(t.x); r[2] += bflo(t.y); r[3] += bfhi(t.y); r[4] += bflo(t.z); r[5] += bfhi(t.z); r[6] += bflo(t.w); r[7] += bfhi(t.w); }
                    u32x4 w; w.x = cvt_pk_bf16(r[0], r[1]); w.y = cvt_pk_bf16(r[2], r[3]); w.z = cvt_pk_bf16(r[4], r[5]); w.w = cvt_pk_bf16(r[6], r[7]);
                    *(u32x4*)((STEP == 2 ? MG : T1) + row * DM + col) = w; } }
    }
};
struct EpiOut {
    static constexpr bool PERM = false, AFTER_DRAIN = false;
    const float* x; const float* mod; bf16_t* h1;
    __device__ __forceinline__ void operator()(const pg8::f32x4 (&acc)[2][2][4][2], const pg8::Unit& u, int wr, int wc, int fr, int fq) const {
        const int row0 = u.pm * 256 + wr * 64 + fr, col0 = u.pn * 256 + wc * 32 + 4 * fq;
        const float* gate = mod + (u.pm * 256 / SEQ) * 6144 + 2048;
#pragma unroll
        for (int bj = 0; bj < 2; ++bj)
#pragma unroll
            for (int n = 0; n < 2; ++n) { const int col = col0 + bj * 128 + n * 16; const pg8::f32x4 gv = *(const pg8::f32x4*)(gate + col);
#pragma unroll
                for (int ai = 0; ai < 2; ++ai)
#pragma unroll
                    for (int m = 0; m < 4; ++m) { const size_t off = (size_t)(row0 + ai * 128 + m * 16) * DM + col;
                        const pg8::f32x4 xv = *(const pg8::f32x4*)(x + off); const pg8::f32x4 hv = xv + gv * acc[ai][bj][m][n];
                        u32x2 w; w.x = cvt_pk_bf16(hv[0], hv[1]); w.y = cvt_pk_bf16(hv[2], hv[3]); *(u32x2*)(h1 + off) = w; } }
    }
};
struct EpiSwiglu {
    static constexpr bool PERM = true, AFTER_DRAIN = false;
    const float* b1; bf16_t* act; const int* blk_e;
    __device__ __forceinline__ void operator()(const pg8::f32x4 (&acc)[2][2][4][2], const pg8::Unit& u, int wr, int wc, int fr, int fq) const {
        const int row0 = u.pm * 256 + wr * 64 + fr, col0 = u.pn * 128 + wc * 32 + 8 * fq;
        const int e_ = __builtin_amdgcn_readfirstlane(blk_e[u.pm]);
        const float* bg = b1 + e_ * 2048 + col0; const float* bu = bg + 1024;
        float gb[8], ub[8];
#pragma unroll
        for (int j = 0; j < 8; ++j) { gb[j] = bg[j]; ub[j] = bu[j]; }
#pragma unroll
        for (int ai = 0; ai < 2; ++ai)
#pragma unroll
            for (int m = 0; m < 4; ++m) { float r[8];
#pragma unroll
                for (int j = 0; j < 8; ++j) { float g = acc[ai][0][m][j >> 2][j & 3] + gb[j], uu = acc[ai][1][m][j >> 2][j & 3] + ub[j];
                    g = fminf(g, 7.f); uu = fminf(fmaxf(uu, -7.f), 7.f); r[j] = g * sigmoidf_(1.702f * g) * (uu + 1.f); }
                u32x2 w; w.x = pk4_fp8(r[0], r[1], r[2], r[3]); w.y = pk4_fp8(r[4], r[5], r[6], r[7]);
                *(u32x2*)((unsigned char*)act + (size_t)(row0 + ai * 128 + m * 16) * DM + col0) = w; }
    }
};
struct EpiMoe2 {
    static constexpr bool PERM = true, AFTER_DRAIN = false;
    const float* b2; bf16_t* ys; const int* blk_e;
    __device__ __forceinline__ void operator()(const pg8::f32x4 (&acc)[2][2][4][2], const pg8::Unit& u, int wr, int wc, int fr, int fq) const {
        const int row0 = u.pm * 256 + wr * 64 + fr, col0 = u.pn * 256 + wc * 32 + 8 * fq;
        const int e_ = __builtin_amdgcn_readfirstlane(blk_e[u.pm]);
#pragma unroll
        for (int bj = 0; bj < 2; ++bj) { const float* bb = b2 + e_ * 1024 + col0 + bj * 128; float bv[8];
#pragma unroll
            for (int j = 0; j < 8; ++j) bv[j] = bb[j];
#pragma unroll
            for (int ai = 0; ai < 2; ++ai)
#pragma unroll
                for (int m = 0; m < 4; ++m) { const pg8::f32x4 v0 = acc[ai][bj][m][0], v1 = acc[ai][bj][m][1];
                    u32x4 w; w.x = cvt_pk_bf16(v0[0] + bv[0], v0[1] + bv[1]); w.y = cvt_pk_bf16(v0[2] + bv[2], v0[3] + bv[3]); w.z = cvt_pk_bf16(v1[0] + bv[4], v1[1] + bv[5]); w.w = cvt_pk_bf16(v1[2] + bv[6], v1[3] + bv[7]);
                    *(u32x4*)(ys + (size_t)(row0 + ai * 128 + m * 16) * DM + col0 + bj * 128) = w; } }
    }
};
struct MoeOrder {
    int lo, n, nN, gsz, j; const int* blk_e; size_t estride;
    __device__ __forceinline__ MoeOrder(const int* ctl, int nN_, int G, int c, size_t es) { const int x = c & 7, nt = ctl[CT_PTOT] / 256; lo = (x * nt) >> 3; n = (((x + 1) * nt) >> 3) - lo; nN = nN_; gsz = (G - x + 7) >> 3; j = c >> 3; blk_e = ctl + CT_BLKE; estride = es; }
    __device__ __forceinline__ bool next(int i, pg8::Unit& u) const { const int L = i * gsz + j; if (L >= n * nN) return false; u.pm = lo + L / nN; u.pn = L % nN; u.e = blk_e[u.pm]; return true; }
    __device__ __forceinline__ void a_ready(const pg8::Unit&) const {}
    __device__ __forceinline__ void done(const pg8::Unit&) const {}
    __device__ __forceinline__ const char* abase(const pg8::Gemm& g, const pg8::Unit& u, size_t tstep) const { return (const char*)g.A + (size_t)u.pm * tstep; }
    __device__ __forceinline__ const char* bbase(const pg8::Gemm& g, const pg8::Unit& u, size_t tstep) const { return (const char*)g.Bt + (size_t)u.e * estride + (size_t)u.pn * tstep; }
};

constexpr int CW_BAR = 4096;
#define XB_TMO      128
#define XB_XCNT(j)  (256  + 64 * (j))
#define XB_XSUB(j)  (1280 + 64 * (j))
#define XB_XGEN(j)  (2304 + 64 * (j))
#define XB_TOP      3328
#define XB_TOPGEN   3392
#define XCD_BAR_WORDS 3456
#define XB_SPIN_CAP (1u << 18)
__device__ __forceinline__ unsigned xb_ld(unsigned* p)              { return __hip_atomic_load(p, __ATOMIC_RELAXED, __HIP_MEMORY_SCOPE_AGENT); }
__device__ __forceinline__ unsigned xb_add(unsigned* p, unsigned v) { return __hip_atomic_fetch_add(p, v, __ATOMIC_RELAXED, __HIP_MEMORY_SCOPE_AGENT); }
__device__ __forceinline__ unsigned xb_xcc_id() { return (unsigned)__builtin_amdgcn_s_getreg((3 << 11) | 20) & 0xFu; }
#define XB_SPIN(cond, bar) do { unsigned _sp = 0; while (cond) { __builtin_amdgcn_s_sleep(1); \
    if ((++_sp & 255u) == 0u) { if (xb_ld(&(bar)[XB_TMO])) break; if (_sp > XB_SPIN_CAP) { atomicAdd(&(bar)[XB_TMO], 1u); break; } } } } while (0)
struct XcdBarrier { unsigned* bar; unsigned x; volatile LAS unsigned* st; };
__device__ __forceinline__ XcdBarrier xcd_barrier_post(unsigned* bar, volatile LAS unsigned* st, int mk_wk) {
    XcdBarrier b; b.bar = bar; b.x = xb_xcc_id(); b.st = st;
    if (MK_TID == 0) (void)xb_add(&bar[XB_XCNT(b.x)], 1u);
    return b;
}
__device__ __forceinline__ void xcd_barrier_complete(unsigned* bar, unsigned x, unsigned& nloc, unsigned& nx) {
    const unsigned G = gridDim.x * gridDim.y * gridDim.z;
    unsigned sum, cnt, mine, sp = 0u;
    for (;;) {
        sum = 0u; cnt = 0u; mine = 0u;
#pragma unroll
        for (unsigned j = 0; j < 16; ++j) { const unsigned c = xb_ld(&bar[XB_XCNT(j)]); sum += c; cnt += (c > 0u) ? 1u : 0u; mine = (j == x) ? c : mine; }
        if (sum == G) break;
        __builtin_amdgcn_s_sleep(1);
        if ((++sp & 255u) == 0u) { if (xb_ld(&bar[XB_TMO])) break; if (sp > XB_SPIN_CAP) { atomicAdd(&bar[XB_TMO], 1u); break; } }
    }
    nloc = mine > 0u ? mine : 1u; nx = cnt > 0u ? cnt : 1u;
}
__device__ __forceinline__ void xcd_barrier(const XcdBarrier& b, int mk_wk) {
    asm volatile("s_waitcnt vmcnt(0)" ::: "memory");
    __syncthreads();
    if (MK_TID == 0) {
        unsigned* bar = b.bar;
        __builtin_amdgcn_s_waitcnt(0);
        unsigned nloc = b.st[0], nx = b.st[1];
        if (nloc == 0u) { xcd_barrier_complete(bar, b.x, nloc, nx); b.st[0] = nloc; b.st[1] = nx; }
        const unsigned old = xb_add(&bar[XB_XSUB(b.x)], 1u);
        const unsigned gen = old / nloc;
        if (old + 1u == (gen + 1u) * nloc) {
            __builtin_amdgcn_fence(__ATOMIC_RELEASE, "agent");
            asm volatile("s_waitcnt vmcnt(0)" ::: "memory");
            const unsigned og = xb_add(&bar[XB_TOP], 1u);
            const unsigned tg = og / nx;
            if (og + 1u == (tg + 1u) * nx) xb_add(&bar[XB_TOPGEN], 1u);
            else XB_SPIN(xb_ld(&bar[XB_TOPGEN]) == tg, bar);
            __builtin_amdgcn_fence(__ATOMIC_ACQUIRE, "agent");
            xb_add(&bar[XB_XGEN(b.x)], 1u);
            asm volatile("s_waitcnt vmcnt(0)" ::: "memory");
        } else {
            XB_SPIN(xb_ld(&bar[XB_XGEN(b.x)]) == gen, bar);
            __builtin_amdgcn_fence(__ATOMIC_ACQUIRE, "agent");
            asm volatile("s_waitcnt vmcnt(0)" ::: "memory");
        }
    }
    __syncthreads();
}

__device__ __forceinline__ void ph_mod(const P& p, LAS unsigned char* lds, int bid, int nblk, int mk_wk) {
    int tidx_ = MK_TID; asm volatile("" : "+v"(tidx_));
    LAS float* sc = (LAS float*)lds;
    LAS float* red = (LAS float*)(lds + 16384);
    const int tid = tidx_;
    for (int i = tid; i < 4096; i += NTHR) sc[i] = siluf_(p.c[i]);
    __syncthreads();
    for (int cb = bid; cb < 256; cb += nblk) {
        const int cq = tid % 6, kr = tid / 6;
        float acc[4][4];
#pragma unroll
        for (int b = 0; b < 4; ++b)
#pragma unroll
            for (int j = 0; j < 4; ++j) acc[b][j] = 0.f;
        if (kr < 85) {
            f32x4 w[13];
#pragma unroll
            for (int i = 0; i < 13; ++i) { const int k = kr + 85 * i; w[i] = (f32x4){0.f, 0.f, 0.f, 0.f}; if (k < 1024) w[i] = *(const f32x4*)(p.w_ada + (size_t)k * 6144 + cb * 24 + cq * 4); }
#pragma unroll
            for (int i = 0; i < 13; ++i) { const int k = kr + 85 * i;
                if (k < 1024) {
#pragma unroll
                    for (int b = 0; b < 4; ++b) { const float s = sc[b * 1024 + k]; acc[b][0] += s * w[i][0]; acc[b][1] += s * w[i][1]; acc[b][2] += s * w[i][2]; acc[b][3] += s * w[i][3]; } } }
        }
#pragma unroll
        for (int b = 0; b < 4; ++b)
#pragma unroll
            for (int j = 0; j < 4; ++j) red[tid * 16 + b * 4 + j] = acc[b][j];
        __syncthreads();
        if (tid < 96) {
            const int b = tid / 24, col = tid % 24, q = col >> 2, j = col & 3; float s = 0.f;
            for (int r = 0; r < 85; ++r) s += red[(r * 6 + q) * 16 + b * 4 + j];
            WSP(float, WS_MOD)[b * 6144 + cb * 24 + col] = s + p.b_ada[cb * 24 + col];
        }
        __syncthreads();
    }
}
struct ConvItem { const float* src; bf16_t* dst; int ldw, k0, n0, N, dK, mode, arg, fp8; };
__device__ __forceinline__ int conv_rowmap(int mode, int arg, int n) {
    if (mode == 1) { if (n < 3072) return n; if (n < 3088) return n + 4608; if (n < 5648) return n - 16; if (n < 5672) return n + 2048; return n - 40; }
    if (mode == 2) { const int h = n >> 10, r = n & 1023; return (r >> 7) * 256 + h * 128 + (r & 127); }
    return n + arg;
}
constexpr int CV_W1 = 32 * 128, CV_W2 = 32 * 64, CV_WIN = 16 * 31, CV_SQ = 16 * 4, CV_C1 = 2 * 2 * 32, CV_C2 = 2 * 4;
constexpr int CV_NITEMS = CV_WIN + 3 * CV_SQ + CV_W1 + CV_W2 + CV_C1 + CV_C2;
constexpr int CV_QN = CV_W1 + CV_W2;
__device__ __forceinline__ ConvItem conv_decode(const P& p, int it) {
    ConvItem c; int r = it; c.mode = 0; c.arg = 0; c.fp8 = 0;
    if (r < CV_W1) { const int e = r >> 7, t = r & 127; c.src = p.moe_w1 + (size_t)e * 1024 * 2048; c.ldw = 2048; c.k0 = (t >> 3) * 64; c.n0 = (t & 7) * 256; c.N = 2048; c.dst = (bf16_t*)(WSP(unsigned char, WS_W1T) + (size_t)e * 2048 * 1024); c.dK = 1024; c.mode = 2; c.fp8 = 1; return c; } r -= CV_W1;
    if (r < CV_W2) { const int e = r >> 6, t = r & 63; c.src = p.moe_w2 + (size_t)e * 1024 * 1024; c.ldw = 1024; c.k0 = (t >> 2) * 64; c.n0 = (t & 3) * 256; c.N = 1024; c.dst = (bf16_t*)(WSP(unsigned char, WS_W2T) + (size_t)e * 1024 * 1024); c.dK = 1024; c.fp8 = 1; return c; } r -= CV_W2;
    if (r < CV_WIN) { c.src = p.w_in; c.ldw = IN_COLS; c.k0 = (r / 31) * 64; c.n0 = (r % 31) * 256; c.N = IN_COLS; c.dst = WSP(bf16_t, WS_WINT); c.dK = 1024; c.mode = 1; return c; } r -= CV_WIN;
    if (r < 3 * CV_SQ) { const int w = r / CV_SQ, t = r % CV_SQ; c.src = w == 0 ? p.proj_gla : (w == 1 ? p.proj_nsa : p.w_out); c.ldw = 1024; c.k0 = (t >> 2) * 64; c.n0 = (t & 3) * 256; c.N = 1024;
        c.dst = WSP(bf16_t, w == 0 ? WS_PGLAT : (w == 1 ? WS_PNSAT : WS_WOUTT)); c.dK = 1024; return c; } r -= 3 * CV_SQ;
    if (r < CV_C1) { const int which = r >> 6, half = (r >> 5) & 1, kt = r & 31;
        c.src = p.cmp_w1 + ((size_t)which * 4096 + half * 2048) * 256; c.ldw = 256; c.k0 = kt * 64; c.n0 = 0; c.N = 256; c.dst = WSP(bf16_t, WS_CW1T) + (size_t)which * 512 * 2048; c.dK = 2048; c.arg = half * 256; return c; } r -= CV_C1;
    { const int which = r >> 2, kt = r & 3; c.src = p.cmp_w2 + (size_t)which * 256 * 128; c.ldw = 128; c.k0 = kt * 64; c.n0 = 0; c.N = 128; c.dst = WSP(bf16_t, WS_CW2T) + (size_t)which * 128 * 256; c.dK = 256; return c; }
}
__device__ __forceinline__ void conv_load(const ConvItem& c, f32x4 (&v)[8], int wid, int lane) {
#pragma unroll
    for (int r = 0; r < 8; ++r) { const int k = 8 * wid + r, n = 4 * lane;
        v[r] = (f32x4){0.f, 0.f, 0.f, 0.f};
        if (c.n0 + n < c.N) v[r] = *(const f32x4*)(c.src + (size_t)(c.k0 + k) * c.ldw + c.n0 + n); }
}
__device__ __forceinline__ void conv_store(const ConvItem& c, const f32x4 (&v)[8], LAS float* T, int tid, int wid, int lane) {
#pragma unroll
    for (int r = 0; r < 8; ++r) *(LAS f32x4*)(T + (8 * wid + r) * 260 + ((4 * lane) ^ (wid << 2))) = v[r];
    __syncthreads();
    const int cc = tid & 7;
#pragma unroll
    for (int pass = 0; pass < 4; ++pass) {
        const int n = (tid >> 3) + 64 * pass;
        if (c.n0 + n < c.N) {
            float f[8];
#pragma unroll
            for (int i = 0; i < 8; ++i) f[i] = T[(8 * cc + i) * 260 + (n ^ (cc << 2))];
            if (c.fp8) { u32x2 w8; w8.x = pk4_fp8(f[0] * 32.f, f[1] * 32.f, f[2] * 32.f, f[3] * 32.f); w8.y = pk4_fp8(f[4] * 32.f, f[5] * 32.f, f[6] * 32.f, f[7] * 32.f);
                *(u32x2*)((unsigned char*)c.dst + (size_t)conv_rowmap(c.mode, c.arg, c.n0 + n) * c.dK + c.k0 + 8 * cc) = w8; }
            else {
            u32x4 w; w.x = cvt_pk_bf16(f[0], f[1]); w.y = cvt_pk_bf16(f[2], f[3]); w.z = cvt_pk_bf16(f[4], f[5]); w.w = cvt_pk_bf16(f[6], f[7]);
            *(u32x4*)(c.dst + (size_t)conv_rowmap(c.mode, c.arg, c.n0 + n) * c.dK + c.k0 + 8 * cc) = w; }
        }
    }
    __syncthreads();
}
__device__ __forceinline__ void ph_convert(const P& p, LAS unsigned char* lds, int bid, int nblk, int mk_wk) {
    int tidx_ = MK_TID; asm volatile("" : "+v"(tidx_));
    const int tid = tidx_, wid = tid >> 6, lane = tid & 63;
    LAS float* T = (LAS float*)lds;
    if (bid == 0) {
        u32x4* z = (u32x4*)(WSP(bf16_t, WS_WINT) + (size_t)IN_COLS * 1024); const int n16 = (PLD - IN_COLS) * 1024 * 2 / 16;
        for (int i = tid; i < n16; i += NTHR) z[i] = (u32x4){0u, 0u, 0u, 0u};
    }
    f32x4 va[8], vb[8];
    int it = CV_QN + bid;
    if (it < CV_NITEMS) conv_load(conv_decode(p, it), va, wid, lane);
    while (it < CV_NITEMS) {
        const int itn = it + nblk;
        if (itn < CV_NITEMS) conv_load(conv_decode(p, itn), vb, wid, lane);
        conv_store(conv_decode(p, it), va, T, tid, wid, lane);
        if (itn >= CV_NITEMS) break;
        const int itn2 = itn + nblk;
        if (itn2 < CV_NITEMS) conv_load(conv_decode(p, itn2), va, wid, lane);
        conv_store(conv_decode(p, itn), vb, T, tid, wid, lane);
        it = itn2;
    }
}
#ifndef CV_QREP
#define CV_QREP 1
#define CVI(x) (x)
#else
#define CVI(x) ((x) % CV_QN)
#endif
constexpr int CV_QL = CV_QN * CV_QREP;
__device__ __forceinline__ void conv_drain(const P& p, LAS unsigned char* lds, volatile LAS unsigned* st, int mk_wk, const int lim) {
    int tidx_ = MK_TID; asm volatile("" : "+v"(tidx_));
    const int tid = tidx_, wid = tid >> 6, lane = tid & 63;
    LAS float* T = (LAS float*)lds;
    int* q = WSP(int, WS_CTL) + CT_CVQ;
    f32x4 va[8], vb[8];
    __syncthreads();
    if (tid == 0) st[2] = (unsigned)atomicAdd(q, 1);
    __syncthreads();
    int cur = (int)st[2];
    if (cur < CV_QL) conv_load(conv_decode(p, CVI(cur)), va, wid, lane);
    while (cur < CV_QL) {
        if (tid == 0) st[3] = (cur >= lim) ? (unsigned)CV_QL : (unsigned)atomicAdd(q, 1);
        __syncthreads();
        const int nxt = (int)st[3];
        if (nxt < CV_QL) conv_load(conv_decode(p, CVI(nxt)), vb, wid, lane);
        conv_store(conv_decode(p, CVI(cur)), va, T, tid, wid, lane);
        if (nxt >= CV_QL) break;
        if (tid == 0) st[2] = (nxt >= lim) ? (unsigned)CV_QL : (unsigned)atomicAdd(q, 1);
        __syncthreads();
        cur = (int)st[2];
        if (cur < CV_QL) conv_load(conv_decode(p, CVI(cur)), va, wid, lane);
        conv_store(conv_decode(p, CVI(nxt)), vb, T, tid, wid, lane);
    }
}
__device__ __forceinline__ void conv_take(const P& p, LAS unsigned char* lds, volatile LAS unsigned* st, int mk_wk, const int nmax) {
    int tidx_ = MK_TID; asm volatile("" : "+v"(tidx_));
    const int tid = tidx_, wid = tid >> 6, lane = tid & 63;
    LAS float* T = (LAS float*)lds;
    int* q = WSP(int, WS_CTL) + CT_CVQ;
    f32x4 va[8], vb[8];
    __syncthreads();
    if (tid == 0) st[2] = (unsigned)atomicAdd(q, 1);
    __syncthreads();
    int cur = (int)st[2], left = nmax - 1;
    if (cur < CV_QL) conv_load(conv_decode(p, CVI(cur)), va, wid, lane);
    while (cur < CV_QL) {
        if (tid == 0) st[3] = (left <= 0) ? (unsigned)CV_QL : (unsigned)atomicAdd(q, 1);
        __syncthreads();
        const int nxt = (int)st[3]; --left;
        if (nxt < CV_QL) conv_load(conv_decode(p, CVI(nxt)), vb, wid, lane);
        conv_store(conv_decode(p, CVI(cur)), va, T, tid, wid, lane);
        if (nxt >= CV_QL) break;
        if (tid == 0) st[2] = (left <= 0) ? (unsigned)CV_QL : (unsigned)atomicAdd(q, 1);
        __syncthreads();
        cur = (int)st[2]; --left;
        if (cur < CV_QL) conv_load(conv_decode(p, CVI(cur)), va, wid, lane);
        conv_store(conv_decode(p, CVI(nxt)), vb, T, tid, wid, lane);
    }
}
__device__ __forceinline__ void xcd_barrier_fill(const XcdBarrier& b, int mk_wk, const P& p, LAS unsigned char* lds) {
    asm volatile("s_waitcnt vmcnt(0)" ::: "memory");
    __syncthreads();
    int tidx_ = MK_TID; asm volatile("" : "+v"(tidx_));
    const int tid = tidx_, wid = tid >> 6, lane = tid & 63;
    int* q = WSP(int, WS_CTL) + CT_CVQ;
    unsigned gen = 0u; bool waiter = false;
    if (tid == 0) {
        unsigned* bar = b.bar;
        __builtin_amdgcn_s_waitcnt(0);
        unsigned nloc = b.st[0], nx = b.st[1];
        if (nloc == 0u) { xcd_barrier_complete(bar, b.x, nloc, nx); b.st[0] = nloc; b.st[1] = nx; }
        const unsigned old = xb_add(&bar[XB_XSUB(b.x)], 1u);
        gen = old / nloc;
        if (old + 1u == (gen + 1u) * nloc) {
            __builtin_amdgcn_fence(__ATOMIC_RELEASE, "agent");
            asm volatile("s_waitcnt vmcnt(0)" ::: "memory");
            const unsigned og = xb_add(&bar[XB_TOP], 1u);
            const unsigned tg = og / nx;
            if (og + 1u == (tg + 1u) * nx) xb_add(&bar[XB_TOPGEN], 1u);
            else XB_SPIN(xb_ld(&bar[XB_TOPGEN]) == tg, bar);
            __builtin_amdgcn_fence(__ATOMIC_ACQUIRE, "agent");
            xb_add(&bar[XB_XGEN(b.x)], 1u);
            asm volatile("s_waitcnt vmcnt(0)" ::: "memory");
            b.st[2] = (unsigned)CV_QL;
        } else {
            waiter = true;
            b.st[2] = (xb_ld(&bar[XB_XGEN(b.x)]) != gen) ? (unsigned)CV_QL : (unsigned)atomicAdd(q, 1);
        }
    }
    __syncthreads();
    int cur = (int)b.st[2];
    if (cur < CV_QL) {
        LAS float* T = (LAS float*)lds;
        f32x4 va[8], vb[8];
        conv_load(conv_decode(p, CVI(cur)), va, wid, lane);
        for (;;) {
            if (tid == 0) b.st[3] = (xb_ld(&b.bar[XB_XGEN(b.x)]) != gen) ? (unsigned)CV_QL : (unsigned)atomicAdd(q, 1);
            __syncthreads();
            const int nxt = (int)b.st[3];
            if (nxt < CV_QL) conv_load(conv_decode(p, CVI(nxt)), vb, wid, lane);
            conv_store(conv_decode(p, CVI(cur)), va, T, tid, wid, lane);
            if (nxt >= CV_QL) break;
            if (tid == 0) b.st[2] = (xb_ld(&b.bar[XB_XGEN(b.x)]) != gen) ? (unsigned)CV_QL : (unsigned)atomicAdd(q, 1);
            __syncthreads();
            cur = (int)b.st[2];
            if (cur < CV_QL) conv_load(conv_decode(p, CVI(cur)), va, wid, lane);
            conv_store(conv_decode(p, CVI(nxt)), vb, T, tid, wid, lane);
            if (cur >= CV_QL) break;
        }
    }
    if (tid == 0 && waiter) {
        XB_SPIN(xb_ld(&b.bar[XB_XGEN(b.x)]) == gen, b.bar);
        __builtin_amdgcn_fence(__ATOMIC_ACQUIRE, "agent");
        asm volatile("s_waitcnt vmcnt(0)" ::: "memory");
    }
    asm volatile("s_waitcnt vmcnt(0)" ::: "memory");
    __syncthreads();
}
__device__ __forceinline__ void ph_u1(const P& p, int bid, int nblk, int mk_wk) {
    int tidx_ = MK_TID; asm volatile("" : "+v"(tidx_));
    const int lane = tidx_ & 63, gw = bid * NWAVES + (tidx_ >> 6), NGW = nblk * NWAVES;
    for (int row = gw; row < NTOK; row += NGW) {
        const f32x4* xr = (const f32x4*)(p.x + (size_t)row * DM) + lane; const float* mod = WSP(float, WS_MOD) + (row / SEQ) * 6144;
        f32x4 v[4]; float ss = 0.f;
#pragma unroll
        for (int j = 0; j < 4; ++j) { v[j] = xr[64 * j]; ss += (v[j][0] * v[j][0] + v[j][1] * v[j][1]) + (v[j][2] * v[j][2] + v[j][3] * v[j][3]); }
        const float rstd = rsqrtf(wave_sum(ss) * (1.f / DM) + RMS_EPS);
        u32x2* o = (u32x2*)(WSP(bf16_t, WS_U1) + (size_t)row * DM) + lane;
#pragma unroll
        for (int j = 0; j < 4; ++j) { const int col = 4 * lane + 256 * j;
            const f32x4 g = *(const f32x4*)(p.norm1_g + col), sc = *(const f32x4*)(mod + 1024 + col), sh = *(const f32x4*)(mod + col);
            float r[4];
#pragma unroll
            for (int i = 0; i < 4; ++i) r[i] = v[j][i] * rstd * g[i] * (1.f + sc[i]) + sh[i];
            u32x2 w; w.x = cvt_pk_bf16(r[0], r[1]); w.y = cvt_pk_bf16(r[2], r[3]); o[64 * j] = w; }
    }
}

__device__ __forceinline__ void ph_ygla_naive(const P& p, int bid, int nblk, int mk_wk) {
    int tidx_ = MK_TID; asm volatile("" : "+v"(tidx_));
    const int lane = tidx_ & 63, gw = bid * NWAVES + (tidx_ >> 6), NGW = nblk * NWAVES;
    const f32x4 gn = *(const f32x4*)(p.gla_norm_g + 4 * lane);
    for (int w0 = gw * 4; w0 < NTOK * 4; w0 += NGW * 4) {
        f32x4 v[4]; u32x2 gr[4];
#pragma unroll
        for (int i = 0; i < 4; ++i) { const int w = w0 + i, row = w >> 2, h = w & 3;
            { const u32x2 ow = *(const u32x2*)(WSP(bf16_t, WS_OGLA) + (size_t)row * DM + h * 256 + 4 * lane); v[i] = (f32x4){bflo(ow.x), bfhi(ow.x), bflo(ow.y), bfhi(ow.y)}; }
            gr[i] = *(const u32x2*)(WSP(bf16_t, WS_PROJ) + (size_t)row * PLD + C_GR + h * 256 + 4 * lane); }
#pragma unroll
        for (int i = 0; i < 4; ++i) { const int w = w0 + i, row = w >> 2, h = w & 3;
            const float ss = (v[i][0] * v[i][0] + v[i][1] * v[i][1]) + (v[i][2] * v[i][2] + v[i][3] * v[i][3]);
            const float rstd = rsqrtf(wave_sum(ss) * (1.f / 256.f) + RMS_EPS);
            const float y0 = v[i][0] * rstd * gn[0] * siluf_(bflo(gr[i].x)), y1 = v[i][1] * rstd * gn[1] * siluf_(bfhi(gr[i].x));
            const float y2 = v[i][2] * rstd * gn[2] * siluf_(bflo(gr[i].y)), y3 = v[i][3] * rstd * gn[3] * siluf_(bfhi(gr[i].y));
            u32x2 o; o.x = cvt_pk_bf16(y0, y1); o.y = cvt_pk_bf16(y2, y3);
            *(u32x2*)(WSP(bf16_t, WS_YGLA) + (size_t)row * DM + h * 256 + 4 * lane) = o; }
    }
}
__device__ __forceinline__ void ph_route(const P& p, LAS unsigned char* lds, int bid, int nblk, int mk_wk, const bool count = true) {
    int tidx_ = MK_TID; asm volatile("" : "+v"(tidx_));
    const int wid = tidx_ >> 6, lane = tidx_ & 63, gw = bid * NWAVES + wid, NGW = nblk * NWAVES;
    LAS float* uu = (LAS float*)lds + wid * 4096;
    for (int row4 = gw * 4; row4 < NTOK; row4 += NGW * 4) {
        const float* mod = WSP(float, WS_MOD) + (row4 / SEQ) * 6144;
        f32x4 vall[4][4];
#pragma unroll
        for (int r = 0; r < 4; ++r)
#pragma unroll
            for (int j = 0; j < 4; ++j) { const u32x2 hw = ((const u32x2*)(WSP(bf16_t, WS_H1) + (size_t)(row4 + r) * DM) + lane)[64 * j]; vall[r][j] = (f32x4){bflo(hw.x), bfhi(hw.x), bflo(hw.y), bfhi(hw.y)}; }
        const int e = lane & 31, kh = lane >> 5;
        const float* rw = p.router_w + (size_t)kh * 512 * 32 + e;
        float wn[16];
#pragma unroll
        for (int i = 0; i < 16; ++i) wn[i] = rw[i * 32];
#pragma unroll
        for (int r = 0; r < 4; ++r) {
            f32x4 v[4]; float ss = 0.f;
#pragma unroll
            for (int j = 0; j < 4; ++j) { v[j] = vall[r][j]; ss += (v[j][0] * v[j][0] + v[j][1] * v[j][1]) + (v[j][2] * v[j][2] + v[j][3] * v[j][3]); }
            const float rstd = rsqrtf(wave_sum(ss) * (1.f / DM) + RMS_EPS);
            unsigned* uo = (unsigned*)(WSP(unsigned char, WS_U2) + (size_t)(row4 + r) * DM) + lane;
#pragma unroll
            for (int j = 0; j < 4; ++j) { const int col = 4 * lane + 256 * j;
                const f32x4 g = *(const f32x4*)(p.norm2_g + col), sc = *(const f32x4*)(mod + 4096 + col), sh = *(const f32x4*)(mod + 3072 + col);
                f32x4 o;
#pragma unroll
                for (int i = 0; i < 4; ++i) o[i] = v[j][i] * rstd * g[i] * (1.f + sc[i]) + sh[i];
                *(LAS f32x4*)(uu + r * 1024 + col) = o;
                uo[64 * j] = pk4_fp8(o[0], o[1], o[2], o[3]); }
        }
        __builtin_amdgcn_wave_barrier();
        float acc[4] = {0.f, 0.f, 0.f, 0.f};
        for (int k = 0; k < 512; k += 16) {
            float wc[16];
#pragma unroll
            for (int i = 0; i < 16; ++i) wc[i] = wn[i];
            if (k + 16 < 512) {
#pragma unroll
                for (int i = 0; i < 16; ++i) wn[i] = rw[(k + 16 + i) * 32];
            }
#pragma unroll
            for (int q = 0; q < 4; ++q)
#pragma unroll
                for (int r = 0; r < 4; ++r) { const f32x4 u = *(const LAS f32x4*)(uu + r * 1024 + kh * 512 + k + 4 * q); acc[r] += (u[0] * wc[4 * q] + u[1] * wc[4 * q + 1]) + (u[2] * wc[4 * q + 2] + u[3] * wc[4 * q + 3]); }
        }
        const float rb = p.router_b[e];
#pragma unroll
        for (int r = 0; r < 4; ++r) {
            const float logit = acc[r] + __shfl_xor(acc[r], 32) + rb;
            int rank = 0;
            for (int j = 0; j < 32; ++j) { const float lj = __shfl(logit, j); rank += (lj > logit) || (lj == logit && j < e); }
            const float mx = wave_max(logit);
            const bool sel = rank < 4;
            const float ex = sel ? __expf(logit - mx) : 0.f;
            float sum = ex; for (int o = 1; o < 32; o <<= 1) sum += __shfl_xor(sum, o);
            if (sel && lane < 32) {
                WSP(int, WS_TOPE)[(row4 + r) * 4 + rank] = e; WSP(float, WS_TOPW)[(row4 + r) * 4 + rank] = ex / sum;
                if (count) atomicAdd(WSP(int, WS_CTL) + CT_CNT + e, 1);
            }
        }
        __builtin_amdgcn_wave_barrier();
    }
}
__device__ __forceinline__ void ph_assign(const P& p, LAS unsigned char* lds, int bid, int nblk, int mk_wk) {
    int tidx_ = MK_TID; asm volatile("" : "+v"(tidx_));
    LAS int* pst = (LAS int*)lds;
    int* ctl = WSP(int, WS_CTL);
    if (tidx_ == 0) {
        int ps = 0;
        for (int e = 0; e < NEXP; ++e) { pst[e] = ps; const int nb = (ctl[CT_CNT + e] + MOEB - 1) / MOEB;
            if (bid == 0) for (int i = 0; i < nb; ++i) ctl[CT_BLKE + ps / MOEB + i] = e;
            ps += nb * MOEB; }
        pst[NEXP] = ps; if (bid == 0) ctl[CT_PTOT] = ps;
    }
    __syncthreads();
    const int wid = tidx_ >> 6, lane = tidx_ & 63, gw = bid * NWAVES + wid, NGW = nblk * NWAVES;
    for (int idx0 = gw * 32; idx0 < NTOK * 4; idx0 += NGW * 32) {
        int pos = 0;
        if (lane < 32) { const int e = WSP(int, WS_TOPE)[idx0 + lane]; pos = pst[e] + atomicAdd(ctl + CT_FILL + e, 1); WSP(int, WS_SLOTOF)[idx0 + lane] = pos; }
        u32x4 v[8];
#pragma unroll
        for (int t = 0; t < 8; ++t) v[t] = ((const u32x4*)(WSP(unsigned char, WS_U2) + (size_t)((idx0 >> 2) + t) * DM))[lane];
#pragma unroll
        for (int j = 0; j < 32; ++j) { const int pj = __shfl(pos, j); ((u32x4*)(WSP(unsigned char, WS_XS) + (size_t)pj * DM))[lane] = v[j >> 2]; }
    }
}
__device__ __forceinline__ void ph_final(const P& p, int bid, int nblk, int mk_wk) {
    int tidx_ = MK_TID; asm volatile("" : "+v"(tidx_));
    const int lane = tidx_ & 63, gw = bid * NWAVES + (tidx_ >> 6), NGW = nblk * NWAVES;
    for (int row = gw; row < NTOK; row += NGW) {
        const float* mod = WSP(float, WS_MOD) + (row / SEQ) * 6144 + 5120;
        const int* so = WSP(int, WS_SLOTOF) + row * 4; const float* tw = WSP(float, WS_TOPW) + row * 4;
        const bf16_t* ys = WSP(bf16_t, WS_YSLOT);
        const int s0 = so[0], s1 = so[1], s2 = so[2], s3 = so[3]; const float w0 = tw[0], w1 = tw[1], w2 = tw[2], w3 = tw[3];
        f32x4 v[4]; u32x2 y[4][4]; float ss = 0.f;
#pragma unroll
        for (int j = 0; j < 4; ++j) { const int col = 4 * lane + 256 * j;
            { const u32x2 hw = *(const u32x2*)(WSP(bf16_t, WS_H1) + (size_t)row * DM + col); v[j] = (f32x4){bflo(hw.x), bfhi(hw.x), bflo(hw.y), bfhi(hw.y)}; }
            y[j][0] = *(const u32x2*)(ys + (size_t)s0 * DM + col); y[j][1] = *(const u32x2*)(ys + (size_t)s1 * DM + col);
            y[j][2] = *(const u32x2*)(ys + (size_t)s2 * DM + col); y[j][3] = *(const u32x2*)(ys + (size_t)s3 * DM + col); }
#pragma unroll
        for (int j = 0; j < 4; ++j) { const int col = 4 * lane + 256 * j; const f32x4 g2 = *(const f32x4*)(mod + col);
            const float m0 = w0 * bflo(y[j][0].x) + w1 * bflo(y[j][1].x) + w2 * bflo(y[j][2].x) + w3 * bflo(y[j][3].x);
            const float m1 = w0 * bfhi(y[j][0].x) + w1 * bfhi(y[j][1].x) + w2 * bfhi(y[j][2].x) + w3 * bfhi(y[j][3].x);
            const float m2 = w0 * bflo(y[j][0].y) + w1 * bflo(y[j][1].y) + w2 * bflo(y[j][2].y) + w3 * bflo(y[j][3].y);
            const float m3 = w0 * bfhi(y[j][0].y) + w1 * bfhi(y[j][1].y) + w2 * bfhi(y[j][2].y) + w3 * bfhi(y[j][3].y);
            v[j][0] += g2[0] * m0; v[j][1] += g2[1] * m1; v[j][2] += g2[2] * m2; v[j][3] += g2[3] * m3;
            ss += (v[j][0] * v[j][0] + v[j][1] * v[j][1]) + (v[j][2] * v[j][2] + v[j][3] * v[j][3]); }
        const float rstd = rsqrtf(wave_sum(ss) * (1.f / DM) + RMS_EPS);
#pragma unroll
        for (int j = 0; j < 4; ++j) { const int col = 4 * lane + 256 * j; const f32x4 fg = *(const f32x4*)(p.final_g + col);
            f32x4 o; o[0] = v[j][0] * rstd * fg[0]; o[1] = v[j][1] * rstd * fg[1]; o[2] = v[j][2] * rstd * fg[2]; o[3] = v[j][3] * rstd * fg[3];
            *(f32x4*)(p.out + (size_t)row * DM + col) = o; }
    }
}

constexpr size_t WS_QE = 735 * MiB;
constexpr size_t WS_KDT = 751 * MiB;
constexpr size_t WS_AM = 767 * MiB;
constexpr size_t WS_DEC = 775 * MiB;
typedef short s16x4 __attribute__((ext_vector_type(4)));
__device__ __forceinline__ s16x4 lds_tr16(LAS const void* ptr) { return __builtin_bit_cast(s16x4, __builtin_amdgcn_ds_read_tr16_b64_v4i16((LAS s16x4*)ptr)); }
__device__ __forceinline__ bf16x8 cat8(s16x4 a, s16x4 b) { return (bf16x8){a[0], a[1], a[2], a[3], b[0], b[1], b[2], b[3]}; }

__device__ __forceinline__ void ph_gla_g1(const P& p, LAS unsigned char* lds, int bid, int nblk, int mk_wk) {
    int tidx_ = MK_TID; asm volatile("" : "+v"(tidx_));
    const int tid = tidx_, wid = tid >> 6, lane = tid & 63, fr = lane & 15, fq = lane >> 4;
    LAS float* gaL = (LAS float*)lds;
    LAS float* segL = (LAS float*)(lds + 4096);
    LAS bf16_t* qeL = (LAS bf16_t*)(lds + 8192);
    LAS bf16_t* keL = (LAS bf16_t*)(lds + 8192 + 17408);
    const bf16_t* proj = WSP(bf16_t, WS_PROJ);
    const int n_my = (nblk == 256) ? (bid < 128 ? 3 : 5) : ((1024 - bid + nblk - 1) / nblk);
    for (int ii = 0; ii < n_my; ++ii) {
        const int item = (nblk == 256) ? (bid < 128 ? bid * 3 + ii : 384 + (bid - 128) * 5 + ii) : (bid + ii * nblk);
        const int b = item >> 8, h = (item >> 6) & 3, n = item & 63;
        const size_t r0 = (size_t)b * SEQ + n * 64;
        if (tid < 128) { const int tok = tid >> 1, half = tid & 1;
            const u32x4 v = *(const u32x4*)(proj + (r0 + tok) * PLD + C_GA + half * 8);
            LAS float* d = gaL + tok * 16 + half * 8;
            d[0] = bflo(v.x); d[1] = bfhi(v.x); d[2] = bflo(v.y); d[3] = bfhi(v.y); d[4] = bflo(v.z); d[5] = bfhi(v.z); d[6] = bflo(v.w); d[7] = bfhi(v.w); }
        const int d = tid & 127, seg = tid >> 7;
        bf16_t qraw[16], kraw[16];
#pragma unroll
        for (int i = 0; i < 16; ++i) { const bf16_t* pr = proj + (r0 + seg * 16 + i) * PLD + h * 128 + d; qraw[i] = pr[C_GQ]; kraw[i] = pr[C_GK]; }
        __syncthreads();
        float w[16];
#pragma unroll
        for (int r = 0; r < 16; ++r) w[r] = p.gla_wa2[r * 512 + h * 128 + d];
        const float ba = p.gla_ba[h * 128 + d];
        float bc[16]; float run = 0.f;
#pragma unroll
        for (int i = 0; i < 16; ++i) {
            const LAS float* g = gaL + (seg * 16 + i) * 16; float xx = ba;
#pragma unroll
            for (int r = 0; r < 16; ++r) xx += g[r] * w[r];
            const float ls = fminf(xx, 0.f) - __logf(1.f + __expf(-fabsf(xx)));
            run += ls * (1.f / 16.f); bc[i] = run;
        }
        segL[seg * 128 + d] = run;
        __syncthreads();
        float off = 0.f, blast = 0.f;
#pragma unroll
        for (int s = 0; s < 4; ++s) { const float v = segL[s * 128 + d]; blast += v; if (s < seg) off += v; }
        bf16_t* QE = WSP(bf16_t, WS_QE) + (size_t)item * 8192; bf16_t* KDT = WSP(bf16_t, WS_KDT) + (size_t)item * 8192;
        float kd[16];
#pragma unroll
        for (int i = 0; i < 16; ++i) {
            const int tok = seg * 16 + i; const float bcv = bc[i] + off;
            const float q = bf2f(qraw[i]), k = bf2f(kraw[i]);
            const float e = __expf(bcv);
            const bf16_t qe = f2bf(q * 0.08838834764831845f * e), ke = f2bf(k * __expf(-bcv));
            kd[i] = k * __expf(blast - bcv);
            qeL[tok * 136 + d] = qe; keL[tok * 136 + d] = ke; QE[tok * 128 + d] = qe;
        }
        { u32x4 w0, w1; w0.x = cvt_pk_bf16(kd[0], kd[1]); w0.y = cvt_pk_bf16(kd[2], kd[3]); w0.z = cvt_pk_bf16(kd[4], kd[5]); w0.w = cvt_pk_bf16(kd[6], kd[7]);
          w1.x = cvt_pk_bf16(kd[8], kd[9]); w1.y = cvt_pk_bf16(kd[10], kd[11]); w1.z = cvt_pk_bf16(kd[12], kd[13]); w1.w = cvt_pk_bf16(kd[14], kd[15]);
          u32x4* dst = (u32x4*)(KDT + d * 64 + seg * 16); dst[0] = w0; dst[1] = w1; }
        if (seg == 0) WSP(float, WS_DEC)[(size_t)item * 128 + d] = __expf(blast);
        __syncthreads();
        bf16_t* AM = WSP(bf16_t, WS_AM) + (size_t)item * 4096;
#pragma unroll
        for (int tt = 0; tt < 2; ++tt) {
            const int id = wid * 2 + tt, ti = id >> 2, tj = id & 3;
            f32x4 acc = (f32x4){0.f, 0.f, 0.f, 0.f};
            if (tj <= ti) {
#pragma unroll
                for (int s = 0; s < 4; ++s) {
                    const bf16x8 af = *(const LAS bf16x8*)(qeL + (16 * ti + fr) * 136 + 32 * s + 8 * fq);
                    const bf16x8 bf = *(const LAS bf16x8*)(keL + (16 * tj + fr) * 136 + 32 * s + 8 * fq);
                    acc = __builtin_amdgcn_mfma_f32_16x16x32_bf16(af, bf, acc, 0, 0, 0);
                }
            }
            const int j = 16 * tj + fr;
#pragma unroll
            for (int r = 0; r < 4; ++r) { const int i = 16 * ti + 4 * fq + r; AM[i * 64 + j] = f2bf(j <= i ? acc[r] : 0.f); }
        }
        __syncthreads();
    }
}

struct G2Ops { bf16x8 kdt[2], am[2], qe[4]; f32x4 dec; u32x4 v; };
__device__ __forceinline__ void g2_load(G2Ops& op, const P& p, int item, size_t vrow0, int vcol, int wid, int fr, int fq, int tid) {
    const bf16_t* KDT = WSP(bf16_t, WS_KDT) + (size_t)item * 8192; const bf16_t* AMp = WSP(bf16_t, WS_AM) + (size_t)item * 4096; const bf16_t* QE = WSP(bf16_t, WS_QE) + (size_t)item * 8192;
#pragma unroll
    for (int s = 0; s < 2; ++s) op.kdt[s] = *(const bf16x8*)(KDT + (16 * wid + fr) * 64 + 32 * s + 8 * fq);
    if (wid < 4) {
#pragma unroll
        for (int s = 0; s < 2; ++s) op.am[s] = *(const bf16x8*)(AMp + (16 * wid + fr) * 64 + 32 * s + 8 * fq);
#pragma unroll
        for (int s = 0; s < 4; ++s) op.qe[s] = *(const bf16x8*)(QE + (16 * wid + fr) * 128 + 32 * s + 8 * fq);
    }
    op.dec = *(const f32x4*)(WSP(float, WS_DEC) + (size_t)item * 128 + 16 * wid + 4 * fq);
    if (tid < 128) op.v = *(const u32x4*)(WSP(bf16_t, WS_PROJ) + (vrow0 + (tid >> 1)) * PLD + vcol + (tid & 1) * 8);
}
#define G2_BAR() do { asm volatile("s_waitcnt lgkmcnt(0)" ::: "memory"); __builtin_amdgcn_s_barrier(); asm volatile("" ::: "memory"); } while (0)
__device__ __forceinline__ void g2_step(const G2Ops& op, f32x4& S, LAS bf16_t* Vb, LAS const bf16_t* ST  , LAS bf16_t* STn  , bf16_t* og, int wid, int lane, int fr, int fq, int tid) {
    if (tid < 128) *(LAS u32x4*)(Vb + (tid >> 1) * 16 + (tid & 1) * 8) = op.v;
    G2_BAR();
    bf16x8 vb[2];
#pragma unroll
    for (int ks = 0; ks < 2; ++ks) {
        const int q = (lane & 15) >> 2, pp = lane & 3;
        const s16x4 lo = lds_tr16(Vb + (32 * ks + 8 * fq + q) * 16 + 4 * pp);
        const s16x4 hi = lds_tr16(Vb + (32 * ks + 8 * fq + 4 + q) * 16 + 4 * pp);
        vb[ks] = cat8(lo, hi);
    }
    f32x4 cs = (f32x4){0.f, 0.f, 0.f, 0.f};
    cs = __builtin_amdgcn_mfma_f32_16x16x32_bf16(op.kdt[0], vb[0], cs, 0, 0, 0);
    cs = __builtin_amdgcn_mfma_f32_16x16x32_bf16(op.kdt[1], vb[1], cs, 0, 0, 0);
    if (wid < 4) {
        f32x4 o = (f32x4){0.f, 0.f, 0.f, 0.f};
        o = __builtin_amdgcn_mfma_f32_16x16x32_bf16(op.am[0], vb[0], o, 0, 0, 0);
        o = __builtin_amdgcn_mfma_f32_16x16x32_bf16(op.am[1], vb[1], o, 0, 0, 0);
#pragma unroll
        for (int s = 0; s < 4; ++s) { const bf16x8 sb = *(const LAS bf16x8*)(ST + fr * 136 + 32 * s + 8 * fq); o = __builtin_amdgcn_mfma_f32_16x16x32_bf16(op.qe[s], sb, o, 0, 0, 0); }
#pragma unroll
        for (int r = 0; r < 4; ++r) og[(size_t)r * DM] = f2bf(o[r]);
    }
    S = op.dec * S + cs;
    { u32x2 w; w.x = cvt_pk_bf16(S[0], S[1]); w.y = cvt_pk_bf16(S[2], S[3]); *(LAS u32x2*)(STn + fr * 136 + 16 * wid + 4 * fq) = w; }
}
__device__ __forceinline__ void ph_gla_g2(const P& p, LAS unsigned char* lds, int bid, int nblk, int mk_wk) {
    int tidx_ = MK_TID; asm volatile("" : "+v"(tidx_));
    const int tid = tidx_, wid = __builtin_amdgcn_readfirstlane(tid >> 6), lane = tid & 63, fr = lane & 15, fq = lane >> 4;
    LAS bf16_t* VL = (LAS bf16_t*)lds;
    LAS bf16_t* ST = (LAS bf16_t*)(lds + 4096);
    for (int it = bid; it < 256; it += nblk) {
        const int bh = (it & 7) + 8 * ((it >> 3) & 1), slice = it >> 4, b = bh >> 2, h = bh & 3;
        for (int i = tid; i < 16 * 136 / 2; i += NTHR) ((LAS unsigned*)ST)[i] = 0u;
        f32x4 S = (f32x4){0.f, 0.f, 0.f, 0.f};
        const int item0 = (b * 4 + h) * 64;
        const size_t r0 = (size_t)b * SEQ;
        const int vcol = C_GV + h * 256 + slice * 16;
        bf16_t* og0 = WSP(bf16_t, WS_OGLA) + (r0 + 16 * wid + 4 * fq) * DM + h * 256 + slice * 16 + fr;
        G2Ops opA = {}, opB = {}, opC = {}, opD = {};
        g2_load(opA, p, item0, r0, vcol, wid, fr, fq, tid);
        g2_load(opB, p, item0 + 1, r0 + 64, vcol, wid, fr, fq, tid);
        g2_load(opC, p, item0 + 2, r0 + 128, vcol, wid, fr, fq, tid);
        g2_load(opD, p, item0 + 3, r0 + 192, vcol, wid, fr, fq, tid);
#pragma unroll 1
        for (int n = 0; n < 64; n += 4) {
            const int n4 = n + 4 < 64 ? n + 4 : 60;
            g2_step(opA, S, VL, ST, ST + 16 * 136, og0 + (size_t)n * 64 * DM, wid, lane, fr, fq, tid);
            g2_load(opA, p, item0 + n4, r0 + (size_t)n4 * 64, vcol, wid, fr, fq, tid);
            g2_step(opB, S, VL + 1024, ST + 16 * 136, ST, og0 + (size_t)(n + 1) * 64 * DM, wid, lane, fr, fq, tid);
            g2_load(opB, p, item0 + n4 + 1, r0 + (size_t)(n4 + 1) * 64, vcol, wid, fr, fq, tid);
            g2_step(opC, S, VL, ST, ST + 16 * 136, og0 + (size_t)(n + 2) * 64 * DM, wid, lane, fr, fq, tid);
            g2_load(opC, p, item0 + n4 + 2, r0 + (size_t)(n4 + 2) * 64, vcol, wid, fr, fq, tid);
            g2_step(opD, S, VL + 1024, ST + 16 * 136, ST, og0 + (size_t)(n + 3) * 64 * DM, wid, lane, fr, fq, tid);
            g2_load(opD, p, item0 + n4 + 3, r0 + (size_t)(n4 + 3) * 64, vcol, wid, fr, fq, tid);
        }
        __syncthreads();
    }
}
constexpr size_t WS_KCB = 864 * MiB;
constexpr size_t WS_SLAB = 824 * MiB;
constexpr size_t WS_CB1 = 856 * MiB;
struct CmpOrder {
    int G, c;
    __device__ __forceinline__ bool next(int i, pg8::Unit& u) const { const int L = i * G + c; if (L >= 128) return false; u.pm = (L >> 1) & 7; u.pn = L & 1; u.e = L >> 4; return true; }
    __device__ __forceinline__ void a_ready(const pg8::Unit&) const {}
    __device__ __forceinline__ void done(const pg8::Unit&) const {}
    __device__ __forceinline__ const char* abase(const pg8::Gemm& g, const pg8::Unit& u, size_t tstep) const { return (const char*)g.A + (size_t)(u.e >> 2) * 2048 * 2048 * 2 + (size_t)u.pm * tstep + (size_t)(u.e & 3) * 1024; }
    __device__ __forceinline__ const char* bbase(const pg8::Gemm& g, const pg8::Unit& u, size_t tstep) const { return (const char*)g.Bt + (size_t)(u.e >> 2) * 512 * 2048 * 2 + (size_t)u.pn * tstep + (size_t)(u.e & 3) * 1024; }
};
struct EpiSlab {
    static constexpr bool PERM = false, AFTER_DRAIN = false;
    float* slab;
    __device__ __forceinline__ void operator()(const pg8::f32x4 (&acc)[2][2][4][2], const pg8::Unit& u, int wr, int wc, int fr, int fq) const {
        const int row0 = u.pm * 256 + wr * 64 + fr, col0 = u.pn * 256 + wc * 32 + 4 * fq;
        float* base = slab + ((size_t)(u.e & 3) * 2 + (u.e >> 2)) * 2048 * 512;
#pragma unroll
        for (int ai = 0; ai < 2; ++ai)
#pragma unroll
            for (int m = 0; m < 4; ++m)
#pragma unroll
                for (int bj = 0; bj < 2; ++bj)
#pragma unroll
                    for (int n = 0; n < 2; ++n) *(pg8::f32x4*)(base + (size_t)(row0 + ai * 128 + m * 16) * 512 + col0 + bj * 128 + n * 16) = acc[ai][bj][m][n];
    }
};
constexpr size_t WS_CB1P = 857 * MiB;
__device__ __forceinline__ void ph_cmp_bias(const P& p, int bid, int nblk, int mk_wk) {
    int tidx_ = MK_TID; asm volatile("" : "+v"(tidx_));
    const int lane = tidx_ & 63, wv = tidx_ >> 6;
    for (int it = bid + nblk * wv; it < 512; it += nblk * NWAVES) {
        const int ks = it >> 3, which = (it >> 2) & 1, ng = it & 3, n = ng * 64 + lane;
        const float* pe = p.cmp_pe + which * 4096 + ks * 64; const float* w1 = p.cmp_w1 + ((size_t)which * 4096 + ks * 64) * 256 + n;
        float a0 = 0.f, a1 = 0.f, a2 = 0.f, a3 = 0.f;
#pragma unroll
        for (int k0 = 0; k0 < 64; k0 += 32) {
            float wv_[32];
#pragma unroll
            for (int k = 0; k < 32; ++k) wv_[k] = w1[(size_t)(k0 + k) * 256];
#pragma unroll
            for (int k = 0; k < 32; k += 4) { a0 += pe[k0 + k] * wv_[k]; a1 += pe[k0 + k + 1] * wv_[k + 1]; a2 += pe[k0 + k + 2] * wv_[k + 2]; a3 += pe[k0 + k + 3] * wv_[k + 3]; }
        }
        WSP(float, WS_CB1P)[ks * 512 + which * 256 + n] = (a0 + a1) + (a2 + a3);
    }
}
__device__ __forceinline__ void ph_cmp_bias2(const P& p, int bid, int mk_wk) {
    if (bid != 0) return;
    const int t = MK_TID;
    float s = 0.f;
    for (int ks = 0; ks < 64; ++ks) s += WSP(float, WS_CB1P)[ks * 512 + t];
    WSP(float, WS_CB1)[t] = s;
}
__device__ __forceinline__ void ph_cmp_fin(const P& p, LAS unsigned char* lds, int bid, int nblk, int mk_wk) {
    int tidx_ = MK_TID; asm volatile("" : "+v"(tidx_));
    const int tid = tidx_, wid = __builtin_amdgcn_readfirstlane(tid >> 6), lane = tid & 63, fr = lane & 15, fq = lane >> 4;
    LAS bf16_t* hidL = (LAS bf16_t*)lds;
    for (int it = bid; it < 256; it += nblk) {
        const int which = it >> 7, bg = (it >> 4) & 7, cb = it & 15;
        const float* slab = WSP(float, WS_SLAB);
        const int n = tid & 255;
        float bias1 = 0.f;
#pragma unroll 16
        for (int ks = 0; ks < 64; ++ks) bias1 += WSP(float, WS_CB1P)[ks * 512 + which * 256 + n];
#pragma unroll
        for (int i = 0; i < 8; ++i) {
            const int r = (tid >> 8) + 2 * i, c = cb * 16 + r;
            const size_t rowA = (size_t)bg * 256 + c, rowB = c < 255 ? rowA + 1 : rowA;
            float v = bias1;
#pragma unroll
            for (int s = 0; s < 4; ++s) { const float* sl = slab + ((size_t)s * 2 + which) * 2048 * 512; v += sl[rowA * 512 + n] + sl[rowB * 512 + 256 + n]; }
            hidL[r * 264 + n] = f2bf(gelu_tanh(v));
        }
        __syncthreads();
        const bf16_t* w2t = WSP(bf16_t, WS_CW2T) + (size_t)which * 128 * 256 + (size_t)(16 * wid + fr) * 256 + 8 * fq;
        f32x4 acc = (f32x4){0.f, 0.f, 0.f, 0.f};
#pragma unroll
        for (int s = 0; s < 8; ++s) {
            const bf16x8 bf = *(const bf16x8*)(w2t + 32 * s);
            const bf16x8 af = *(const LAS bf16x8*)(hidL + fr * 264 + 32 * s + 8 * fq);
            acc = __builtin_amdgcn_mfma_f32_16x16x32_bf16(af, bf, acc, 0, 0, 0);
        }
        bf16_t* out = WSP(bf16_t, WS_KCVC) + (((size_t)which * 8 + bg) * 256) * 128 + 16 * wid + fr;
#pragma unroll
        for (int r = 0; r < 4; ++r) { const int c = cb * 16 + 4 * fq + r; out[(size_t)c * 128] = c < 255 ? f2bf(acc[r]) : (bf16_t)0; }
        __syncthreads();
    }
}
#ifndef REP_SEL
#define REP_SEL 1
#endif
constexpr size_t WS_NSCR = 776 * MiB;
typedef float f32x16 __attribute__((ext_vector_type(16)));
constexpr int NSA_KV0 = 0, NSA_IMP = 131072, NSA_MASK = 147456, NSA_UNI = 147968, NSA_WSF = 148480;
constexpr float NSA_NEG = -1e30f;
__device__ __forceinline__ unsigned offb(unsigned row, unsigned ch) { return 2048u * (row >> 3) + 512u * (ch >> 2) + 64u * (row & 7u) + 16u * ((ch & 3u) ^ ((row >> 2) & 3u)); }
__device__ __forceinline__ int crow16(int r, int hi) { return (r & 3) + 8 * (r >> 2) + 4 * hi; }
struct TileRegs { u32x4 k[2], v[2]; };
template <bool LOADV>
__device__ __forceinline__ void nsa_tile_load(TileRegs& R, const bf16_t* kb, const bf16_t* vb, size_t pitch) {
    unsigned tx = threadIdx.x; asm volatile("" : "+v"(tx));
#pragma unroll
    for (int i = 0; i < 2; ++i) { const int c = tx + NTHR * i, row = c >> 4, ch = c & 15;
        R.k[i] = *(const u32x4*)(kb + (size_t)row * pitch + ch * 8);
        if (LOADV) R.v[i] = *(const u32x4*)(vb + (size_t)row * pitch + ch * 8); }
}
template <bool LOADV>
__device__ __forceinline__ void nsa_tile_store(const TileRegs& R, LAS unsigned char* buf) {
#pragma unroll
    for (int i = 0; i < 2; ++i) { const int c = threadIdx.x + NTHR * i, row = c >> 4, ch = c & 15;
        *(LAS u32x4*)(buf + offb(row, ch)) = R.k[i];
        if (LOADV) *(LAS u32x4*)(buf + 16384 + offb(row, ch)) = R.v[i]; }
}
template <bool LOADV>
__device__ __forceinline__ void nsa_tile_glds(LAS unsigned char* buf, const bf16_t* kb, const bf16_t* vb, size_t pitch, int wid, int mk_wk) {
    unsigned ln = MK_TID & 63u; asm volatile("" : "+v"(ln));
#pragma unroll
    for (int i = 0; i < 2; ++i) {
        const unsigned X = (unsigned)(wid * 1024 + i * 8192) + ln * 16u;
        const unsigned row = ((X >> 11) << 3) | ((X >> 6) & 7u), ch = (((X >> 9) & 3u) << 2) | (((X >> 4) & 3u) ^ ((row >> 2) & 3u));
        __builtin_amdgcn_global_load_lds((const unsigned*)(kb + (size_t)row * pitch + ch * 8), (LAS unsigned*)(buf + wid * 1024 + i * 8192), 16, 0, 0);
        if (LOADV) __builtin_amdgcn_global_load_lds((const unsigned*)(vb + (size_t)row * pitch + ch * 8), (LAS unsigned*)(buf + 16384 + wid * 1024 + i * 8192), 16, 0, 0);
    }
}
#define NSA_SYNC() do { asm volatile("s_waitcnt vmcnt(0)" ::: "memory"); __syncthreads(); } while (0)
#define NSA_RING_WAIT(more, NL) do { if (more) { if ((NL) == 4) asm volatile("s_waitcnt vmcnt(4)" ::: "memory"); else asm volatile("s_waitcnt vmcnt(2)" ::: "memory"); } \
    else asm volatile("s_waitcnt vmcnt(0)" ::: "memory"); asm volatile("s_waitcnt lgkmcnt(0)" ::: "memory"); __builtin_amdgcn_s_barrier(); asm volatile("" ::: "memory"); } while (0)
#define NSA_BUF(i) (lds + NSA_KV0 + ((i) & 3) * 32768)
struct NsaCtx {
    int lane, q32, hi, tl6, tb, ncv; LAS const unsigned* maskw; float invl;
    LAS float* wsf; LAS float* impW;
    int probe; unsigned kb0, vb0;
};
#define NSA_LWAIT(N) do { asm volatile("s_waitcnt lgkmcnt(" #N ")" ::: "memory"); __builtin_amdgcn_sched_barrier(0); } while (0)
template <int MODE>
__device__ __forceinline__ void nsa_tile(LAS const unsigned char* Kt, const bf16x8 (&qr)[8], f32x16 (&o)[4], float& m, float& lp, const NsaCtx& cx, int j  , const bool premask  ) {
    const int q32 = cx.q32, hi = cx.hi;
    f32x16 p0, p1;
#pragma unroll
    for (int r = 0; r < 16; ++r) { p0[r] = 0.f; p1[r] = 0.f; }
    {
        const unsigned ka0 = (unsigned)(size_t)Kt + cx.kb0, ka1 = (unsigned)(size_t)Kt + (cx.kb0 ^ 32u);
#define NSA_KRD(dst, addr, off) asm volatile("ds_read_b128 %0, %1 offset:%c2" : "=&v"(dst) : "v"(addr), "i"(off) : "memory")
        bf16x8 ka[2][2], kb[2][2];
        NSA_KRD(ka[0][0], ka0, 0); NSA_KRD(ka[0][1], ka0, 8192); NSA_KRD(ka[1][0], ka1, 0); NSA_KRD(ka[1][1], ka1, 8192);
        NSA_KRD(kb[0][0], ka0, 512); NSA_KRD(kb[0][1], ka0, 8704); NSA_KRD(kb[1][0], ka1, 512); NSA_KRD(kb[1][1], ka1, 8704);
        NSA_LWAIT(4);
#pragma unroll
        for (int s = 0; s < 2; ++s) { p0 = __builtin_amdgcn_mfma_f32_32x32x16_bf16(ka[s][0], qr[s], p0, 0, 0, 0); p1 = __builtin_amdgcn_mfma_f32_32x32x16_bf16(ka[s][1], qr[s], p1, 0, 0, 0); }
        __builtin_amdgcn_sched_barrier(0);
        NSA_KRD(ka[0][0], ka0, 1024); NSA_KRD(ka[0][1], ka0, 9216); NSA_KRD(ka[1][0], ka1, 1024); NSA_KRD(ka[1][1], ka1, 9216);
        NSA_LWAIT(4);
#pragma unroll
        for (int s = 0; s < 2; ++s) { p0 = __builtin_amdgcn_mfma_f32_32x32x16_bf16(kb[s][0], qr[2 + s], p0, 0, 0, 0); p1 = __builtin_amdgcn_mfma_f32_32x32x16_bf16(kb[s][1], qr[2 + s], p1, 0, 0, 0); }
        __builtin_amdgcn_sched_barrier(0);
        NSA_KRD(kb[0][0], ka0, 1536); NSA_KRD(kb[0][1], ka0, 9728); NSA_KRD(kb[1][0], ka1, 1536); NSA_KRD(kb[1][1], ka1, 9728);
        NSA_LWAIT(4);
#pragma unroll
        for (int s = 0; s < 2; ++s) { p0 = __builtin_amdgcn_mfma_f32_32x32x16_bf16(ka[s][0], qr[4 + s], p0, 0, 0, 0); p1 = __builtin_amdgcn_mfma_f32_32x32x16_bf16(ka[s][1], qr[4 + s], p1, 0, 0, 0); }
        NSA_LWAIT(0);
#pragma unroll
        for (int s = 0; s < 2; ++s) { p0 = __builtin_amdgcn_mfma_f32_32x32x16_bf16(kb[s][0], qr[6 + s], p0, 0, 0, 0); p1 = __builtin_amdgcn_mfma_f32_32x32x16_bf16(kb[s][1], qr[6 + s], p1, 0, 0, 0); }
#undef NSA_KRD
    }
    const float SC = 0.08838834764831845f * 1.4426950408889634f;
    if (MODE <= 1 || premask) {
#pragma unroll
        for (int r = 0; r < 16; ++r) {
            const int kk0 = crow16(r, hi), kk1 = kk0 + 32;
            bool v0, v1;
            if (MODE <= 1) { v0 = (64 * j + kk0) < cx.ncv; v1 = (64 * j + kk1) < cx.ncv; }
            else if (MODE == 2) { v0 = (j < cx.tb || kk0 <= cx.tl6); v1 = (j < cx.tb || kk1 <= cx.tl6); }
            else { v0 = (j != cx.tb || kk0 <= cx.tl6) && (j != cx.tb - 8 || kk0 > cx.tl6); v1 = (j != cx.tb || kk1 <= cx.tl6) && (j != cx.tb - 8 || kk1 > cx.tl6); }
            p0[r] = v0 ? p0[r] : -INFINITY; p1[r] = v1 ? p1[r] : -INFINITY;
        }
    }
    if (MODE != 1) {
        const bool rowvalid = (MODE == 2) ? (((cx.maskw[(j >> 5)] >> (j & 31)) & 1u) != 0u) : true;
        float ta = __builtin_fmaxf(__builtin_fmaxf(p0[0], p0[1]), p1[0]), tb_ = __builtin_fmaxf(__builtin_fmaxf(p0[2], p0[3]), p1[1]);
        ta = __builtin_fmaxf(__builtin_fmaxf(ta, p1[2]), p1[3]);
#pragma unroll
        for (int r = 4; r < 16; r += 4) { ta = __builtin_fmaxf(__builtin_fmaxf(ta, p0[r]), p0[r + 1]); tb_ = __builtin_fmaxf(__builtin_fmaxf(tb_, p0[r + 2]), p0[r + 3]);
            ta = __builtin_fmaxf(__builtin_fmaxf(ta, p1[r]), p1[r + 1]); tb_ = __builtin_fmaxf(__builtin_fmaxf(tb_, p1[r + 2]), p1[r + 3]); }
        float tmax = __builtin_fmaxf(ta, tb_);
        tmax = __builtin_fmaxf(tmax, __shfl_xor(tmax, 32));
        const float m_cand = rowvalid ? __builtin_fmaxf(m, tmax * SC) : m;
        const float m_new = (m_cand > m + 8.f) ? m_cand : m;
        const float alpha = __builtin_amdgcn_exp2f(m - m_new);
        m = m_new;
        const float nb = rowvalid ? -m_new : -INFINITY;
        float ps0 = 0.f, ps1 = 0.f;
#pragma unroll
        for (int r = 0; r < 16; ++r) { p0[r] = __builtin_amdgcn_exp2f(__builtin_fmaf(p0[r], SC, nb)); p1[r] = __builtin_amdgcn_exp2f(__builtin_fmaf(p1[r], SC, nb)); ps0 += p0[r]; ps1 += p1[r]; }
        lp = lp * alpha + (ps0 + ps1);
        if (MODE != 0) {
            if (__any(alpha != 1.f)) {
                if (hi == 0) cx.wsf[q32] = alpha;
                __builtin_amdgcn_wave_barrier();
#pragma unroll
                for (int r = 0; r < 16; ++r) { const float a = cx.wsf[crow16(r, hi)];
#pragma unroll
                    for (int c = 0; c < 4; ++c) o[c][r] *= a; }
                __builtin_amdgcn_wave_barrier();
            }
        }
    } else {
        const float nb = -m;
#pragma unroll
        for (int r = 0; r < 16; ++r) { p0[r] = __builtin_amdgcn_exp2f(__builtin_fmaf(p0[r], SC, nb)) * cx.invl; p1[r] = __builtin_amdgcn_exp2f(__builtin_fmaf(p1[r], SC, nb)) * cx.invl; }
#pragma unroll
        for (int kb2 = 0; kb2 < 2; ++kb2)
#pragma unroll
            for (int gq = 0; gq < 4; ++gq) {
                float s4, e1;
                if (kb2 == 0) { e1 = p0[4 * gq + 3]; s4 = (p0[4 * gq] + p0[4 * gq + 1]) + (p0[4 * gq + 2] + e1); }
                else { e1 = p1[4 * gq + 3]; s4 = (p1[4 * gq] + p1[4 * gq + 1]) + (p1[4 * gq + 2] + e1); }
                s4 += __shfl_xor(s4, 1); s4 += __shfl_xor(s4, 2); e1 += __shfl_xor(e1, 1); e1 += __shfl_xor(e1, 2);
                const int sblk = (64 * j + 32 * kb2 + 8 * gq + 4 * hi) >> 2;
                LAS float* impRow = cx.impW + (q32 >> 2) * 64;
                if ((q32 & 3) == 0) { __hip_atomic_fetch_add(impRow + sblk, s4, __ATOMIC_RELAXED, __HIP_MEMORY_SCOPE_WORKGROUP); if (sblk + 1 < 64) __hip_atomic_fetch_add(impRow + sblk + 1, e1, __ATOMIC_RELAXED, __HIP_MEMORY_SCOPE_WORKGROUP); }
            }
    }
    if (MODE != 0) {
        LAS const unsigned char* Vt = Kt + 16384;
        const unsigned va0 = (unsigned)(size_t)Vt + cx.vb0, va1 = (unsigned)(size_t)Vt + (cx.vb0 ^ 32u);
#define NSA_TRR(dst, addr, off) asm volatile("ds_read_b64_tr_b16 %0, %1 offset:%c2" : "=&v"(dst) : "v"(addr), "i"(off) : "memory")
#define NSA_VREADS(L, H, ks) do { NSA_TRR(L[0], va0, 4096 * (ks)); NSA_TRR(H[0], va1, 4096 * (ks) + 2048); NSA_TRR(L[1], va0, 4096 * (ks) + 512); NSA_TRR(H[1], va1, 4096 * (ks) + 2560); \
        NSA_TRR(L[2], va0, 4096 * (ks) + 1024); NSA_TRR(H[2], va1, 4096 * (ks) + 3072); NSA_TRR(L[3], va0, 4096 * (ks) + 1536); NSA_TRR(H[3], va1, 4096 * (ks) + 3584); } while (0)
#define NSA_PVMMA(L, H, ks) do { _Pragma("unroll") for (int c = 0; c < 4; ++c) o[c] = __builtin_amdgcn_mfma_f32_32x32x16_bf16(__builtin_bit_cast(bf16x8, pw[ks]), cat8(L[c], H[c]), o[c], 0, 0, 0); } while (0)
        s16x4 la[4], ha[4], lb[4], hb[4];
        u32x4 pw[4];
        pw[0] = (u32x4){cvt_pk_bf16(p0[0], p0[1]), cvt_pk_bf16(p0[2], p0[3]), cvt_pk_bf16(p0[4], p0[5]), cvt_pk_bf16(p0[6], p0[7])};
        pw[1] = (u32x4){cvt_pk_bf16(p0[8], p0[9]), cvt_pk_bf16(p0[10], p0[11]), cvt_pk_bf16(p0[12], p0[13]), cvt_pk_bf16(p0[14], p0[15])};
        pw[2] = (u32x4){cvt_pk_bf16(p1[0], p1[1]), cvt_pk_bf16(p1[2], p1[3]), cvt_pk_bf16(p1[4], p1[5]), cvt_pk_bf16(p1[6], p1[7])};
        pw[3] = (u32x4){cvt_pk_bf16(p1[8], p1[9]), cvt_pk_bf16(p1[10], p1[11]), cvt_pk_bf16(p1[12], p1[13]), cvt_pk_bf16(p1[14], p1[15])};
        NSA_VREADS(la, ha, 0); NSA_VREADS(lb, hb, 1);
        NSA_LWAIT(8);
        NSA_PVMMA(la, ha, 0);
        __builtin_amdgcn_sched_barrier(0);
        NSA_VREADS(la, ha, 2);
        NSA_LWAIT(8);
        NSA_PVMMA(lb, hb, 1);
        __builtin_amdgcn_sched_barrier(0);
        NSA_VREADS(lb, hb, 3);
        NSA_LWAIT(8);
        NSA_PVMMA(la, ha, 2);
        NSA_LWAIT(0);
        NSA_PVMMA(lb, hb, 3);
#undef NSA_TRR
#undef NSA_VREADS
#undef NSA_PVMMA
    }
}
template <int STAGE  >
__device__ __forceinline__ void nsa_flush(const f32x16 (&o)[4], float sc, const NsaCtx& cx, float* scr, bf16_t* yrow0  ) {
    if (cx.hi == 0) cx.wsf[cx.q32] = sc;
    __builtin_amdgcn_wave_barrier();
    unsigned lofs = (unsigned)cx.lane, yofs = (unsigned)(cx.hi * 1024 + cx.q32);
    asm volatile("" : "+v"(lofs), "+v"(yofs));
    f32x4* sp0 = (f32x4*)scr + lofs; bf16_t* yp0 = yrow0 + yofs;
    f32x4 acc[16];
    if (STAGE >= 1) {
#pragma unroll
        for (int i = 0; i < 16; ++i) acc[i] = sp0[i * 64];
    }
#pragma unroll
    for (int c = 0; c < 4; ++c)
#pragma unroll
        for (int v = 0; v < 4; ++v) {
            f32x4 t;
#pragma unroll
            for (int e = 0; e < 4; ++e) t[e] = o[c][4 * v + e] * cx.wsf[crow16(4 * v + e, cx.hi)];
            if (STAGE >= 1) t += acc[c * 4 + v];
            if (STAGE <= 1) sp0[(c * 4 + v) * 64] = t;
            else {
#pragma unroll
                for (int e = 0; e < 4; ++e) { const int r = 4 * v + e; yp0[(2 * (r >> 2)) * DM + (r & 3) * 128 + 32 * c] = f2bf(t[e]); }
            }
        }
    __builtin_amdgcn_wave_barrier();
}
__device__ __forceinline__ void ph_nsa(const P& p, LAS unsigned char* lds, int bid, int nblk, int mk_wk) {
    int tidx_ = MK_TID; asm volatile("" : "+v"(tidx_));
    const int tid = tidx_, wid = __builtin_amdgcn_readfirstlane(tid >> 6), lane = tid & 63;
    const bf16_t* proj = WSP(bf16_t, WS_PROJ);
    LAS float* impL = (LAS float*)(lds + NSA_IMP);
    LAS unsigned* maskL = (LAS unsigned*)(lds + NSA_MASK);
    LAS unsigned* uniL = (LAS unsigned*)(lds + NSA_UNI);
    NsaCtx cx; cx.probe = 0; cx.lane = lane; cx.q32 = lane & 31; cx.hi = lane >> 5; cx.wsf = (LAS float*)(lds + NSA_WSF) + wid * 256;
    float* scr = WSP(float, WS_NSCR) + (size_t)bid * 32768 + wid * 4096;
    { const unsigned q32 = cx.q32, hi = cx.hi, blk = (lane >> 4) & 1, qq = (lane & 15) >> 2, pq = lane & 3;
      cx.kb0 = 2048u * (q32 >> 3) + 64u * (q32 & 7u) + 16u * ((0u + hi) ^ ((q32 >> 2) & 3u));
      cx.vb0 = 64u * (4u * hi + qq) + 16u * ((2u * blk + (pq >> 1)) ^ ((0u + hi) & 3u)) + 8u * (pq & 1u); }
    for (int k2 = 0; k2 < 2; ++k2) {
        for (int ub = bid; ub < 256; ub += nblk) {
            const int idx = k2 == 0 ? ub : 511 - ub;
            const int tb = 63 - (idx >> 3), bg = idx & 7, b = bg >> 1, g = bg & 1;
            const int tokw = 64 * tb + 8 * wid;
            const int t = tokw + (cx.q32 >> 2), hq = 4 * g + (cx.q32 & 3);
            const size_t rowq = (size_t)b * SEQ + t;
            cx.tb = tb; cx.tl6 = t & 63; cx.ncv = t >= 31 ? (t - 31) / 16 + 1 : 0;
            cx.impW = impL + 8 * wid * 64;
            { unsigned tz = (unsigned)cx.lane + 64u * (unsigned)wid; asm volatile("" : "+v"(tz));
              for (unsigned i = tz; i < 4096u; i += NTHR) impL[i] = 0.f; }
            bf16x8 qr[8];
#pragma unroll
            for (int s = 0; s < 8; ++s) qr[s] = *(const bf16x8*)(proj + rowq * PLD + C_NQ + hq * 128 + 16 * s + 8 * cx.hi);
            const bf16_t* gp = proj + rowq * PLD + C_NG + hq * 3;
            if (cx.hi == 0) { cx.wsf[64 + cx.q32] = sigmoidf_(bf2f(gp[0])); cx.wsf[96 + cx.q32] = sigmoidf_(bf2f(gp[1])); cx.wsf[128 + cx.q32] = sigmoidf_(bf2f(gp[2])); }
            bf16_t* yrow0 = WSP(bf16_t, WS_YNSA) + ((size_t)b * SEQ + tokw) * DM + 4 * g * 128;
            f32x16 o[4]; float m, lp;
#define NSA_RESET() do { _Pragma("unroll") for (int c_ = 0; c_ < 4; ++c_) _Pragma("unroll") for (int r_ = 0; r_ < 16; ++r_) o[c_][r_] = 0.f; m = NSA_NEG; lp = 0.f; } while (0)
            const int ntc = (4 * tb + 3 + 63) >> 6;
            const bf16_t* kc = WSP(bf16_t, WS_KCVC) + (((size_t)0 * 4 + b) * 2 + g) * 256 * 128;
            const bf16_t* vc = WSP(bf16_t, WS_KCVC) + (((size_t)1 * 4 + b) * 2 + g) * 256 * 128;
            NSA_RESET();
            __syncthreads();
            nsa_tile_glds<false>(NSA_BUF(0), kc, vc, 128, wid, mk_wk); if (ntc > 1) nsa_tile_glds<false>(NSA_BUF(1), kc + (size_t)64 * 128, vc, 128, wid, mk_wk);
            for (int i = 0; i < ntc; ++i) {
                NSA_RING_WAIT(i + 1 < ntc, 2);
                if (i + 2 < ntc) nsa_tile_glds<false>(NSA_BUF(i + 2), kc + (size_t)(i + 2) * 64 * 128, vc, 128, wid, mk_wk);
                nsa_tile<0>(NSA_BUF(i), qr, o, m, lp, cx, i, true);
            }
            NSA_SYNC();
            { const float lt = lp + __shfl_xor(lp, 32); cx.invl = lt > 0.f ? 1.f / lt : 0.f; }
            nsa_tile_glds<true>(NSA_BUF(0), kc, vc, 128, wid, mk_wk); if (ntc > 1) nsa_tile_glds<true>(NSA_BUF(1), kc + (size_t)64 * 128, vc + (size_t)64 * 128, 128, wid, mk_wk);
            for (int i = 0; i < ntc; ++i) {
                NSA_RING_WAIT(i + 1 < ntc, 4);
                if (i + 2 < ntc) nsa_tile_glds<true>(NSA_BUF(i + 2), kc + (size_t)(i + 2) * 64 * 128, vc + (size_t)(i + 2) * 64 * 128, 128, wid, mk_wk);
                nsa_tile<1>(NSA_BUF(i), qr, o, m, lp, cx, i, true);
            }
            NSA_SYNC();
            nsa_flush<0>(o, cx.wsf[64 + cx.q32], cx, scr, yrow0);
            unsigned ulo = 0u, uhi = 0u;
            int lane_s = cx.lane; asm volatile("" : "+v"(lane_s));
            {
                unsigned key[8], T[8];
                const int tbb = tokw >> 6, s = lane_s;
                const bool forced = (s == 0) || (s == tbb) || (s == tbb - 1), valid = s <= tbb;
#pragma unroll
                for (int tl = 0; tl < 8; ++tl) {
                    const float imp = impL[(8 * wid + tl) * 64 + s];
                    const float score = forced ? INFINITY : (valid ? imp : -INFINITY);
                    const unsigned u = __float_as_uint(score);
                    key[tl] = u ^ ((u >> 31) ? 0xFFFFFFFFu : 0x80000000u);
                    T[tl] = 0u;
                }
#pragma unroll 2
                for (int b = 31; b >= 0; --b) {
#pragma unroll
                    for (int tl = 0; tl < 8; ++tl) { const unsigned cand = T[tl] | (1u << b); T[tl] = (__popcll(__ballot(key[tl] >= cand)) >= 16) ? cand : T[tl]; }
                }
#pragma unroll
                for (int tl = 0; tl < 8; ++tl) {
                    const u64 gt = __ballot(key[tl] > T[tl]); u64 eq = __ballot(key[tl] == T[tl]);
                    int r = 16 - (int)__popcll(gt);
                    u64 sel = gt;
                    if ((int)__popcll(eq) <= r) sel |= eq;
                    else { for (; r > 0; --r) { const u64 lowb = eq & (0ull - eq); sel |= lowb; eq ^= lowb; } }
                    const u64 mk = sel & __ballot(key[tl] > 0x007FFFFFu);
                    if (lane_s == 0) { maskL[(8 * wid + tl) * 2] = (unsigned)mk; maskL[(8 * wid + tl) * 2 + 1] = (unsigned)(mk >> 32); }
                    ulo |= (unsigned)mk; uhi |= (unsigned)(mk >> 32);
                }
            }
            if (lane_s == 0) { uniL[wid * 2] = ulo; uniL[wid * 2 + 1] = uhi; }
            const u64 wmask = ((u64)(unsigned)__builtin_amdgcn_readfirstlane(ulo)) | (((u64)(unsigned)__builtin_amdgcn_readfirstlane(uhi)) << 32);
            __syncthreads();
            cx.maskw = maskL + (8 * wid + (cx.q32 >> 2)) * 2;
            u64 um = 0ull;
#pragma unroll
            for (int w8 = 0; w8 < 8; ++w8) um |= (u64)uniL[w8 * 2] | ((u64)uniL[w8 * 2 + 1] << 32);
            um = ((u64)(unsigned)__builtin_amdgcn_readfirstlane((unsigned)um)) | ((u64)(unsigned)__builtin_amdgcn_readfirstlane((unsigned)(um >> 32)) << 32);
            um &= (tb >= 63) ? ~0ull : ((1ull << (tb + 1)) - 1ull);
            NSA_RESET();
            {
                const bf16_t* kbase = WSP(bf16_t, WS_KCB) + (((size_t)2 * 4 + b) * 2 + g) * 4096 * 128; const bf16_t* vbase = WSP(bf16_t, WS_KCB) + (((size_t)3 * 4 + b) * 2 + g) * 4096 * 128;
#define NSA_POP(r_) (__ffsll((long long)(r_)) - 1)
                u64 rem = um; int ja = NSA_POP(rem); rem &= rem - 1;
                int jb = -1; if (rem) { jb = NSA_POP(rem); rem &= rem - 1; }
                nsa_tile_glds<true>(NSA_BUF(0), kbase + (size_t)ja * 64 * 128, vbase + (size_t)ja * 64 * 128, 128, wid, mk_wk);
                if (jb >= 0) nsa_tile_glds<true>(NSA_BUF(1), kbase + (size_t)jb * 64 * 128, vbase + (size_t)jb * 64 * 128, 128, wid, mk_wk);
                for (int i = 0;; i += 2) {
                    NSA_SYNC();
                    int jc = -1, jd = -1;
                    if (rem) { jc = NSA_POP(rem); rem &= rem - 1; nsa_tile_glds<true>(NSA_BUF(i + 2), kbase + (size_t)jc * 64 * 128, vbase + (size_t)jc * 64 * 128, 128, wid, mk_wk);
                        if (rem) { jd = NSA_POP(rem); rem &= rem - 1; nsa_tile_glds<true>(NSA_BUF(i + 3), kbase + (size_t)jd * 64 * 128, vbase + (size_t)jd * 64 * 128, 128, wid, mk_wk); } }
                    if ((wmask >> ja) & 1ull) nsa_tile<2>(NSA_BUF(i), qr, o, m, lp, cx, ja, ja >= tb);
                    if (jb >= 0 && ((wmask >> jb) & 1ull)) nsa_tile<2>(NSA_BUF(i + 1), qr, o, m, lp, cx, jb, jb >= tb);
                    if (jc < 0) break;
                    ja = jc; jb = jd;
                }
                NSA_SYNC();
#undef NSA_POP
                cx.probe = 0;
                const float lt = lp + __shfl_xor(lp, 32);
                nsa_flush<1>(o, lt > 0.f ? cx.wsf[96 + cx.q32] / lt : 0.f, cx, scr, yrow0);
            }
            NSA_RESET();
            {
                const bf16_t* kbase = WSP(bf16_t, WS_KCB) + (((size_t)4 * 4 + b) * 2 + g) * 4096 * 128; const bf16_t* vbase = WSP(bf16_t, WS_KCB) + (((size_t)5 * 4 + b) * 2 + g) * 4096 * 128;
                const int j0 = tb >= 8 ? tb - 8 : 0, nt = tb - j0 + 1;
                nsa_tile_glds<true>(NSA_BUF(0), kbase + (size_t)j0 * 64 * 128, vbase + (size_t)j0 * 64 * 128, 128, wid, mk_wk);
                if (nt > 1) nsa_tile_glds<true>(NSA_BUF(1), kbase + (size_t)(j0 + 1) * 64 * 128, vbase + (size_t)(j0 + 1) * 64 * 128, 128, wid, mk_wk);
                for (int i = 0; i < nt; i += 2) {
                    NSA_SYNC();
                    if (i + 2 < nt) nsa_tile_glds<true>(NSA_BUF(i + 2), kbase + (size_t)(j0 + i + 2) * 64 * 128, vbase + (size_t)(j0 + i + 2) * 64 * 128, 128, wid, mk_wk);
                    if (i + 3 < nt) nsa_tile_glds<true>(NSA_BUF(i + 3), kbase + (size_t)(j0 + i + 3) * 64 * 128, vbase + (size_t)(j0 + i + 3) * 64 * 128, 128, wid, mk_wk);
                    nsa_tile<3>(NSA_BUF(i), qr, o, m, lp, cx, j0 + i, (j0 + i == tb) || (j0 + i == tb - 8));
                    if (i + 1 < nt) nsa_tile<3>(NSA_BUF(i + 1), qr, o, m, lp, cx, j0 + i + 1, (j0 + i + 1 == tb) || (j0 + i + 1 == tb - 8));
                }
                NSA_SYNC();
                const float lt = lp + __shfl_xor(lp, 32);
                nsa_flush<2>(o, lt > 0.f ? cx.wsf[128 + cx.q32] / lt : 0.f, cx, scr, yrow0);
            }
#undef NSA_RESET
        }
    }
}
#ifndef REP_U1
#define REP_U1 1
#endif
#ifndef REP_ROUTE
#define REP_ROUTE 1
#endif
#ifndef REP_P0
#define REP_P0 1
#endif
#ifndef REP_INPROJ
#define REP_INPROJ 1
#endif
#ifndef REP_G3
#define REP_G3 1
#endif
#ifndef REP_G4
#define REP_G4 1
#endif
#ifndef REP_NSA
#define REP_NSA 1
#endif
#ifndef REP_MERGE
#define REP_MERGE 1
#endif
#ifndef REP_OUT
#define REP_OUT 1
#endif
#ifndef REP_MOE1
#define REP_MOE1 1
#endif
#ifndef REP_MOE2
#define REP_MOE2 1
#endif
#ifndef REP_FINAL
#define REP_FINAL 1
#endif
#ifndef FILL_AT
#define FILL_AT(k) ((k) < PH_ASSIGN)
#endif
enum { PH_MOD = 0, PH_U1, PH_INPROJ, PH_G3, PH_G4, PH_NSA, PH_MERGE, PH_OUT, PH_ROUTE, PH_ASSIGN, PH_MOE1, PH_MOE2, PH_FINAL, PH_END };
struct Args { P p; int ph_lo, ph_hi; };
__global__ void __launch_bounds__(NTHR, 2) mega(Args a) {
    extern __shared__ __attribute__((aligned(16))) unsigned char lds_raw[];
    LAS unsigned char* lds = (LAS unsigned char*)lds_raw;
    const P& p = a.p;
    const int mk_wk = __builtin_amdgcn_readfirstlane((int)threadIdx.x >> 6);
    const int bid = blockIdx.x, nblk = gridDim.x;
    volatile LAS unsigned* MISC = (volatile LAS unsigned*)(lds + LDS_MISC_OFF);
    for (int u = MK_TID; u < (MK_LDS_BYTES - LDS_MISC_OFF) / 4; u += NTHR) ((LAS unsigned*)(lds + LDS_MISC_OFF))[u] = 0u;
    __syncthreads();
    const bool multi = (a.ph_hi - a.ph_lo) > 1;
    XcdBarrier bar; bar.bar = WSP(unsigned, WS_CTL) + CW_BAR; bar.x = 0; bar.st = nullptr;
    if (multi) bar = xcd_barrier_post(WSP(unsigned, WS_CTL) + CW_BAR, MISC + 8, mk_wk);
#define IN(k) (a.ph_lo <= (k) && (k) < a.ph_hi)
#ifdef TS_A
#define SEAM(k) do { if (IN(k) && IN((k) + 1)) xcd_barrier(bar, mk_wk); if (bid == 0 && MK_TID == 0) ((unsigned long long*)(WSP(int, WS_CTL) + 2048))[(k) + 1] = __builtin_amdgcn_s_memrealtime(); } while (0)
#else
#define SEAM(k) do { if (IN(k) && IN((k) + 1)) { if (FILL_AT(k)) xcd_barrier_fill(bar, mk_wk, p, lds); else xcd_barrier(bar, mk_wk); } } while (0)
#endif
    for (int rep_ = 0; rep_ < REP_P0; ++rep_)
#ifdef TS_A
    if (bid == 0 && MK_TID == 0) ((unsigned long long*)(WSP(int, WS_CTL) + 2048))[0] = __builtin_amdgcn_s_memrealtime();
#endif
    if (IN(PH_MOD)) { ph_cmp_bias(p, bid, nblk, mk_wk); ph_mod(p, lds, bid, nblk, mk_wk); ph_convert(p, lds, bid, nblk, mk_wk); }
    SEAM(PH_MOD);
    for (int rep_ = 0; rep_ < REP_U1; ++rep_)
    if (IN(PH_U1)) ph_u1(p, bid, nblk, mk_wk);
    SEAM(PH_U1);
#ifdef PROBE_BARRIERS
    for (int xb_ = 0; xb_ < 20; ++xb_) xcd_barrier(bar, mk_wk);
#endif
    for (int rep_ = 0; rep_ < REP_INPROJ; ++rep_)
    if (IN(PH_INPROJ)) {
        if (((bid >> 3) & 1) != 0) conv_take(p, lds, MISC + 8, mk_wk, 3);
        pg8::Gemm g{WSP(bf16_t, WS_U1), WSP(bf16_t, WS_WINT), NTOK, PLD, 1024, 1024}; pg8::StaticOrder S; S.init(NTOK, PLD, nblk, bid);
        EpiProj E{WSP(bf16_t, WS_PROJ), PLD, WSP(bf16_t, WS_KCB), WSP(unsigned char, WS_MG8)};
        pg8::gemm_phase<EpiProj, pg8::StaticOrder, true, true>(lds, g, S, E, mk_wk);
    }
    SEAM(PH_INPROJ);
    for (int rep_ = 0; rep_ < REP_G3; ++rep_)
    if (IN(PH_G3)) {
        ph_gla_g1(p, lds, bid, nblk, mk_wk);
        { pg8::Gemm g{WSP(bf16_t, WS_KCB), WSP(bf16_t, WS_CW1T), 2048, 512, 512, 2048}; CmpOrder S{nblk, bid}; EpiSlab E{WSP(float, WS_SLAB)};
          pg8::gemm_phase<EpiSlab, CmpOrder, true, true>(lds, g, S, E, mk_wk); }
    }
    SEAM(PH_G3);
    for (int rep_ = 0; rep_ < REP_G4; ++rep_)
    if (IN(PH_G4)) {
        ph_cmp_fin(p, lds, bid, nblk, mk_wk);
        ph_gla_g2(p, lds, bid, nblk, mk_wk);
    }
    SEAM(PH_G4);
    for (int rep_ = 0; rep_ < REP_NSA; ++rep_)
    if (IN(PH_NSA)) { ph_ygla_naive(p, bid, nblk, mk_wk); ph_nsa(p, lds, bid, nblk, mk_wk); }
    SEAM(PH_NSA);
    for (int rep_ = 0; rep_ < REP_MERGE; ++rep_)
    if (IN(PH_MERGE)) {
        pg8::StaticOrder S; S.init(NTOK, 1024, nblk, bid);
        { pg8::Gemm g{WSP(bf16_t, WS_YGLA), WSP(bf16_t, WS_PGLAT), NTOK, 1024, 1024, 1024}; EpiMerge<1> E{WSP(unsigned char, WS_MG8), WSP(bf16_t, WS_T1), WSP(bf16_t, WS_MERG)};
          pg8::gemm_phase<EpiMerge<1>, pg8::StaticOrder, true, true>(lds, g, S, E, mk_wk); }
        asm volatile("s_waitcnt vmcnt(0)" ::: "memory"); __syncthreads();
        { pg8::Gemm g{WSP(bf16_t, WS_YNSA), WSP(bf16_t, WS_PNSAT), NTOK, 1024, 1024, 1024}; EpiMerge<2> E{WSP(unsigned char, WS_MG8), WSP(bf16_t, WS_T1), WSP(bf16_t, WS_MERG)};
          pg8::gemm_phase<EpiMerge<2>, pg8::StaticOrder, true, true>(lds, g, S, E, mk_wk); }
    }
    SEAM(PH_MERGE);
    for (int rep_ = 0; rep_ < REP_OUT; ++rep_)
    if (IN(PH_OUT)) {
        pg8::Gemm g{WSP(bf16_t, WS_MERG), WSP(bf16_t, WS_WOUTT), NTOK, 1024, 1024, 1024}; pg8::StaticOrder S; S.init(NTOK, 1024, nblk, bid);
        EpiOut E{p.x, WSP(float, WS_MOD), WSP(bf16_t, WS_H1)};
        pg8::gemm_phase<EpiOut, pg8::StaticOrder, true, true>(lds, g, S, E, mk_wk);
    }
    SEAM(PH_OUT);
    for (int rep_ = 0; rep_ < REP_ROUTE; ++rep_)
    if (IN(PH_ROUTE)) ph_route(p, lds, bid, nblk, mk_wk, rep_ == 0);
    SEAM(PH_ROUTE);
    if (IN(PH_ASSIGN)) { conv_drain(p, lds, MISC + 8, mk_wk, CV_QL); ph_assign(p, lds, bid, nblk, mk_wk); }
    SEAM(PH_ASSIGN);
    for (int rep_ = 0; rep_ < REP_MOE1; ++rep_)
    if (IN(PH_MOE1)) {
        const int* ctl = WSP(int, WS_CTL);
        pg8::Gemm g{WSP(bf16_t, WS_XS), WSP(bf16_t, WS_W1T), PROWS, 2048, 512, 512};
        MoeOrder S(ctl, 8, nblk, bid, (size_t)2048 * 1024);
        EpiSwiglu E{p.moe_b1, WSP(bf16_t, WS_ACT), ctl + CT_BLKE};
        pg8::gemm_phase<EpiSwiglu, MoeOrder, true, true, true>(lds, g, S, E, mk_wk);
    }
    SEAM(PH_MOE1);
    for (int rep_ = 0; rep_ < REP_MOE2; ++rep_)
    if (IN(PH_MOE2)) {
        const int* ctl = WSP(int, WS_CTL);
        pg8::Gemm g{WSP(bf16_t, WS_ACT), WSP(bf16_t, WS_W2T), PROWS, 1024, 512, 512};
        MoeOrder S(ctl, 4, nblk, bid, (size_t)1024 * 1024);
        EpiMoe2 E{p.moe_b2, WSP(bf16_t, WS_YSLOT), ctl + CT_BLKE};
        pg8::gemm_phase<EpiMoe2, MoeOrder, true, true, true>(lds, g, S, E, mk_wk);
    }
    SEAM(PH_MOE2);
    for (int rep_ = 0; rep_ < REP_FINAL; ++rep_)
    if (IN(PH_FINAL)) ph_final(p, bid, nblk, mk_wk);
#undef IN
#undef SEAM
}

extern "C" void kernel_launch(void* const* d_in, const int* in_sizes, int n_in, void* d_out, int out_size, void* d_ws, size_t ws_size, hipStream_t stream) {
    static int grid = 0;
    if (grid == 0) {
        (void)hipFuncSetAttribute((const void*)mega, hipFuncAttributeMaxDynamicSharedMemorySize, MK_LDS_BYTES);
        int dev = 0, cus = 0, per_cu = 0;
        if (hipGetDevice(&dev) != hipSuccess || hipDeviceGetAttribute(&cus, hipDeviceAttributeMultiprocessorCount, dev) != hipSuccess || cus <= 0) cus = 256;
        if (hipOccupancyMaxActiveBlocksPerMultiprocessor(&per_cu, (const void*)mega, NTHR, MK_LDS_BYTES) != hipSuccess || per_cu < 1) per_cu = 1;
        (void)hipGetLastError();
        grid = cus;
    }
    Args a{};
    const float** pp = (const float**)&a.p;
    for (int i = 0; i < 23; ++i) pp[i] = (const float*)d_in[i];
    a.p.out = (float*)d_out; a.p.ws = (unsigned char*)d_ws;
    (void)hipMemsetAsync((char*)d_ws + WS_CTL, 0, 65536, stream);
    a.ph_lo = 0; a.ph_hi = PH_END;
    hipLaunchKernelGGL(mega, dim3(grid), dim3(NTHR), MK_LDS_BYTES, stream, a);
}
```

```cpp
#include <hip/hip_runtime.h>
#include <stdint.h>
#include <math.h>

typedef unsigned short bf16_t;
typedef unsigned long long u64;

constexpr int BATCH = 4, SEQ = 4096, DM = 1024, NTOK = BATCH * SEQ;
constexpr int IN_COLS = 7720, PLD = 7936;
constexpr int C_GQ = 0, C_GK = 512, C_GV = 1024, C_GR = 2048, C_NQ = 3072, C_KC = 4096, C_VC = 4352, C_KS = 4608, C_VS = 4864,
              C_KW = 5120, C_VW = 5376, C_MG = 5632, C_GA = 7680, C_NG = 7696;
constexpr int NCMP = 255, NSEL = 64, NEXP = 32, TOPK = 4, MOEB = 256;
constexpr int PROWS = NTOK * TOPK + NEXP * MOEB;
constexpr float RMS_EPS = 1e-5f;

__host__ __device__ inline int orig_col(int j) {
    if (j < 3072) return j;
    if (j < 5632) return j + 16;
    if (j < 7680) return j + 40;
    if (j < 7696) return j - 4608;
    return j - 2048;
}

constexpr size_t MiB = 1u << 20;
constexpr size_t WS_CTL = 0;
constexpr size_t WS_MOD = 1 * MiB;
constexpr size_t WS_W1T = 2 * MiB;
constexpr size_t WS_W2T = 130 * MiB;
constexpr size_t WS_WINT = 194 * MiB;
constexpr size_t WS_PGLAT = 210 * MiB, WS_PNSAT = 212 * MiB, WS_WOUTT = 214 * MiB;
constexpr size_t WS_CW1T = 216 * MiB;
constexpr size_t WS_CW2T = 220 * MiB;
constexpr size_t WS_H1 = 221 * MiB;
constexpr size_t WS_U2 = 285 * MiB;
constexpr size_t WS_TOPE = 317 * MiB;
constexpr size_t WS_TOPW = 317 * MiB + 512 * 1024;
constexpr size_t WS_ROWTOK = 318 * MiB;
constexpr size_t WS_SLOTOF = 318 * MiB + 512 * 1024;
constexpr size_t WS_U1 = 320 * MiB;
constexpr size_t WS_PROJ = 352 * MiB;
constexpr size_t WS_MG8 = 600 * MiB;
constexpr size_t WS_OGLA = 632 * MiB;
constexpr size_t WS_YGLA = 696 * MiB;
constexpr size_t WS_HID = 728 * MiB;
constexpr size_t WS_KCVC = 732 * MiB;
constexpr size_t WS_SELM = 734 * MiB;
constexpr size_t WS_OCMP = 735 * MiB;
constexpr size_t WS_OSEL = 799 * MiB;
constexpr size_t WS_OWIN = 863 * MiB;
constexpr size_t WS_YNSA = 927 * MiB;
constexpr size_t WS_MERG = 959 * MiB;
constexpr size_t WS_T1 = 991 * MiB;
constexpr size_t WS_TMPF = 600 * MiB;
constexpr size_t WS_XS = 320 * MiB;
constexpr size_t WS_ACT = 464 * MiB;
constexpr size_t WS_YSLOT = 608 * MiB;
constexpr int CT_CNT = 0, CT_FILL = 64, CT_PSTART = 128, CT_PTOT = 192, CT_CVQ = 200  , CT_BLKE = 256;

__device__ __forceinline__ float bf2f(bf16_t v) { return __uint_as_float(((unsigned)v) << 16); }
__device__ __forceinline__ bf16_t f2bf(float f) { unsigned u = __float_as_uint(f); return (bf16_t)((u + 0x7fffu + ((u >> 16) & 1u)) >> 16); }
__device__ __forceinline__ float sigmoidf_(float x) { return __builtin_amdgcn_rcpf(1.f + __expf(-x)); }
__device__ __forceinline__ float siluf_(float x) { return x * __builtin_amdgcn_rcpf(1.f + __expf(-x)); }
__device__ __forceinline__ float wave_sum(float v) {
#pragma unroll
    for (int o = 1; o < 64; o <<= 1) v += __shfl_xor(v, o);
    return v;
}
__device__ __forceinline__ float wave_max(float v) {
#pragma unroll
    for (int o = 1; o < 64; o <<= 1) v = fmaxf(v, __shfl_xor(v, o));
    return v;
}

struct P {
    const float *x, *c, *w_ada, *b_ada, *norm1_g, *w_in, *gla_wa2, *gla_ba, *gla_norm_g, *cmp_pe, *cmp_w1, *cmp_w2, *proj_gla, *proj_nsa,
        *w_out, *norm2_g, *router_w, *router_b, *moe_w1, *moe_b1, *moe_w2, *moe_b2, *final_g;
    float* out;
    unsigned char* ws;
};
#define WSP(T, off) ((T*)(p.ws + (off)))

__device__ __forceinline__ float gelu_tanh(float x) { const float u = 0.7978845608028654f * (x + 0.044715f * x * x * x); return 0.5f * x * (1.f + tanhf(u)); }
#ifndef EPI_REP
#define EPI_REP 1
#endif
__device__ __forceinline__ int mk_lane_asm() { int l; asm volatile("v_mbcnt_lo_u32_b32 %0, -1, 0\n\tv_mbcnt_hi_u32_b32 %0, -1, %0" : "=v"(l)); return l; }
#define MK_TID (mk_wk * 64 + mk_lane_asm())
namespace pg8 {
#define PG8_LAS __attribute__((address_space(3)))
typedef unsigned short bf16_t;
typedef short bf16x8 __attribute__((ext_vector_type(8)));
typedef float f32x4 __attribute__((ext_vector_type(4)));
typedef unsigned u32x4 __attribute__((ext_vector_type(4)));
constexpr int BM = 256, BK = 64, HALF = 128, HTB = HALF * BK * 2  , STAGE_BYTES = 8 * HTB, NXCD = 8, WGM = 8;

__host__ __device__ __forceinline__ int lds_byte(int r, int c) { const int st = (r >> 4) * 2 + (c >> 5), rr = r & 15, cc = c & 31, ob = rr * 64 + cc * 2; return st * 1024 + (ob ^ (((ob >> 9) & 1) << 5)); }
__host__ __device__ __forceinline__ void stage_rc(int b, int& R, int& C) { const int st = b / 1024, sb = b % 1024, swz = sb ^ (((sb >> 9) & 1) << 5); R = (st >> 1) * 16 + swz / 64; C = (st & 1) * 32 + (swz % 64) / 2; }
__host__ __device__ __forceinline__ int perm32(int rho) { const int n = rho >> 4, i = rho & 15; return 8 * (i >> 2) + 4 * n + (i & 3); }

struct Unit { int pm, pn, e; };
struct Gemm { const bf16_t* A; const bf16_t* Bt; int M, N, K, ld; };

struct StaticOrder {
    int nM, nN, nwg, G, c;
    __host__ __device__ void init(int M, int N, int G_, int c_) { nM = M / BM; nN = N / BM; nwg = nM * nN; G = G_; c = c_; }
    __host__ __device__ bool next(int i, Unit& u) const {
        const long L = (long)i * G + c; if (L >= nwg) return false;
        int wgid = (int)L; { const int q = nwg / NXCD, r = nwg % NXCD, xcd = wgid % NXCD, off = wgid / NXCD; wgid = (xcd < r ? xcd * (q + 1) : r * (q + 1) + (xcd - r) * q) + off; }
        const int nig = WGM * nN, gid = wgid / nig, fm = gid * WGM, gsz = (nM - fm) < WGM ? (nM - fm) : WGM;
        u.pm = fm + ((wgid % nig) % gsz); u.pn = (wgid % nig) / gsz; u.e = 0; return true;
    }
    __device__ __forceinline__ void a_ready(const Unit&) const {}
    __device__ __forceinline__ void done(const Unit&) const {}
    __device__ __forceinline__ const char* abase(const Gemm& g, const Unit& u, size_t tstep) const { return (const char*)g.A + (size_t)u.pm * tstep; }
    __device__ __forceinline__ const char* bbase(const Gemm& g, const Unit& u, size_t tstep) const { return (const char*)g.Bt + (size_t)u.pn * tstep; }
};

template <class Epi, class Sched, bool ALIGN_EPI = false, bool SP2 = false, bool FP8 = false>
__device__ __forceinline__ void gemm_phase(PG8_LAS unsigned char* lds, const Gemm g, const Sched& S, const Epi& E, int mk_wk) {
    int tid_ = MK_TID; asm volatile("" : "+v"(tid_));
    const int tid = tid_, wid = __builtin_amdgcn_readfirstlane(tid >> 6), lane = tid & 63, wr = wid >> 2, wc = wid & 3, fr = lane & 15, fq = lane >> 4;
    const int K = g.ld, nt = g.K / BK;
    unsigned voffA[2], voffB[2];
#pragma unroll
    for (int i = 0; i < 2; ++i) { int R, C; stage_rc(tid * 16 + i * 8192, R, C); const int Rb = Epi::PERM ? ((R & ~31) + perm32(R & 31)) : R;
        voffA[i] = (unsigned)(R * K + C) * 2u; voffB[i] = (unsigned)(Rb * K + C) * 2u; }
    const size_t kstep = (size_t)(BK * 2);
    const size_t hstep = (size_t)HALF * K * 2;
    const size_t tstep = 2 * hstep;
    const unsigned ldsw = (unsigned)wid * 1024u;
    const int aoff = lds_byte(wr * 64 + fr, fq * 8), boff = lds_byte(wc * 32 + fr, fq * 8);
#define PG8_SA(b, h) (((b) * 2 + (h)) * HTB)
#define PG8_SB(b, h) ((4 + (b) * 2 + (h)) * HTB)
#define PG8_STAGE(bufoff, gbase, voff) do { _Pragma("unroll") for (int _i = 0; _i < 2; ++_i) { unsigned vo_ = (voff)[_i]; if constexpr (FP8) asm volatile("" : "+v"(vo_));     \
        __builtin_amdgcn_global_load_lds((const unsigned*)((const char*)(gbase) + vo_), (PG8_LAS unsigned*)(lds + (bufoff) + ldsw + _i * 8192), 16, 0, 0); } } while (0)
#define PG8_LDA(dst, b, h) do { _Pragma("unroll") for (int m = 0; m < 4; ++m) { const v4i_ l0_ = *(const PG8_LAS v4i_*)(lds + PG8_SA(b, h) + aoff + m * 2048), l1_ = *(const PG8_LAS v4i_*)(lds + PG8_SA(b, h) + aoff + m * 2048 + 1024); \
        dst[m] = __builtin_shufflevector(l0_, l1_, 0, 1, 2, 3, 4, 5, 6, 7); } } while (0)
#define PG8_LDB(dst, b, h) do { _Pragma("unroll") for (int n = 0; n < 2; ++n) { const v4i_ l0_ = *(const PG8_LAS v4i_*)(lds + PG8_SB(b, h) + boff + n * 2048), l1_ = *(const PG8_LAS v4i_*)(lds + PG8_SB(b, h) + boff + n * 2048 + 1024); \
        dst[n] = __builtin_shufflevector(l0_, l1_, 0, 1, 2, 3, 4, 5, 6, 7); } } while (0)
#define PG8_MMA(ai, bj, At, Bt) do { __builtin_amdgcn_s_setprio(1); _Pragma("unroll") for (int m = 0; m < 4; ++m) _Pragma("unroll") for (int n = 0; n < 2; ++n) { \
        if constexpr (FP8) acc[ai][bj][m][n] = __builtin_amdgcn_mfma_scale_f32_16x16x128_f8f6f4(Bt[n], At[m], acc[ai][bj][m][n], 0, 0, 0, 0x7a7a7a7a, 0, 0x7f7f7f7f); \
        else { acc[ai][bj][m][n] = __builtin_amdgcn_mfma_f32_16x16x32_bf16(__builtin_bit_cast(bf16x8, __builtin_shufflevector(Bt[n], Bt[n], 0, 1, 2, 3)), __builtin_bit_cast(bf16x8, __builtin_shufflevector(At[m], At[m], 0, 1, 2, 3)), acc[ai][bj][m][n], 0, 0, 0); \
               acc[ai][bj][m][n] = __builtin_amdgcn_mfma_f32_16x16x32_bf16(__builtin_bit_cast(bf16x8, __builtin_shufflevector(Bt[n], Bt[n], 4, 5, 6, 7)), __builtin_bit_cast(bf16x8, __builtin_shufflevector(At[m], At[m], 4, 5, 6, 7)), acc[ai][bj][m][n], 0, 0, 0); } } \
        __builtin_amdgcn_s_setprio(0); } while (0)
#define PG8_WAIT_V(n) asm volatile("s_waitcnt vmcnt(" #n ")" ::: "memory")
#define PG8_WAIT_L(n) asm volatile("s_waitcnt lgkmcnt(" #n ")" ::: "memory")
#define PG8_BAR __builtin_amdgcn_s_barrier()
#define PG8_SCHED __builtin_amdgcn_sched_barrier(0)
    Unit cur, nxt; int ui = 0;
    if (!S.next(0, cur)) return;
    f32x4 acc[2][2][4][2];
#pragma unroll
    for (int a = 0; a < 2; ++a)
#pragma unroll
        for (int b = 0; b < 2; ++b)
#pragma unroll
            for (int m = 0; m < 4; ++m)
#pragma unroll
                for (int n = 0; n < 2; ++n) acc[a][b][m][n] = (f32x4){0.f, 0.f, 0.f, 0.f};
    typedef int v4i_ __attribute__((ext_vector_type(4))); typedef int v8i_ __attribute__((ext_vector_type(8)));
    v8i_ At[4], B0[2], B1[2];
    const char* cA = S.abase(g, cur, tstep); const char* cB = S.bbase(g, cur, tstep);
    S.a_ready(cur);
    if constexpr (SP2) {
        PG8_STAGE(PG8_SB(0, 0), cB, voffB); PG8_STAGE(PG8_SB(0, 1), cB + hstep, voffB); PG8_STAGE(PG8_SA(0, 0), cA, voffA); PG8_STAGE(PG8_SA(0, 1), cA + hstep, voffA);
        if (wr == 1) PG8_BAR;
        PG8_WAIT_V(2); PG8_BAR;
        PG8_STAGE(PG8_SB(1, 0), cB + kstep, voffB); PG8_STAGE(PG8_SA(1, 0), cA + kstep, voffA); PG8_STAGE(PG8_SB(1, 1), cB + hstep + kstep, voffB);
        PG8_WAIT_V(6); PG8_BAR;
    } else {
        PG8_STAGE(PG8_SB(0, 0), cB, voffB); PG8_STAGE(PG8_SA(0, 0), cA, voffA); PG8_STAGE(PG8_SB(0, 1), cB + hstep, voffB); PG8_STAGE(PG8_SA(0, 1), cA + hstep, voffA);
        if (wr == 1) PG8_BAR;
        PG8_WAIT_V(4); PG8_BAR;
        PG8_STAGE(PG8_SB(1, 0), cB + kstep, voffB); PG8_STAGE(PG8_SA(1, 0), cA + kstep, voffA); PG8_STAGE(PG8_SB(1, 1), cB + hstep + kstep, voffB);
        PG8_WAIT_V(6); PG8_BAR;
    }
    for (;;) {
        const bool has_next = S.next(ui + 1, nxt);
        const char* nA = has_next ? S.abase(g, nxt, tstep) : cA; const char* nB = has_next ? S.bbase(g, nxt, tstep) : cB;
#pragma unroll 1
        for (int t = 0; t < nt; t += 2) {
            const bool last = (t == nt - 2);
            const char* a1 = cA + (size_t)(t + 1) * kstep;
            const char* a2 = last ? nA : cA + (size_t)(t + 2) * kstep; const char* b2 = last ? nB : cB + (size_t)(t + 2) * kstep;
            const char* a3 = a2 + kstep; const char* b3 = b2 + kstep;
            if (last && has_next) S.a_ready(nxt);
            if constexpr (SP2) {
            PG8_LDB(B0, 0, 0); PG8_LDB(B1, 0, 1); PG8_SCHED; PG8_LDA(At, 0, 0); PG8_STAGE(PG8_SA(1, 1), a1 + hstep, voffA);
            PG8_WAIT_V(8); PG8_WAIT_L(0); PG8_BAR; PG8_MMA(0, 0, At, B0); PG8_MMA(0, 1, At, B1); PG8_BAR; PG8_SCHED;
            PG8_LDA(At, 0, 1); PG8_STAGE(PG8_SB(0, 0), b2, voffB); PG8_STAGE(PG8_SB(0, 1), b2 + hstep, voffB); PG8_STAGE(PG8_SA(0, 0), a2, voffA);
            PG8_WAIT_V(8); PG8_WAIT_L(0); PG8_BAR; PG8_MMA(1, 0, At, B0); PG8_MMA(1, 1, At, B1); PG8_BAR; PG8_SCHED;
            PG8_LDB(B0, 1, 0); PG8_LDB(B1, 1, 1); PG8_SCHED; PG8_LDA(At, 1, 0); PG8_STAGE(PG8_SA(0, 1), a2 + hstep, voffA);
            PG8_WAIT_V(8); PG8_WAIT_L(0); PG8_BAR; PG8_MMA(0, 0, At, B0); PG8_MMA(0, 1, At, B1); PG8_BAR; PG8_SCHED;
            PG8_LDA(At, 1, 1); PG8_STAGE(PG8_SB(1, 0), b3, voffB); PG8_STAGE(PG8_SB(1, 1), b3 + hstep, voffB); PG8_STAGE(PG8_SA(1, 0), a3, voffA);
            PG8_WAIT_V(8); PG8_WAIT_L(0); PG8_BAR; PG8_MMA(1, 0, At, B0); PG8_MMA(1, 1, At, B1); PG8_BAR; PG8_SCHED;
            } else {
            PG8_LDB(B0, 0, 0); PG8_SCHED; PG8_LDA(At, 0, 0); PG8_STAGE(PG8_SA(1, 1), a1 + hstep, voffA);
            PG8_WAIT_L(8); PG8_BAR; PG8_WAIT_L(0); PG8_MMA(0, 0, At, B0); PG8_BAR; PG8_SCHED;
            PG8_LDB(B1, 0, 1); PG8_STAGE(PG8_SB(0, 0), b2, voffB);
            PG8_BAR; PG8_WAIT_L(0); PG8_MMA(0, 1, At, B1); PG8_BAR;
            PG8_LDA(At, 0, 1); PG8_STAGE(PG8_SA(0, 0), a2, voffA);
            PG8_BAR; PG8_WAIT_L(0); PG8_MMA(1, 0, At, B0); PG8_BAR; PG8_SCHED;
            PG8_STAGE(PG8_SB(0, 1), b2 + hstep, voffB);
            PG8_WAIT_V(6); PG8_BAR; PG8_MMA(1, 1, At, B1); PG8_BAR;
            PG8_LDB(B0, 1, 0); PG8_SCHED; PG8_LDA(At, 1, 0); PG8_STAGE(PG8_SA(0, 1), a2 + hstep, voffA);
            PG8_WAIT_L(8); PG8_BAR; PG8_WAIT_L(0); PG8_MMA(0, 0, At, B0); PG8_BAR; PG8_SCHED;
            PG8_LDB(B1, 1, 1); PG8_STAGE(PG8_SB(1, 0), b3, voffB);
            PG8_BAR; PG8_WAIT_L(0); PG8_MMA(0, 1, At, B1); PG8_BAR;
            PG8_LDA(At, 1, 1); PG8_STAGE(PG8_SA(1, 0), a3, voffA);
            PG8_BAR; PG8_WAIT_L(0); PG8_MMA(1, 0, At, B0); PG8_BAR; PG8_SCHED;
            PG8_STAGE(PG8_SB(1, 1), b3 + hstep, voffB);
            PG8_WAIT_V(6); PG8_BAR; PG8_MMA(1, 1, At, B1); PG8_BAR;
            }
        }
        if constexpr (ALIGN_EPI) { if (wr == 0) PG8_BAR; }
        if constexpr (!Epi::AFTER_DRAIN) { int te_ = MK_TID; asm volatile("" : "+v"(te_));
            for (int er_ = 0; er_ < EPI_REP; ++er_) E(acc, cur, wr, wc, te_ & 15, (te_ >> 4) & 3); S.done(cur); }
        if (!has_next) break;
#pragma unroll
        for (int a = 0; a < 2; ++a)
#pragma unroll
            for (int b = 0; b < 2; ++b)
#pragma unroll
                for (int m = 0; m < 4; ++m)
#pragma unroll
                    for (int n = 0; n < 2; ++n) acc[a][b][m][n] = (f32x4){0.f, 0.f, 0.f, 0.f};
        cur = nxt; cA = nA; cB = nB; ++ui;
        if constexpr (ALIGN_EPI) { if (wr == 1) PG8_BAR; }
    }
    PG8_WAIT_V(0);
    if constexpr (!ALIGN_EPI) { if (wr == 0) PG8_BAR; }
    PG8_BAR;
    if constexpr (Epi::AFTER_DRAIN) { E.fused(acc, cur, wr, wc, fr, fq, lds, wid, lane); S.done(cur); }
#undef PG8_SA
#undef PG8_SB
#undef PG8_STAGE
#undef PG8_LDA
#undef PG8_LDB
#undef PG8_MMA
#undef PG8_WAIT_V
#undef PG8_WAIT_L
#undef PG8_BAR
#undef PG8_SCHED
}
}

#define LAS __attribute__((address_space(3)))
#define GAS __attribute__((address_space(1)))
typedef float f32x4 __attribute__((ext_vector_type(4)));
typedef unsigned u32x4 __attribute__((ext_vector_type(4)));
typedef unsigned u32x2 __attribute__((ext_vector_type(2)));
typedef short bf16x8 __attribute__((ext_vector_type(8)));
constexpr int NTHR = 512, NWAVES = 8;
constexpr int MK_LDS_BYTES = 163840;
constexpr int LDS_MISC_OFF = 163584;

__device__ __forceinline__ unsigned pk4_fp8(float a, float b, float c, float d) { unsigned w = 0u; w = __builtin_amdgcn_cvt_pk_fp8_f32(a, b, w, false); w = __builtin_amdgcn_cvt_pk_fp8_f32(c, d, w, true); return w; }
__device__ __forceinline__ unsigned cvt_pk_bf16(float lo, float hi) { unsigned r; asm volatile("v_cvt_pk_bf16_f32 %0, %1, %2" : "=v"(r) : "v"(lo), "v"(hi)); return r; }

struct EpiProj {
    static constexpr bool PERM = true, AFTER_DRAIN = false;
    bf16_t* O; int ldc; bf16_t* kcb; unsigned char* mg8;
    __device__ __forceinline__ void operator()(const pg8::f32x4 (&acc)[2][2][4][2], const pg8::Unit& u, int wr, int wc, int fr, int fq) const {
        const int row0 = u.pm * 256 + wr * 64 + fr, col0 = u.pn * 256 + wc * 32 + 8 * fq;
#pragma unroll
        for (int ai = 0; ai < 2; ++ai)
#pragma unroll
            for (int m = 0; m < 4; ++m) { bf16_t* rowp = O + (size_t)(row0 + ai * 128 + m * 16) * ldc + col0;
#pragma unroll
                for (int bj = 0; bj < 2; ++bj) { const pg8::f32x4 v0 = acc[ai][bj][m][0], v1 = acc[ai][bj][m][1];
                    u32x4 w; w.x = cvt_pk_bf16(v0[0], v0[1]); w.y = cvt_pk_bf16(v0[2], v0[3]); w.z = cvt_pk_bf16(v1[0], v1[1]); w.w = cvt_pk_bf16(v1[2], v1[3]);
                    if (u.pn >= 22 && u.pn <= 29) {
                        unsigned g0 = 0u, g1 = 0u;
                        g0 = __builtin_amdgcn_cvt_pk_u8_f32(255.f * sigmoidf_(v0[0]), 0, g0); g0 = __builtin_amdgcn_cvt_pk_u8_f32(255.f * sigmoidf_(v0[1]), 1, g0);
                        g0 = __builtin_amdgcn_cvt_pk_u8_f32(255.f * sigmoidf_(v0[2]), 2, g0); g0 = __builtin_amdgcn_cvt_pk_u8_f32(255.f * sigmoidf_(v0[3]), 3, g0);
                        g1 = __builtin_amdgcn_cvt_pk_u8_f32(255.f * sigmoidf_(v1[0]), 0, g1); g1 = __builtin_amdgcn_cvt_pk_u8_f32(255.f * sigmoidf_(v1[1]), 1, g1);
                        g1 = __builtin_amdgcn_cvt_pk_u8_f32(255.f * sigmoidf_(v1[2]), 2, g1); g1 = __builtin_amdgcn_cvt_pk_u8_f32(255.f * sigmoidf_(v1[3]), 3, g1);
                        u32x2 gw; gw.x = g0; gw.y = g1;
                        *(u32x2*)(mg8 + (size_t)(row0 + ai * 128 + m * 16) * 2048 + (u.pn - 22) * 256 + wc * 32 + 8 * fq + bj * 128) = gw; }
                    else if (u.pn >= 16 && u.pn <= 21) { const int row = row0 + ai * 128 + m * 16;
                        *(u32x4*)(kcb + ((((size_t)(u.pn - 16) * 4 + (row >> 12)) * 2 + bj) * 4096 + (row & 4095)) * 128 + wc * 32 + 8 * fq) = w; }
                    else *(u32x4*)(rowp + bj * 128) = w; } }
    }
};
__device__ __forceinline__ float bflo(unsigned w) { return __uint_as_float(w << 16); }
__device__ __forceinline__ float bfhi(unsigned w) { return __uint_as_float(w & 0xffff0000u); }
template <int STEP> struct EpiMerge {
    static constexpr bool PERM = true, AFTER_DRAIN = false;
    const unsigned char* mg8; bf16_t* T1; bf16_t* MG;
    __device__ __forceinline__ void operator()(const pg8::f32x4 (&acc)[2][2][4][2], const pg8::Unit& u, int wr, int wc, int fr, int fq) const {
        const int row0 = u.pm * 256 + wr * 64 + fr, col0 = u.pn * 256 + wc * 32 + 8 * fq;
#pragma unroll
        for (int ai = 0; ai < 2; ++ai)
#pragma unroll
            for (int m = 0; m < 4; ++m) { const size_t row = (size_t)(row0 + ai * 128 + m * 16);
#pragma unroll
                for (int bj = 0; bj < 2; ++bj) { const int col = col0 + bj * 128;
                    const u32x2 g = *(const u32x2*)(mg8 + row * 2048 + (STEP == 2 ? 1024 : 0) + col);
                    const pg8::f32x4 v0 = acc[ai][bj][m][0] * (1.f / 255.f), v1 = acc[ai][bj][m][1] * (1.f / 255.f);
                    float r[8];
                    r[0] = (float)((g.x >> 0) & 0xffu) * v0[0]; r[1] = (float)((g.x >> 8) & 0xffu) * v0[1]; r[2] = (float)((g.x >> 16) & 0xffu) * v0[2]; r[3] = (float)((g.x >> 24) & 0xffu) * v0[3];
                    r[4] = (float)((g.y >> 0) & 0xffu) * v1[0]; r[5] = (float)((g.y >> 8) & 0xffu) * v1[1]; r[6] = (float)((g.y >> 16) & 0xffu) * v1[2]; r[7] = (float)((g.y >> 24) & 0xffu) * v1[3];
                    if (STEP == 2) { const u32x4 t = *(const u32x4*)(T1 + row * DM + col);
                        r[0] += bflo(t.x); r[1] += bfhi(t.x); r[2] += bflo(t.y); r[3] += bfhi(t.y); r[4] += bflo(t.z); r[5] += bfhi(t.z); r[6] += bflo(t.w); r[7] += bfhi(t.w); }
                    u32x4 w; w.x = cvt_pk_bf16(r[0], r[1]); w.y = cvt_pk_bf16(r[2], r[3]); w.z = cvt_pk_bf16(r[4], r[5]); w.w = cvt_pk_bf16(r[6], r[7]);
                    *(u32x4*)((STEP == 2 ? MG : T1) + row * DM + col) = w; } }
    }
};
struct EpiOut {
    static constexpr bool PERM = false, AFTER_DRAIN = false;
    const float* x; const float* mod; bf16_t* h1;
    __device__ __forceinline__ void operator()(const pg8::f32x4 (&acc)[2][2][4][2], const pg8::Unit& u, int wr, int wc, int fr, int fq) const {
        const int row0 = u.pm * 256 + wr * 64 + fr, col0 = u.pn * 256 + wc * 32 + 4 * fq;
        const float* gate = mod + (u.pm * 256 / SEQ) * 6144 + 2048;
#pragma unroll
        for (int bj = 0; bj < 2; ++bj)
#pragma unroll
            for (int n = 0; n < 2; ++n) { const int col = col0 + bj * 128 + n * 16; const pg8::f32x4 gv = *(const pg8::f32x4*)(gate + col);
#pragma unroll
                for (int ai = 0; ai < 2; ++ai)
#pragma unroll
                    for (int m = 0; m < 4; ++m) { const size_t off = (size_t)(row0 + ai * 128 + m * 16) * DM + col;
                        const pg8::f32x4 xv = *(const pg8::f32x4*)(x + off); const pg8::f32x4 hv = xv + gv * acc[ai][bj][m][n];
                        u32x2 w; w.x = cvt_pk_bf16(hv[0], hv[1]); w.y = cvt_pk_bf16(hv[2], hv[3]); *(u32x2*)(h1 + off) = w; } }
    }
};
struct EpiSwiglu {
    static constexpr bool PERM = true, AFTER_DRAIN = false;
    const float* b1; bf16_t* act; const int* blk_e;
    __device__ __forceinline__ void operator()(const pg8::f32x4 (&acc)[2][2][4][2], const pg8::Unit& u, int wr, int wc, int fr, int fq) const {
        const int row0 = u.pm * 256 + wr * 64 + fr, col0 = u.pn * 128 + wc * 32 + 8 * fq;
        const int e_ = __builtin_amdgcn_readfirstlane(blk_e[u.pm]);
        const float* bg = b1 + e_ * 2048 + col0; const float* bu = bg + 1024;
        float gb[8], ub[8];
#pragma unroll
        for (int j = 0; j < 8; ++j) { gb[j] = bg[j]; ub[j] = bu[j]; }
#pragma unroll
        for (int ai = 0; ai < 2; ++ai)
#pragma unroll
            for (int m = 0; m < 4; ++m) { float r[8];
#pragma unroll
                for (int j = 0; j < 8; ++j) { float g = acc[ai][0][m][j >> 2][j & 3] + gb[j], uu = acc[ai][1][m][j >> 2][j & 3] + ub[j];
                    g = fminf(g, 7.f); uu = fminf(fmaxf(uu, -7.f), 7.f); r[j] = g * sigmoidf_(1.702f * g) * (uu + 1.f); }
                u32x2 w; w.x = pk4_fp8(r[0], r[1], r[2], r[3]); w.y = pk4_fp8(r[4], r[5], r[6], r[7]);
                *(u32x2*)((unsigned char*)act + (size_t)(row0 + ai * 128 + m * 16) * DM + col0) = w; }
    }
};
struct EpiMoe2 {
    static constexpr bool PERM = true, AFTER_DRAIN = false;
    const float* b2; bf16_t* ys; const int* blk_e;
    __device__ __forceinline__ void operator()(const pg8::f32x4 (&acc)[2][2][4][2], const pg8::Unit& u, int wr, int wc, int fr, int fq) const {
        const int row0 = u.pm * 256 + wr * 64 + fr, col0 = u.pn * 256 + wc * 32 + 8 * fq;
        const int e_ = __builtin_amdgcn_readfirstlane(blk_e[u.pm]);
#pragma unroll
        for (int bj = 0; bj < 2; ++bj) { const float* bb = b2 + e_ * 1024 + col0 + bj * 128; float bv[8];
#pragma unroll
            for (int j = 0; j < 8; ++j) bv[j] = bb[j];
#pragma unroll
            for (int ai = 0; ai < 2; ++ai)
#pragma unroll
                for (int m = 0; m < 4; ++m) { const pg8::f32x4 v0 = acc[ai][bj][m][0], v1 = acc[ai][bj][m][1];
                    u32x4 w; w.x = cvt_pk_bf16(v0[0] + bv[0], v0[1] + bv[1]); w.y = cvt_pk_bf16(v0[2] + bv[2], v0[3] + bv[3]); w.z = cvt_pk_bf16(v1[0] + bv[4], v1[1] + bv[5]); w.w = cvt_pk_bf16(v1[2] + bv[6], v1[3] + bv[7]);
                    *(u32x4*)(ys + (size_t)(row0 + ai * 128 + m * 16) * DM + col0 + bj * 128) = w; } }
    }
};
struct MoeOrder {
    int lo, n, nN, gsz, j; const int* blk_e; size_t estride;
    __device__ __forceinline__ MoeOrder(const int* ctl, int nN_, int G, int c, size_t es) { const int x = c & 7, nt = ctl[CT_PTOT] / 256; lo = (x * nt) >> 3; n = (((x + 1) * nt) >> 3) - lo; nN = nN_; gsz = (G - x + 7) >> 3; j = c >> 3; blk_e = ctl + CT_BLKE; estride = es; }
    __device__ __forceinline__ bool next(int i, pg8::Unit& u) const { const int L = i * gsz + j; if (L >= n * nN) return false; u.pm = lo + L / nN; u.pn = L % nN; u.e = blk_e[u.pm]; return true; }
    __device__ __forceinline__ void a_ready(const pg8::Unit&) const {}
    __device__ __forceinline__ void done(const pg8::Unit&) const {}
    __device__ __forceinline__ const char* abase(const pg8::Gemm& g, const pg8::Unit& u, size_t tstep) const { return (const char*)g.A + (size_t)u.pm * tstep; }
    __device__ __forceinline__ const char* bbase(const pg8::Gemm& g, const pg8::Unit& u, size_t tstep) const { return (const char*)g.Bt + (size_t)u.e * estride + (size_t)u.pn * tstep; }
};

constexpr int CW_BAR = 4096;
#define XB_TMO      128
#define XB_XCNT(j)  (256  + 64 * (j))
#define XB_XSUB(j)  (1280 + 64 * (j))
#define XB_XGEN(j)  (2304 + 64 * (j))
#define XB_TOP      3328
#define XB_TOPGEN   3392
#define XCD_BAR_WORDS 3456
#define XB_SPIN_CAP (1u << 18)
__device__ __forceinline__ unsigned xb_ld(unsigned* p)              { return __hip_atomic_load(p, __ATOMIC_RELAXED, __HIP_MEMORY_SCOPE_AGENT); }
__device__ __forceinline__ unsigned xb_add(unsigned* p, unsigned v) { return __hip_atomic_fetch_add(p, v, __ATOMIC_RELAXED, __HIP_MEMORY_SCOPE_AGENT); }
__device__ __forceinline__ unsigned xb_xcc_id() { return (unsigned)__builtin_amdgcn_s_getreg((3 << 11) | 20) & 0xFu; }
#define XB_SPIN(cond, bar) do { unsigned _sp = 0; while (cond) { __builtin_amdgcn_s_sleep(1); \
    if ((++_sp & 255u) == 0u) { if (xb_ld(&(bar)[XB_TMO])) break; if (_sp > XB_SPIN_CAP) { atomicAdd(&(bar)[XB_TMO], 1u); break; } } } } while (0)
struct XcdBarrier { unsigned* bar; unsigned x; volatile LAS unsigned* st; };
__device__ __forceinline__ XcdBarrier xcd_barrier_post(unsigned* bar, volatile LAS unsigned* st, int mk_wk) {
    XcdBarrier b; b.bar = bar; b.x = xb_xcc_id(); b.st = st;
    if (MK_TID == 0) (void)xb_add(&bar[XB_XCNT(b.x)], 1u);
    return b;
}
__device__ __forceinline__ void xcd_barrier_complete(unsigned* bar, unsigned x, unsigned& nloc, unsigned& nx) {
    const unsigned G = gridDim.x * gridDim.y * gridDim.z;
    unsigned sum, cnt, mine, sp = 0u;
    for (;;) {
        sum = 0u; cnt = 0u; mine = 0u;
#pragma unroll
        for (unsigned j = 0; j < 16; ++j) { const unsigned c = xb_ld(&bar[XB_XCNT(j)]); sum += c; cnt += (c > 0u) ? 1u : 0u; mine = (j == x) ? c : mine; }
        if (sum == G) break;
        __builtin_amdgcn_s_sleep(1);
        if ((++sp & 255u) == 0u) { if (xb_ld(&bar[XB_TMO])) break; if (sp > XB_SPIN_CAP) { atomicAdd(&bar[XB_TMO], 1u); break; } }
    }
    nloc = mine > 0u ? mine : 1u; nx = cnt > 0u ? cnt : 1u;
}
__device__ __forceinline__ void xcd_barrier(const XcdBarrier& b, int mk_wk) {
    asm volatile("s_waitcnt vmcnt(0)" ::: "memory");
    __syncthreads();
    if (MK_TID == 0) {
        unsigned* bar = b.bar;
        __builtin_amdgcn_s_waitcnt(0);
        unsigned nloc = b.st[0], nx = b.st[1];
        if (nloc == 0u) { xcd_barrier_complete(bar, b.x, nloc, nx); b.st[0] = nloc; b.st[1] = nx; }
        const unsigned old = xb_add(&bar[XB_XSUB(b.x)], 1u);
        const unsigned gen = old / nloc;
        if (old + 1u == (gen + 1u) * nloc) {
            __builtin_amdgcn_fence(__ATOMIC_RELEASE, "agent");
            asm volatile("s_waitcnt vmcnt(0)" ::: "memory");
            const unsigned og = xb_add(&bar[XB_TOP], 1u);
            const unsigned tg = og / nx;
            if (og + 1u == (tg + 1u) * nx) xb_add(&bar[XB_TOPGEN], 1u);
            else XB_SPIN(xb_ld(&bar[XB_TOPGEN]) == tg, bar);
            __builtin_amdgcn_fence(__ATOMIC_ACQUIRE, "agent");
            xb_add(&bar[XB_XGEN(b.x)], 1u);
            asm volatile("s_waitcnt vmcnt(0)" ::: "memory");
        } else {
            XB_SPIN(xb_ld(&bar[XB_XGEN(b.x)]) == gen, bar);
            __builtin_amdgcn_fence(__ATOMIC_ACQUIRE, "agent");
            asm volatile("s_waitcnt vmcnt(0)" ::: "memory");
        }
    }
    __syncthreads();
}

__device__ __forceinline__ void ph_mod(const P& p, LAS unsigned char* lds, int bid, int nblk, int mk_wk) {
    int tidx_ = MK_TID; asm volatile("" : "+v"(tidx_));
    LAS float* sc = (LAS float*)lds;
    LAS float* red = (LAS float*)(lds + 16384);
    const int tid = tidx_;
    for (int i = tid; i < 4096; i += NTHR) sc[i] = siluf_(p.c[i]);
    __syncthreads();
    for (int cb = bid; cb < 256; cb += nblk) {
        const int cq = tid % 6, kr = tid / 6;
        float acc[4][4];
#pragma unroll
        for (int b = 0; b < 4; ++b)
#pragma unroll
            for (int j = 0; j < 4; ++j) acc[b][j] = 0.f;
        if (kr < 85) {
            f32x4 w[13];
#pragma unroll
            for (int i = 0; i < 13; ++i) { const int k = kr + 85 * i; w[i] = (f32x4){0.f, 0.f, 0.f, 0.f}; if (k < 1024) w[i] = *(const f32x4*)(p.w_ada + (size_t)k * 6144 + cb * 24 + cq * 4); }
#pragma unroll
            for (int i = 0; i < 13; ++i) { const int k = kr + 85 * i;
                if (k < 1024) {
#pragma unroll
                    for (int b = 0; b < 4; ++b) { const float s = sc[b * 1024 + k]; acc[b][0] += s * w[i][0]; acc[b][1] += s * w[i][1]; acc[b][2] += s * w[i][2]; acc[b][3] += s * w[i][3]; } } }
        }
#pragma unroll
        for (int b = 0; b < 4; ++b)
#pragma unroll
            for (int j = 0; j < 4; ++j) red[tid * 16 + b * 4 + j] = acc[b][j];
        __syncthreads();
        if (tid < 96) {
            const int b = tid / 24, col = tid % 24, q = col >> 2, j = col & 3; float s = 0.f;
            for (int r = 0; r < 85; ++r) s += red[(r * 6 + q) * 16 + b * 4 + j];
            WSP(float, WS_MOD)[b * 6144 + cb * 24 + col] = s + p.b_ada[cb * 24 + col];
        }
        __syncthreads();
    }
}
struct ConvItem { const float* src; bf16_t* dst; int ldw, k0, n0, N, dK, mode, arg, fp8; };
__device__ __forceinline__ int conv_rowmap(int mode, int arg, int n) {
    if (mode == 1) { if (n < 3072) return n; if (n < 3088) return n + 4608; if (n < 5648) return n - 16; if (n < 5672) return n + 2048; return n - 40; }
    if (mode == 2) { const int h = n >> 10, r = n & 1023; return (r >> 7) * 256 + h * 128 + (r & 127); }
    return n + arg;
}
constexpr int CV_W1 = 32 * 128, CV_W2 = 32 * 64, CV_WIN = 16 * 31, CV_SQ = 16 * 4, CV_C1 = 2 * 2 * 32, CV_C2 = 2 * 4;
constexpr int CV_NITEMS = CV_WIN + 3 * CV_SQ + CV_W1 + CV_W2 + CV_C1 + CV_C2;
constexpr int CV_QN = CV_W1 + CV_W2;
__device__ __forceinline__ ConvItem conv_decode(const P& p, int it) {
    ConvItem c; int r = it; c.mode = 0; c.arg = 0; c.fp8 = 0;
    if (r < CV_W1) { const int e = r >> 7, t = r & 127; c.src = p.moe_w1 + (size_t)e * 1024 * 2048; c.ldw = 2048; c.k0 = (t >> 3) * 64; c.n0 = (t & 7) * 256; c.N = 2048; c.dst = (bf16_t*)(WSP(unsigned char, WS_W1T) + (size_t)e * 2048 * 1024); c.dK = 1024; c.mode = 2; c.fp8 = 1; return c; } r -= CV_W1;
    if (r < CV_W2) { const int e = r >> 6, t = r & 63; c.src = p.moe_w2 + (size_t)e * 1024 * 1024; c.ldw = 1024; c.k0 = (t >> 2) * 64; c.n0 = (t & 3) * 256; c.N = 1024; c.dst = (bf16_t*)(WSP(unsigned char, WS_W2T) + (size_t)e * 1024 * 1024); c.dK = 1024; c.fp8 = 1; return c; } r -= CV_W2;
    if (r < CV_WIN) { c.src = p.w_in; c.ldw = IN_COLS; c.k0 = (r / 31) * 64; c.n0 = (r % 31) * 256; c.N = IN_COLS; c.dst = WSP(bf16_t, WS_WINT); c.dK = 1024; c.mode = 1; return c; } r -= CV_WIN;
    if (r < 3 * CV_SQ) { const int w = r / CV_SQ, t = r % CV_SQ; c.src = w == 0 ? p.proj_gla : (w == 1 ? p.proj_nsa : p.w_out); c.ldw = 1024; c.k0 = (t >> 2) * 64; c.n0 = (t & 3) * 256; c.N = 1024;
        c.dst = WSP(bf16_t, w == 0 ? WS_PGLAT : (w == 1 ? WS_PNSAT : WS_WOUTT)); c.dK = 1024; return c; } r -= 3 * CV_SQ;
    if (r < CV_C1) { const int which = r >> 6, half = (r >> 5) & 1, kt = r & 31;
        c.src = p.cmp_w1 + ((size_t)which * 4096 + half * 2048) * 256; c.ldw = 256; c.k0 = kt * 64; c.n0 = 0; c.N = 256; c.dst = WSP(bf16_t, WS_CW1T) + (size_t)which * 512 * 2048; c.dK = 2048; c.arg = half * 256; return c; } r -= CV_C1;
    { const int which = r >> 2, kt = r & 3; c.src = p.cmp_w2 + (size_t)which * 256 * 128; c.ldw = 128; c.k0 = kt * 64; c.n0 = 0; c.N = 128; c.dst = WSP(bf16_t, WS_CW2T) + (size_t)which * 128 * 256; c.dK = 256; return c; }
}
__device__ __forceinline__ void conv_load(const ConvItem& c, f32x4 (&v)[8], int wid, int lane) {
#pragma unroll
    for (int r = 0; r < 8; ++r) { const int k = 8 * wid + r, n = 4 * lane;
        v[r] = (f32x4){0.f, 0.f, 0.f, 0.f};
        if (c.n0 + n < c.N) v[r] = *(const f32x4*)(c.src + (size_t)(c.k0 + k) * c.ldw + c.n0 + n); }
}
__device__ __forceinline__ void conv_store(const ConvItem& c, const f32x4 (&v)[8], LAS float* T, int tid, int wid, int lane) {
#pragma unroll
    for (int r = 0; r < 8; ++r) *(LAS f32x4*)(T + (8 * wid + r) * 260 + ((4 * lane) ^ (wid << 2))) = v[r];
    __syncthreads();
    const int cc = tid & 7;
#pragma unroll
    for (int pass = 0; pass < 4; ++pass) {
        const int n = (tid >> 3) + 64 * pass;
        if (c.n0 + n < c.N) {
            float f[8];
#pragma unroll
            for (int i = 0; i < 8; ++i) f[i] = T[(8 * cc + i) * 260 + (n ^ (cc << 2))];
            if (c.fp8) { u32x2 w8; w8.x = pk4_fp8(f[0] * 32.f, f[1] * 32.f, f[2] * 32.f, f[3] * 32.f); w8.y = pk4_fp8(f[4] * 32.f, f[5] * 32.f, f[6] * 32.f, f[7] * 32.f);
                *(u32x2*)((unsigned char*)c.dst + (size_t)conv_rowmap(c.mode, c.arg, c.n0 + n) * c.dK + c.k0 + 8 * cc) = w8; }
            else {
            u32x4 w; w.x = cvt_pk_bf16(f[0], f[1]); w.y = cvt_pk_bf16(f[2], f[3]); w.z = cvt_pk_bf16(f[4], f[5]); w.w = cvt_pk_bf16(f[6], f[7]);
            *(u32x4*)(c.dst + (size_t)conv_rowmap(c.mode, c.arg, c.n0 + n) * c.dK + c.k0 + 8 * cc) = w; }
        }
    }
    __syncthreads();
}
__device__ __forceinline__ void ph_convert(const P& p, LAS unsigned char* lds, int bid, int nblk, int mk_wk) {
    int tidx_ = MK_TID; asm volatile("" : "+v"(tidx_));
    const int tid = tidx_, wid = tid >> 6, lane = tid & 63;
    LAS float* T = (LAS float*)lds;
    if (bid == 0) {
        u32x4* z = (u32x4*)(WSP(bf16_t, WS_WINT) + (size_t)IN_COLS * 1024); const int n16 = (PLD - IN_COLS) * 1024 * 2 / 16;
        for (int i = tid; i < n16; i += NTHR) z[i] = (u32x4){0u, 0u, 0u, 0u};
    }
    f32x4 va[8], vb[8];
    int it = CV_QN + bid;
    if (it < CV_NITEMS) conv_load(conv_decode(p, it), va, wid, lane);
    while (it < CV_NITEMS) {
        const int itn = it + nblk;
        if (itn < CV_NITEMS) conv_load(conv_decode(p, itn), vb, wid, lane);
        conv_store(conv_decode(p, it), va, T, tid, wid, lane);
        if (itn >= CV_NITEMS) break;
        const int itn2 = itn + nblk;
        if (itn2 < CV_NITEMS) conv_load(conv_decode(p, itn2), va, wid, lane);
        conv_store(conv_decode(p, itn), vb, T, tid, wid, lane);
        it = itn2;
    }
}
#ifndef CV_QREP
#define CV_QREP 1
#define CVI(x) (x)
#else
#define CVI(x) ((x) % CV_QN)
#endif
constexpr int CV_QL = CV_QN * CV_QREP;
__device__ __forceinline__ void conv_drain(const P& p, LAS unsigned char* lds, volatile LAS unsigned* st, int mk_wk, const int lim) {
    int tidx_ = MK_TID; asm volatile("" : "+v"(tidx_));
    const int tid = tidx_, wid = tid >> 6, lane = tid & 63;
    LAS float* T = (LAS float*)lds;
    int* q = WSP(int, WS_CTL) + CT_CVQ;
    f32x4 va[8], vb[8];
    __syncthreads();
    if (tid == 0) st[2] = (unsigned)atomicAdd(q, 1);
    __syncthreads();
    int cur = (int)st[2];
    if (cur < CV_QL) conv_load(conv_decode(p, CVI(cur)), va, wid, lane);
    while (cur < CV_QL) {
        if (tid == 0) st[3] = (cur >= lim) ? (unsigned)CV_QL : (unsigned)atomicAdd(q, 1);
        __syncthreads();
        const int nxt = (int)st[3];
        if (nxt < CV_QL) conv_load(conv_decode(p, CVI(nxt)), vb, wid, lane);
        conv_store(conv_decode(p, CVI(cur)), va, T, tid, wid, lane);
        if (nxt >= CV_QL) break;
        if (tid == 0) st[2] = (nxt >= lim) ? (unsigned)CV_QL : (unsigned)atomicAdd(q, 1);
        __syncthreads();
        cur = (int)st[2];
        if (cur < CV_QL) conv_load(conv_decode(p, CVI(cur)), va, wid, lane);
        conv_store(conv_decode(p, CVI(nxt)), vb, T, tid, wid, lane);
    }
}
__device__ __forceinline__ void conv_take(const P& p, LAS unsigned char* lds, volatile LAS unsigned* st, int mk_wk, const int nmax) {
    int tidx_ = MK_TID; asm volatile("" : "+v"(tidx_));
    const int tid = tidx_, wid = tid >> 6, lane = tid & 63;
    LAS float* T = (LAS float*)lds;
    int* q = WSP(int, WS_CTL) + CT_CVQ;
    f32x4 va[8], vb[8];
    __syncthreads();
    if (tid == 0) st[2] = (unsigned)atomicAdd(q, 1);
    __syncthreads();
    int cur = (int)st[2], left = nmax - 1;
    if (cur < CV_QL) conv_load(conv_decode(p, CVI(cur)), va, wid, lane);
    while (cur < CV_QL) {
        if (tid == 0) st[3] = (left <= 0) ? (unsigned)CV_QL : (unsigned)atomicAdd(q, 1);
        __syncthreads();
        const int nxt = (int)st[3]; --left;
        if (nxt < CV_QL) conv_load(conv_decode(p, CVI(nxt)), vb, wid, lane);
        conv_store(conv_decode(p, CVI(cur)), va, T, tid, wid, lane);
        if (nxt >= CV_QL) break;
        if (tid == 0) st[2] = (left <= 0) ? (unsigned)CV_QL : (unsigned)atomicAdd(q, 1);
        __syncthreads();
        cur = (int)st[2]; --left;
        if (cur < CV_QL) conv_load(conv_decode(p, CVI(cur)), va, wid, lane);
        conv_store(conv_decode(p, CVI(nxt)), vb, T, tid, wid, lane);
    }
}
__device__ __forceinline__ void xcd_barrier_fill(const XcdBarrier& b, int mk_wk, const P& p, LAS unsigned char* lds) {
    asm volatile("s_waitcnt vmcnt(0)" ::: "memory");
    __syncthreads();
    int tidx_ = MK_TID; asm volatile("" : "+v"(tidx_));
    const int tid = tidx_, wid = tid >> 6, lane = tid & 63;
    int* q = WSP(int, WS_CTL) + CT_CVQ;
    unsigned gen = 0u; bool waiter = false;
    if (tid == 0) {
        unsigned* bar = b.bar;
        __builtin_amdgcn_s_waitcnt(0);
        unsigned nloc = b.st[0], nx = b.st[1];
        if (nloc == 0u) { xcd_barrier_complete(bar, b.x, nloc, nx); b.st[0] = nloc; b.st[1] = nx; }
        const unsigned old = xb_add(&bar[XB_XSUB(b.x)], 1u);
        gen = old / nloc;
        if (old + 1u == (gen + 1u) * nloc) {
            __builtin_amdgcn_fence(__ATOMIC_RELEASE, "agent");
            asm volatile("s_waitcnt vmcnt(0)" ::: "memory");
            const unsigned og = xb_add(&bar[XB_TOP], 1u);
            const unsigned tg = og / nx;
            if (og + 1u == (tg + 1u) * nx) xb_add(&bar[XB_TOPGEN], 1u);
            else XB_SPIN(xb_ld(&bar[XB_TOPGEN]) == tg, bar);
            __builtin_amdgcn_fence(__ATOMIC_ACQUIRE, "agent");
            xb_add(&bar[XB_XGEN(b.x)], 1u);
            asm volatile("s_waitcnt vmcnt(0)" ::: "memory");
            b.st[2] = (unsigned)CV_QL;
        } else {
            waiter = true;
            b.st[2] = (xb_ld(&bar[XB_XGEN(b.x)]) != gen) ? (unsigned)CV_QL : (unsigned)atomicAdd(q, 1);
        }
    }
    __syncthreads();
    int cur = (int)b.st[2];
    if (cur < CV_QL) {
        LAS float* T = (LAS float*)lds;
        f32x4 va[8], vb[8];
        conv_load(conv_decode(p, CVI(cur)), va, wid, lane);
        for (;;) {
            if (tid == 0) b.st[3] = (xb_ld(&b.bar[XB_XGEN(b.x)]) != gen) ? (unsigned)CV_QL : (unsigned)atomicAdd(q, 1);
            __syncthreads();
            const int nxt = (int)b.st[3];
            if (nxt < CV_QL) conv_load(conv_decode(p, CVI(nxt)), vb, wid, lane);
            conv_store(conv_decode(p, CVI(cur)), va, T, tid, wid, lane);
            if (nxt >= CV_QL) break;
            if (tid == 0) b.st[2] = (xb_ld(&b.bar[XB_XGEN(b.x)]) != gen) ? (unsigned)CV_QL : (unsigned)atomicAdd(q, 1);
            __syncthreads();
            cur = (int)b.st[2];
            if (cur < CV_QL) conv_load(conv_decode(p, CVI(cur)), va, wid, lane);
            conv_store(conv_decode(p, CVI(nxt)), vb, T, tid, wid, lane);
            if (cur >= CV_QL) break;
        }
    }
    if (tid == 0 && waiter) {
        XB_SPIN(xb_ld(&b.bar[XB_XGEN(b.x)]) == gen, b.bar);
        __builtin_amdgcn_fence(__ATOMIC_ACQUIRE, "agent");
        asm volatile("s_waitcnt vmcnt(0)" ::: "memory");
    }
    asm volatile("s_waitcnt vmcnt(0)" ::: "memory");
    __syncthreads();
}
__device__ __forceinline__ void ph_u1(const P& p, int bid, int nblk, int mk_wk) {
    int tidx_ = MK_TID; asm volatile("" : "+v"(tidx_));
    const int lane = tidx_ & 63, gw = bid * NWAVES + (tidx_ >> 6), NGW = nblk * NWAVES;
    for (int row = gw; row < NTOK; row += NGW) {
        const f32x4* xr = (const f32x4*)(p.x + (size_t)row * DM) + lane; const float* mod = WSP(float, WS_MOD) + (row / SEQ) * 6144;
        f32x4 v[4]; float ss = 0.f;
#pragma unroll
        for (int j = 0; j < 4; ++j) { v[j] = xr[64 * j]; ss += (v[j][0] * v[j][0] + v[j][1] * v[j][1]) + (v[j][2] * v[j][2] + v[j][3] * v[j][3]); }
        const float rstd = rsqrtf(wave_sum(ss) * (1.f / DM) + RMS_EPS);
        u32x2* o = (u32x2*)(WSP(bf16_t, WS_U1) + (size_t)row * DM) + lane;
#pragma unroll
        for (int j = 0; j < 4; ++j) { const int col = 4 * lane + 256 * j;
            const f32x4 g = *(const f32x4*)(p.norm1_g + col), sc = *(const f32x4*)(mod + 1024 + col), sh = *(const f32x4*)(mod + col);
            float r[4];
#pragma unroll
            for (int i = 0; i < 4; ++i) r[i] = v[j][i] * rstd * g[i] * (1.f + sc[i]) + sh[i];
            u32x2 w; w.x = cvt_pk_bf16(r[0], r[1]); w.y = cvt_pk_bf16(r[2], r[3]); o[64 * j] = w; }
    }
}

__device__ __forceinline__ void ph_ygla_naive(const P& p, int bid, int nblk, int mk_wk) {
    int tidx_ = MK_TID; asm volatile("" : "+v"(tidx_));
    const int lane = tidx_ & 63, gw = bid * NWAVES + (tidx_ >> 6), NGW = nblk * NWAVES;
    const f32x4 gn = *(const f32x4*)(p.gla_norm_g + 4 * lane);
    for (int w0 = gw * 4; w0 < NTOK * 4; w0 += NGW * 4) {
        f32x4 v[4]; u32x2 gr[4];
#pragma unroll
        for (int i = 0; i < 4; ++i) { const int w = w0 + i, row = w >> 2, h = w & 3;
            { const u32x2 ow = *(const u32x2*)(WSP(bf16_t, WS_OGLA) + (size_t)row * DM + h * 256 + 4 * lane); v[i] = (f32x4){bflo(ow.x), bfhi(ow.x), bflo(ow.y), bfhi(ow.y)}; }
            gr[i] = *(const u32x2*)(WSP(bf16_t, WS_PROJ) + (size_t)row * PLD + C_GR + h * 256 + 4 * lane); }
#pragma unroll
        for (int i = 0; i < 4; ++i) { const int w = w0 + i, row = w >> 2, h = w & 3;
            const float ss = (v[i][0] * v[i][0] + v[i][1] * v[i][1]) + (v[i][2] * v[i][2] + v[i][3] * v[i][3]);
            const float rstd = rsqrtf(wave_sum(ss) * (1.f / 256.f) + RMS_EPS);
            const float y0 = v[i][0] * rstd * gn[0] * siluf_(bflo(gr[i].x)), y1 = v[i][1] * rstd * gn[1] * siluf_(bfhi(gr[i].x));
            const float y2 = v[i][2] * rstd * gn[2] * siluf_(bflo(gr[i].y)), y3 = v[i][3] * rstd * gn[3] * siluf_(bfhi(gr[i].y));
            u32x2 o; o.x = cvt_pk_bf16(y0, y1); o.y = cvt_pk_bf16(y2, y3);
            *(u32x2*)(WSP(bf16_t, WS_YGLA) + (size_t)row * DM + h * 256 + 4 * lane) = o; }
    }
}
__device__ __forceinline__ void ph_route(const P& p, LAS unsigned char* lds, int bid, int nblk, int mk_wk, const bool count = true) {
    int tidx_ = MK_TID; asm volatile("" : "+v"(tidx_));
    const int wid = tidx_ >> 6, lane = tidx_ & 63, gw = bid * NWAVES + wid, NGW = nblk * NWAVES;
    LAS float* uu = (LAS float*)lds + wid * 4096;
    for (int row4 = gw * 4; row4 < NTOK; row4 += NGW * 4) {
        const float* mod = WSP(float, WS_MOD) + (row4 / SEQ) * 6144;
        f32x4 vall[4][4];
#pragma unroll
        for (int r = 0; r < 4; ++r)
#pragma unroll
            for (int j = 0; j < 4; ++j) { const u32x2 hw = ((const u32x2*)(WSP(bf16_t, WS_H1) + (size_t)(row4 + r) * DM) + lane)[64 * j]; vall[r][j] = (f32x4){bflo(hw.x), bfhi(hw.x), bflo(hw.y), bfhi(hw.y)}; }
        const int e = lane & 31, kh = lane >> 5;
        const float* rw = p.router_w + (size_t)kh * 512 * 32 + e;
        float wn[16];
#pragma unroll
        for (int i = 0; i < 16; ++i) wn[i] = rw[i * 32];
#pragma unroll
        for (int r = 0; r < 4; ++r) {
            f32x4 v[4]; float ss = 0.f;
#pragma unroll
            for (int j = 0; j < 4; ++j) { v[j] = vall[r][j]; ss += (v[j][0] * v[j][0] + v[j][1] * v[j][1]) + (v[j][2] * v[j][2] + v[j][3] * v[j][3]); }
            const float rstd = rsqrtf(wave_sum(ss) * (1.f / DM) + RMS_EPS);
            unsigned* uo = (unsigned*)(WSP(unsigned char, WS_U2) + (size_t)(row4 + r) * DM) + lane;
#pragma unroll
            for (int j = 0; j < 4; ++j) { const int col = 4 * lane + 256 * j;
                const f32x4 g = *(const f32x4*)(p.norm2_g + col), sc = *(const f32x4*)(mod + 4096 + col), sh = *(const f32x4*)(mod + 3072 + col);
                f32x4 o;
#pragma unroll
                for (int i = 0; i < 4; ++i) o[i] = v[j][i] * rstd * g[i] * (1.f + sc[i]) + sh[i];
                *(LAS f32x4*)(uu + r * 1024 + col) = o;
                uo[64 * j] = pk4_fp8(o[0], o[1], o[2], o[3]); }
        }
        __builtin_amdgcn_wave_barrier();
        float acc[4] = {0.f, 0.f, 0.f, 0.f};
        for (int k = 0; k < 512; k += 16) {
            float wc[16];
#pragma unroll
            for (int i = 0; i < 16; ++i) wc[i] = wn[i];
            if (k + 16 < 512) {
#pragma unroll
                for (int i = 0; i < 16; ++i) wn[i] = rw[(k + 16 + i) * 32];
            }
#pragma unroll
            for (int q = 0; q < 4; ++q)
#pragma unroll
                for (int r = 0; r < 4; ++r) { const f32x4 u = *(const LAS f32x4*)(uu + r * 1024 + kh * 512 + k + 4 * q); acc[r] += (u[0] * wc[4 * q] + u[1] * wc[4 * q + 1]) + (u[2] * wc[4 * q + 2] + u[3] * wc[4 * q + 3]); }
        }
        const float rb = p.router_b[e];
#pragma unroll
        for (int r = 0; r < 4; ++r) {
            const float logit = acc[r] + __shfl_xor(acc[r], 32) + rb;
            int rank = 0;
            for (int j = 0; j < 32; ++j) { const float lj = __shfl(logit, j); rank += (lj > logit) || (lj == logit && j < e); }
            const float mx = wave_max(logit);
            const bool sel = rank < 4;
            const float ex = sel ? __expf(logit - mx) : 0.f;
            float sum = ex; for (int o = 1; o < 32; o <<= 1) sum += __shfl_xor(sum, o);
            if (sel && lane < 32) {
                WSP(int, WS_TOPE)[(row4 + r) * 4 + rank] = e; WSP(float, WS_TOPW)[(row4 + r) * 4 + rank] = ex / sum;
                if (count) atomicAdd(WSP(int, WS_CTL) + CT_CNT + e, 1);
            }
        }
        __builtin_amdgcn_wave_barrier();
    }
}
__device__ __forceinline__ void ph_assign(const P& p, LAS unsigned char* lds, int bid, int nblk, int mk_wk) {
    int tidx_ = MK_TID; asm volatile("" : "+v"(tidx_));
    LAS int* pst = (LAS int*)lds;
    int* ctl = WSP(int, WS_CTL);
    if (tidx_ == 0) {
        int ps = 0;
        for (int e = 0; e < NEXP; ++e) { pst[e] = ps; const int nb = (ctl[CT_CNT + e] + MOEB - 1) / MOEB;
            if (bid == 0) for (int i = 0; i < nb; ++i) ctl[CT_BLKE + ps / MOEB + i] = e;
            ps += nb * MOEB; }
        pst[NEXP] = ps; if (bid == 0) ctl[CT_PTOT] = ps;
    }
    __syncthreads();
    const int wid = tidx_ >> 6, lane = tidx_ & 63, gw = bid * NWAVES + wid, NGW = nblk * NWAVES;
    for (int idx0 = gw * 32; idx0 < NTOK * 4; idx0 += NGW * 32) {
        int pos = 0;
        if (lane < 32) { const int e = WSP(int, WS_TOPE)[idx0 + lane]; pos = pst[e] + atomicAdd(ctl + CT_FILL + e, 1); WSP(int, WS_SLOTOF)[idx0 + lane] = pos; }
        u32x4 v[8];
#pragma unroll
        for (int t = 0; t < 8; ++t) v[t] = ((const u32x4*)(WSP(unsigned char, WS_U2) + (size_t)((idx0 >> 2) + t) * DM))[lane];
#pragma unroll
        for (int j = 0; j < 32; ++j) { const int pj = __shfl(pos, j); ((u32x4*)(WSP(unsigned char, WS_XS) + (size_t)pj * DM))[lane] = v[j >> 2]; }
    }
}
__device__ __forceinline__ void ph_final(const P& p, int bid, int nblk, int mk_wk) {
    int tidx_ = MK_TID; asm volatile("" : "+v"(tidx_));
    const int lane = tidx_ & 63, gw = bid * NWAVES + (tidx_ >> 6), NGW = nblk * NWAVES;
    for (int row = gw; row < NTOK; row += NGW) {
        const float* mod = WSP(float, WS_MOD) + (row / SEQ) * 6144 + 5120;
        const int* so = WSP(int, WS_SLOTOF) + row * 4; const float* tw = WSP(float, WS_TOPW) + row * 4;
        const bf16_t* ys = WSP(bf16_t, WS_YSLOT);
        const int s0 = so[0], s1 = so[1], s2 = so[2], s3 = so[3]; const float w0 = tw[0], w1 = tw[1], w2 = tw[2], w3 = tw[3];
        f32x4 v[4]; u32x2 y[4][4]; float ss = 0.f;
#pragma unroll
        for (int j = 0; j < 4; ++j) { const int col = 4 * lane + 256 * j;
            { const u32x2 hw = *(const u32x2*)(WSP(bf16_t, WS_H1) + (size_t)row * DM + col); v[j] = (f32x4){bflo(hw.x), bfhi(hw.x), bflo(hw.y), bfhi(hw.y)}; }
            y[j][0] = *(const u32x2*)(ys + (size_t)s0 * DM + col); y[j][1] = *(const u32x2*)(ys + (size_t)s1 * DM + col);
            y[j][2] = *(const u32x2*)(ys + (size_t)s2 * DM + col); y[j][3] = *(const u32x2*)(ys + (size_t)s3 * DM + col); }
#pragma unroll
        for (int j = 0; j < 4; ++j) { const int col = 4 * lane + 256 * j; const f32x4 g2 = *(const f32x4*)(mod + col);
            const float m0 = w0 * bflo(y[j][0].x) + w1 * bflo(y[j][1].x) + w2 * bflo(y[j][2].x) + w3 * bflo(y[j][3].x);
            const float m1 = w0 * bfhi(y[j][0].x) + w1 * bfhi(y[j][1].x) + w2 * bfhi(y[j][2].x) + w3 * bfhi(y[j][3].x);
            const float m2 = w0 * bflo(y[j][0].y) + w1 * bflo(y[j][1].y) + w2 * bflo(y[j][2].y) + w3 * bflo(y[j][3].y);
            const float m3 = w0 * bfhi(y[j][0].y) + w1 * bfhi(y[j][1].y) + w2 * bfhi(y[j][2].y) + w3 * bfhi(y[j][3].y);
            v[j][0] += g2[0] * m0; v[j][1] += g2[1] * m1; v[j][2] += g2[2] * m2; v[j][3] += g2[3] * m3;
            ss += (v[j][0] * v[j][0] + v[j][1] * v[j][1]) + (v[j][2] * v[j][2] + v[j][3] * v[j][3]); }
        const float rstd = rsqrtf(wave_sum(ss) * (1.f / DM) + RMS_EPS);
#pragma unroll
        for (int j = 0; j < 4; ++j) { const int col = 4 * lane + 256 * j; const f32x4 fg = *(const f32x4*)(p.final_g + col);
            f32x4 o; o[0] = v[j][0] * rstd * fg[0]; o[1] = v[j][1] * rstd * fg[1]; o[2] = v[j][2] * rstd * fg[2]; o[3] = v[j][3] * rstd * fg[3];
            *(f32x4*)(p.out + (size_t)row * DM + col) = o; }
    }
}

constexpr size_t WS_QE = 735 * MiB;
constexpr size_t WS_KDT = 751 * MiB;
constexpr size_t WS_AM = 767 * MiB;
constexpr size_t WS_DEC = 775 * MiB;
typedef short s16x4 __attribute__((ext_vector_type(4)));
__device__ __forceinline__ s16x4 lds_tr16(LAS const void* ptr) { return __builtin_bit_cast(s16x4, __builtin_amdgcn_ds_read_tr16_b64_v4i16((LAS s16x4*)ptr)); }
__device__ __forceinline__ bf16x8 cat8(s16x4 a, s16x4 b) { return (bf16x8){a[0], a[1], a[2], a[3], b[0], b[1], b[2], b[3]}; }

__device__ __forceinline__ void ph_gla_g1(const P& p, LAS unsigned char* lds, int bid, int nblk, int mk_wk) {
    int tidx_ = MK_TID; asm volatile("" : "+v"(tidx_));
    const int tid = tidx_, wid = tid >> 6, lane = tid & 63, fr = lane & 15, fq = lane >> 4;
    LAS float* gaL = (LAS float*)lds;
    LAS float* segL = (LAS float*)(lds + 4096);
    LAS bf16_t* qeL = (LAS bf16_t*)(lds + 8192);
    LAS bf16_t* keL = (LAS bf16_t*)(lds + 8192 + 17408);
    const bf16_t* proj = WSP(bf16_t, WS_PROJ);
    const int n_my = (nblk == 256) ? (bid < 128 ? 3 : 5) : ((1024 - bid + nblk - 1) / nblk);
    for (int ii = 0; ii < n_my; ++ii) {
        const int item = (nblk == 256) ? (bid < 128 ? bid * 3 + ii : 384 + (bid - 128) * 5 + ii) : (bid + ii * nblk);
        const int b = item >> 8, h = (item >> 6) & 3, n = item & 63;
        const size_t r0 = (size_t)b * SEQ + n * 64;
        if (tid < 128) { const int tok = tid >> 1, half = tid & 1;
            const u32x4 v = *(const u32x4*)(proj + (r0 + tok) * PLD + C_GA + half * 8);
            LAS float* d = gaL + tok * 16 + half * 8;
            d[0] = bflo(v.x); d[1] = bfhi(v.x); d[2] = bflo(v.y); d[3] = bfhi(v.y); d[4] = bflo(v.z); d[5] = bfhi(v.z); d[6] = bflo(v.w); d[7] = bfhi(v.w); }
        const int d = tid & 127, seg = tid >> 7;
        bf16_t qraw[16], kraw[16];
#pragma unroll
        for (int i = 0; i < 16; ++i) { const bf16_t* pr = proj + (r0 + seg * 16 + i) * PLD + h * 128 + d; qraw[i] = pr[C_GQ]; kraw[i] = pr[C_GK]; }
        __syncthreads();
        float w[16];
#pragma unroll
        for (int r = 0; r < 16; ++r) w[r] = p.gla_wa2[r * 512 + h * 128 + d];
        const float ba = p.gla_ba[h * 128 + d];
        float bc[16]; float run = 0.f;
#pragma unroll
        for (int i = 0; i < 16; ++i) {
            const LAS float* g = gaL + (seg * 16 + i) * 16; float xx = ba;
#pragma unroll
            for (int r = 0; r < 16; ++r) xx += g[r] * w[r];
            const float ls = fminf(xx, 0.f) - __logf(1.f + __expf(-fabsf(xx)));
            run += ls * (1.f / 16.f); bc[i] = run;
        }
        segL[seg * 128 + d] = run;
        __syncthreads();
        float off = 0.f, blast = 0.f;
#pragma unroll
        for (int s = 0; s < 4; ++s) { const float v = segL[s * 128 + d]; blast += v; if (s < seg) off += v; }
        bf16_t* QE = WSP(bf16_t, WS_QE) + (size_t)item * 8192; bf16_t* KDT = WSP(bf16_t, WS_KDT) + (size_t)item * 8192;
        float kd[16];
#pragma unroll
        for (int i = 0; i < 16; ++i) {
            const int tok = seg * 16 + i; const float bcv = bc[i] + off;
            const float q = bf2f(qraw[i]), k = bf2f(kraw[i]);
            const float e = __expf(bcv);
            const bf16_t qe = f2bf(q * 0.08838834764831845f * e), ke = f2bf(k * __expf(-bcv));
            kd[i] = k * __expf(blast - bcv);
            qeL[tok * 136 + d] = qe; keL[tok * 136 + d] = ke; QE[tok * 128 + d] = qe;
        }
        { u32x4 w0, w1; w0.x = cvt_pk_bf16(kd[0], kd[1]); w0.y = cvt_pk_bf16(kd[2], kd[3]); w0.z = cvt_pk_bf16(kd[4], kd[5]); w0.w = cvt_pk_bf16(kd[6], kd[7]);
          w1.x = cvt_pk_bf16(kd[8], kd[9]); w1.y = cvt_pk_bf16(kd[10], kd[11]); w1.z = cvt_pk_bf16(kd[12], kd[13]); w1.w = cvt_pk_bf16(kd[14], kd[15]);
          u32x4* dst = (u32x4*)(KDT + d * 64 + seg * 16); dst[0] = w0; dst[1] = w1; }
        if (seg == 0) WSP(float, WS_DEC)[(size_t)item * 128 + d] = __expf(blast);
        __syncthreads();
        bf16_t* AM = WSP(bf16_t, WS_AM) + (size_t)item * 4096;
#pragma unroll
        for (int tt = 0; tt < 2; ++tt) {
            const int id = wid * 2 + tt, ti = id >> 2, tj = id & 3;
            f32x4 acc = (f32x4){0.f, 0.f, 0.f, 0.f};
            if (tj <= ti) {
#pragma unroll
                for (int s = 0; s < 4; ++s) {
                    const bf16x8 af = *(const LAS bf16x8*)(qeL + (16 * ti + fr) * 136 + 32 * s + 8 * fq);
                    const bf16x8 bf = *(const LAS bf16x8*)(keL + (16 * tj + fr) * 136 + 32 * s + 8 * fq);
                    acc = __builtin_amdgcn_mfma_f32_16x16x32_bf16(af, bf, acc, 0, 0, 0);
                }
            }
            const int j = 16 * tj + fr;
#pragma unroll
            for (int r = 0; r < 4; ++r) { const int i = 16 * ti + 4 * fq + r; AM[i * 64 + j] = f2bf(j <= i ? acc[r] : 0.f); }
        }
        __syncthreads();
    }
}

struct G2Ops { bf16x8 kdt[2], am[2], qe[4]; f32x4 dec; u32x2 v; };
template <bool A>
__device__ __forceinline__ void g2_load(G2Ops& op, const P& p, int item, size_t vrow0, int vcol, int wid, int fr, int fq, int tid) {
    const bf16_t* KDT = WSP(bf16_t, WS_KDT) + (size_t)item * 8192; const bf16_t* AMp = WSP(bf16_t, WS_AM) + (size_t)item * 4096; const bf16_t* QE = WSP(bf16_t, WS_QE) + (size_t)item * 8192;
#pragma unroll
    for (int s = 0; s < 2; ++s) op.kdt[s] = *(const bf16x8*)(KDT + (16 * wid + fr) * 64 + 32 * s + 8 * fq);
    if (A) {
#pragma unroll
        for (int s = 0; s < 2; ++s) op.am[s] = *(const bf16x8*)(AMp + (16 * wid + fr) * 64 + 32 * s + 8 * fq);
#pragma unroll
        for (int s = 0; s < 4; ++s) op.qe[s] = *(const bf16x8*)(QE + (16 * wid + fr) * 128 + 32 * s + 8 * fq);
        op.v = *(const u32x2*)(WSP(bf16_t, WS_PROJ) + (vrow0 + (tid >> 2)) * PLD + vcol + (tid & 3) * 4);
    }
    op.dec = *(const f32x4*)(WSP(float, WS_DEC) + (size_t)item * 128 + 16 * wid + 4 * fq);
}
#define G2_BAR() do { asm volatile("s_waitcnt lgkmcnt(0)" ::: "memory"); __builtin_amdgcn_s_barrier(); asm volatile("" ::: "memory"); } while (0)
template <bool A>
__device__ __forceinline__ void g2_step(const G2Ops& op, f32x4& S, LAS bf16_t* Vb, LAS const bf16_t* ST  , LAS bf16_t* STn  , bf16_t* og, int wid, int lane, int fr, int fq, int tid) {
    if (A) *(LAS u32x2*)(Vb + (tid >> 2) * 16 + (tid & 3) * 4) = op.v;
    G2_BAR();
    bf16x8 vb[2];
#pragma unroll
    for (int ks = 0; ks < 2; ++ks) {
        const int q = (lane & 15) >> 2, pp = lane & 3;
        const s16x4 lo = lds_tr16(Vb + (32 * ks + 8 * fq + q) * 16 + 4 * pp);
        const s16x4 hi = lds_tr16(Vb + (32 * ks + 8 * fq + 4 + q) * 16 + 4 * pp);
        vb[ks] = cat8(lo, hi);
    }
    f32x4 cs = (f32x4){0.f, 0.f, 0.f, 0.f};
    cs = __builtin_amdgcn_mfma_f32_16x16x32_bf16(op.kdt[0], vb[0], cs, 0, 0, 0);
    cs = __builtin_amdgcn_mfma_f32_16x16x32_bf16(op.kdt[1], vb[1], cs, 0, 0, 0);
    if (A) {
        f32x4 o = (f32x4){0.f, 0.f, 0.f, 0.f};
        o = __builtin_amdgcn_mfma_f32_16x16x32_bf16(op.am[0], vb[0], o, 0, 0, 0);
        o = __builtin_amdgcn_mfma_f32_16x16x32_bf16(op.am[1], vb[1], o, 0, 0, 0);
#pragma unroll
        for (int s = 0; s < 4; ++s) { const bf16x8 sb = *(const LAS bf16x8*)(ST + fr * 136 + 32 * s + 8 * fq); o = __builtin_amdgcn_mfma_f32_16x16x32_bf16(op.qe[s], sb, o, 0, 0, 0); }
#pragma unroll
        for (int r = 0; r < 4; ++r) og[(size_t)r * DM] = f2bf(o[r]);
    }
    S = op.dec * S + cs;
    { u32x2 w; w.x = cvt_pk_bf16(S[0], S[1]); w.y = cvt_pk_bf16(S[2], S[3]); *(LAS u32x2*)(STn + fr * 136 + 16 * wid + 4 * fq) = w; }
}
template <bool A>
__device__ __forceinline__ void g2_run(const P& p, LAS unsigned char* lds, int bid, int nblk, int tid, int wid) {
    const int lane = tid & 63, fr = lane & 15, fq = lane >> 4;
    LAS bf16_t* VL = (LAS bf16_t*)lds;
    LAS bf16_t* ST = (LAS bf16_t*)(lds + 4096);
    for (int it = bid; it < 256; it += nblk) {
        const int bh = (it & 7) + 8 * ((it >> 3) & 1), slice = it >> 4, b = bh >> 2, h = bh & 3;
        for (int i = tid; i < 16 * 136 / 2; i += NTHR) ((LAS unsigned*)ST)[i] = 0u;
        f32x4 S = (f32x4){0.f, 0.f, 0.f, 0.f};
        const int item0 = (b * 4 + h) * 64;
        const size_t r0 = (size_t)b * SEQ;
        const int vcol = C_GV + h * 256 + slice * 16;
        bf16_t* og0 = WSP(bf16_t, WS_OGLA) + (r0 + 16 * wid + 4 * fq) * DM + h * 256 + slice * 16 + fr;
        G2Ops opA = {}, opB = {}, opC = {}, opD = {};
        g2_load<A>(opA, p, item0, r0, vcol, wid, fr, fq, tid);
        g2_load<A>(opB, p, item0 + 1, r0 + 64, vcol, wid, fr, fq, tid);
        g2_load<A>(opC, p, item0 + 2, r0 + 128, vcol, wid, fr, fq, tid);
        g2_load<A>(opD, p, item0 + 3, r0 + 192, vcol, wid, fr, fq, tid);
#pragma unroll 1
        for (int n = 0; n < 64; n += 4) {
            const int n4 = n + 4 < 64 ? n + 4 : 60;
            g2_step<A>(opA, S, VL, ST, ST + 16 * 136, og0 + (size_t)n * 64 * DM, wid, lane, fr, fq, tid);
            g2_load<A>(opA, p, item0 + n4, r0 + (size_t)n4 * 64, vcol, wid, fr, fq, tid);
            g2_step<A>(opB, S, VL + 1024, ST + 16 * 136, ST, og0 + (size_t)(n + 1) * 64 * DM, wid, lane, fr, fq, tid);
            g2_load<A>(opB, p, item0 + n4 + 1, r0 + (size_t)(n4 + 1) * 64, vcol, wid, fr, fq, tid);
            g2_step<A>(opC, S, VL, ST, ST + 16 * 136, og0 + (size_t)(n + 2) * 64 * DM, wid, lane, fr, fq, tid);
            g2_load<A>(opC, p, item0 + n4 + 2, r0 + (size_t)(n4 + 2) * 64, vcol, wid, fr, fq, tid);
            g2_step<A>(opD, S, VL + 1024, ST + 16 * 136, ST, og0 + (size_t)(n + 3) * 64 * DM, wid, lane, fr, fq, tid);
            g2_load<A>(opD, p, item0 + n4 + 3, r0 + (size_t)(n4 + 3) * 64, vcol, wid, fr, fq, tid);
        }
        __syncthreads();
    }
}
__device__ __forceinline__ void ph_gla_g2(const P& p, LAS unsigned char* lds, int bid, int nblk, int mk_wk) {
    int tidx_ = MK_TID; asm volatile("" : "+v"(tidx_));
    const int tid = tidx_, wid = __builtin_amdgcn_readfirstlane(tid >> 6);
    if (wid < 4) g2_run<true>(p, lds, bid, nblk, tid, wid); else g2_run<false>(p, lds, bid, nblk, tid, wid);
}
constexpr size_t WS_KCB = 864 * MiB;
constexpr size_t WS_SLAB = 824 * MiB;
constexpr size_t WS_CB1 = 856 * MiB;
struct CmpOrder {
    int G, c;
    __device__ __forceinline__ bool next(int i, pg8::Unit& u) const { const int L = i * G + c; if (L >= 128) return false; u.pm = (L >> 1) & 7; u.pn = L & 1; u.e = L >> 4; return true; }
    __device__ __forceinline__ void a_ready(const pg8::Unit&) const {}
    __device__ __forceinline__ void done(const pg8::Unit&) const {}
    __device__ __forceinline__ const char* abase(const pg8::Gemm& g, const pg8::Unit& u, size_t tstep) const { return (const char*)g.A + (size_t)(u.e >> 2) * 2048 * 2048 * 2 + (size_t)u.pm * tstep + (size_t)(u.e & 3) * 1024; }
    __device__ __forceinline__ const char* bbase(const pg8::Gemm& g, const pg8::Unit& u, size_t tstep) const { return (const char*)g.Bt + (size_t)(u.e >> 2) * 512 * 2048 * 2 + (size_t)u.pn * tstep + (size_t)(u.e & 3) * 1024; }
};
struct EpiSlab {
    static constexpr bool PERM = false, AFTER_DRAIN = false;
    float* slab;
    __device__ __forceinline__ void operator()(const pg8::f32x4 (&acc)[2][2][4][2], const pg8::Unit& u, int wr, int wc, int fr, int fq) const {
        const int row0 = u.pm * 256 + wr * 64 + fr, col0 = u.pn * 256 + wc * 32 + 4 * fq;
        float* base = slab + ((size_t)(u.e & 3) * 2 + (u.e >> 2)) * 2048 * 512;
#pragma unroll
        for (int ai = 0; ai < 2; ++ai)
#pragma unroll
            for (int m = 0; m < 4; ++m)
#pragma unroll
                for (int bj = 0; bj < 2; ++bj)
#pragma unroll
                    for (int n = 0; n < 2; ++n) *(pg8::f32x4*)(base + (size_t)(row0 + ai * 128 + m * 16) * 512 + col0 + bj * 128 + n * 16) = acc[ai][bj][m][n];
    }
};
constexpr size_t WS_CB1P = 857 * MiB;
__device__ __forceinline__ void ph_cmp_bias(const P& p, int bid, int nblk, int mk_wk) {
    int tidx_ = MK_TID; asm volatile("" : "+v"(tidx_));
    const int lane = tidx_ & 63, wv = tidx_ >> 6;
    for (int it = bid + nblk * wv; it < 512; it += nblk * NWAVES) {
        const int ks = it >> 3, which = (it >> 2) & 1, ng = it & 3, n = ng * 64 + lane;
        const float* pe = p.cmp_pe + which * 4096 + ks * 64; const float* w1 = p.cmp_w1 + ((size_t)which * 4096 + ks * 64) * 256 + n;
        float a0 = 0.f, a1 = 0.f, a2 = 0.f, a3 = 0.f;
#pragma unroll
        for (int k0 = 0; k0 < 64; k0 += 32) {
            float wv_[32];
#pragma unroll
            for (int k = 0; k < 32; ++k) wv_[k] = w1[(size_t)(k0 + k) * 256];
#pragma unroll
            for (int k = 0; k < 32; k += 4) { a0 += pe[k0 + k] * wv_[k]; a1 += pe[k0 + k + 1] * wv_[k + 1]; a2 += pe[k0 + k + 2] * wv_[k + 2]; a3 += pe[k0 + k + 3] * wv_[k + 3]; }
        }
        WSP(float, WS_CB1P)[ks * 512 + which * 256 + n] = (a0 + a1) + (a2 + a3);
    }
}
__device__ __forceinline__ void ph_cmp_bias2(const P& p, int bid, int mk_wk) {
    if (bid != 0) return;
    const int t = MK_TID;
    float s = 0.f;
    for (int ks = 0; ks < 64; ++ks) s += WSP(float, WS_CB1P)[ks * 512 + t];
    WSP(float, WS_CB1)[t] = s;
}
__device__ __forceinline__ void ph_cmp_fin(const P& p, LAS unsigned char* lds, int bid, int nblk, int mk_wk) {
    int tidx_ = MK_TID; asm volatile("" : "+v"(tidx_));
    const int tid = tidx_, wid = __builtin_amdgcn_readfirstlane(tid >> 6), lane = tid & 63, fr = lane & 15, fq = lane >> 4;
    LAS bf16_t* hidL = (LAS bf16_t*)lds;
    for (int it = bid; it < 256; it += nblk) {
        const int which = it >> 7, bg = (it >> 4) & 7, cb = it & 15;
        const float* slab = WSP(float, WS_SLAB);
        const int n = tid & 255;
        float bias1 = 0.f;
#pragma unroll 16
        for (int ks = 0; ks < 64; ++ks) bias1 += WSP(float, WS_CB1P)[ks * 512 + which * 256 + n];
#pragma unroll
        for (int i = 0; i < 8; ++i) {
            const int r = (tid >> 8) + 2 * i, c = cb * 16 + r;
            const size_t rowA = (size_t)bg * 256 + c, rowB = c < 255 ? rowA + 1 : rowA;
            float v = bias1;
#pragma unroll
            for (int s = 0; s < 4; ++s) { const float* sl = slab + ((size_t)s * 2 + which) * 2048 * 512; v += sl[rowA * 512 + n] + sl[rowB * 512 + 256 + n]; }
            hidL[r * 264 + n] = f2bf(gelu_tanh(v));
        }
        __syncthreads();
        const bf16_t* w2t = WSP(bf16_t, WS_CW2T) + (size_t)which * 128 * 256 + (size_t)(16 * wid + fr) * 256 + 8 * fq;
        f32x4 acc = (f32x4){0.f, 0.f, 0.f, 0.f};
#pragma unroll
        for (int s = 0; s < 8; ++s) {
            const bf16x8 bf = *(const bf16x8*)(w2t + 32 * s);
            const bf16x8 af = *(const LAS bf16x8*)(hidL + fr * 264 + 32 * s + 8 * fq);
            acc = __builtin_amdgcn_mfma_f32_16x16x32_bf16(af, bf, acc, 0, 0, 0);
        }
        bf16_t* out = WSP(bf16_t, WS_KCVC) + (((size_t)which * 8 + bg) * 256) * 128 + 16 * wid + fr;
#pragma unroll
        for (int r = 0; r < 4; ++r) { const int c = cb * 16 + 4 * fq + r; out[(size_t)c * 128] = c < 255 ? f2bf(acc[r]) : (bf16_t)0; }
        __syncthreads();
    }
}
#ifndef REP_SEL
#define REP_SEL 1
#endif
constexpr size_t WS_NSCR = 776 * MiB;
typedef float f32x16 __attribute__((ext_vector_type(16)));
constexpr int NSA_KV0 = 0, NSA_IMP = 131072, NSA_MASK = 147456, NSA_UNI = 147968, NSA_WSF = 148480;
constexpr float NSA_NEG = -1e30f;
__device__ __forceinline__ unsigned offb(unsigned row, unsigned ch) { return 2048u * (row >> 3) + 512u * (ch >> 2) + 64u * (row & 7u) + 16u * ((ch & 3u) ^ ((row >> 2) & 3u)); }
__device__ __forceinline__ int crow16(int r, int hi) { return (r & 3) + 8 * (r >> 2) + 4 * hi; }
struct TileRegs { u32x4 k[2], v[2]; };
template <bool LOADV>
__device__ __forceinline__ void nsa_tile_load(TileRegs& R, const bf16_t* kb, const bf16_t* vb, size_t pitch) {
    unsigned tx = threadIdx.x; asm volatile("" : "+v"(tx));
#pragma unroll
    for (int i = 0; i < 2; ++i) { const int c = tx + NTHR * i, row = c >> 4, ch = c & 15;
        R.k[i] = *(const u32x4*)(kb + (size_t)row * pitch + ch * 8);
        if (LOADV) R.v[i] = *(const u32x4*)(vb + (size_t)row * pitch + ch * 8); }
}
template <bool LOADV>
__device__ __forceinline__ void nsa_tile_store(const TileRegs& R, LAS unsigned char* buf) {
#pragma unroll
    for (int i = 0; i < 2; ++i) { const int c = threadIdx.x + NTHR * i, row = c >> 4, ch = c & 15;
        *(LAS u32x4*)(buf + offb(row, ch)) = R.k[i];
        if (LOADV) *(LAS u32x4*)(buf + 16384 + offb(row, ch)) = R.v[i]; }
}
template <bool LOADV>
__device__ __forceinline__ void nsa_tile_glds(LAS unsigned char* buf, const bf16_t* kb, const bf16_t* vb, size_t pitch, int wid, int mk_wk) {
    unsigned ln = MK_TID & 63u; asm volatile("" : "+v"(ln));
#pragma unroll
    for (int i = 0; i < 2; ++i) {
        const unsigned X = (unsigned)(wid * 1024 + i * 8192) + ln * 16u;
        const unsigned row = ((X >> 11) << 3) | ((X >> 6) & 7u), ch = (((X >> 9) & 3u) << 2) | (((X >> 4) & 3u) ^ ((row >> 2) & 3u));
        __builtin_amdgcn_global_load_lds((const unsigned*)(kb + (size_t)row * pitch + ch * 8), (LAS unsigned*)(buf + wid * 1024 + i * 8192), 16, 0, 0);
        if (LOADV) __builtin_amdgcn_global_load_lds((const unsigned*)(vb + (size_t)row * pitch + ch * 8), (LAS unsigned*)(buf + 16384 + wid * 1024 + i * 8192), 16, 0, 0);
    }
}
#define NSA_SYNC() do { asm volatile("s_waitcnt vmcnt(0)" ::: "memory"); __syncthreads(); } while (0)
#define NSA_RING_WAIT(more, NL) do { if (more) { if ((NL) == 4) asm volatile("s_waitcnt vmcnt(4)" ::: "memory"); else asm volatile("s_waitcnt vmcnt(2)" ::: "memory"); } \
    else asm volatile("s_waitcnt vmcnt(0)" ::: "memory"); asm volatile("s_waitcnt lgkmcnt(0)" ::: "memory"); __builtin_amdgcn_s_barrier(); asm volatile("" ::: "memory"); } while (0)
#define NSA_BUF(i) (lds + NSA_KV0 + ((i) & 3) * 32768)
struct NsaCtx {
    int lane, q32, hi, tl6, tb, ncv; LAS const unsigned* maskw; float invl;
    LAS float* wsf; LAS float* impW;
    int probe; unsigned kb0, vb0;
};
#define NSA_LWAIT(N) do { asm volatile("s_waitcnt lgkmcnt(" #N ")" ::: "memory"); __builtin_amdgcn_sched_barrier(0); } while (0)
template <int MODE>
__device__ __forceinline__ void nsa_tile(LAS const unsigned char* Kt, const bf16x8 (&qr)[8], f32x16 (&o)[4], float& m, float& lp, const NsaCtx& cx, int j  , const bool premask  ) {
    const int q32 = cx.q32, hi = cx.hi;
    f32x16 p0, p1;
#pragma unroll
    for (int r = 0; r < 16; ++r) { p0[r] = 0.f; p1[r] = 0.f; }
    {
        const unsigned ka0 = (unsigned)(size_t)Kt + cx.kb0, ka1 = (unsigned)(size_t)Kt + (cx.kb0 ^ 32u);
#define NSA_KRD(dst, addr, off) asm volatile("ds_read_b128 %0, %1 offset:%c2" : "=&v"(dst) : "v"(addr), "i"(off) : "memory")
        bf16x8 ka[2][2], kb[2][2];
        NSA_KRD(ka[0][0], ka0, 0); NSA_KRD(ka[0][1], ka0, 8192); NSA_KRD(ka[1][0], ka1, 0); NSA_KRD(ka[1][1], ka1, 8192);
        NSA_KRD(kb[0][0], ka0, 512); NSA_KRD(kb[0][1], ka0, 8704); NSA_KRD(kb[1][0], ka1, 512); NSA_KRD(kb[1][1], ka1, 8704);
        NSA_LWAIT(4);
#pragma unroll
        for (int s = 0; s < 2; ++s) { p0 = __builtin_amdgcn_mfma_f32_32x32x16_bf16(ka[s][0], qr[s], p0, 0, 0, 0); p1 = __builtin_amdgcn_mfma_f32_32x32x16_bf16(ka[s][1], qr[s], p1, 0, 0, 0); }
        __builtin_amdgcn_sched_barrier(0);
        NSA_KRD(ka[0][0], ka0, 1024); NSA_KRD(ka[0][1], ka0, 9216); NSA_KRD(ka[1][0], ka1, 1024); NSA_KRD(ka[1][1], ka1, 9216);
        NSA_LWAIT(4);
#pragma unroll
        for (int s = 0; s < 2; ++s) { p0 = __builtin_amdgcn_mfma_f32_32x32x16_bf16(kb[s][0], qr[2 + s], p0, 0, 0, 0); p1 = __builtin_amdgcn_mfma_f32_32x32x16_bf16(kb[s][1], qr[2 + s], p1, 0, 0, 0); }
        __builtin_amdgcn_sched_barrier(0);
        NSA_KRD(kb[0][0], ka0, 1536); NSA_KRD(kb[0][1], ka0, 9728); NSA_KRD(kb[1][0], ka1, 1536); NSA_KRD(kb[1][1], ka1, 9728);
        NSA_LWAIT(4);
#pragma unroll
        for (int s = 0; s < 2; ++s) { p0 = __builtin_amdgcn_mfma_f32_32x32x16_bf16(ka[s][0], qr[4 + s], p0, 0, 0, 0); p1 = __builtin_amdgcn_mfma_f32_32x32x16_bf16(ka[s][1], qr[4 + s], p1, 0, 0, 0); }
        NSA_LWAIT(0);
#pragma unroll
        for (int s = 0; s < 2; ++s) { p0 = __builtin_amdgcn_mfma_f32_32x32x16_bf16(kb[s][0], qr[6 + s], p0, 0, 0, 0); p1 = __builtin_amdgcn_mfma_f32_32x32x16_bf16(kb[s][1], qr[6 + s], p1, 0, 0, 0); }
#undef NSA_KRD
    }
    const float SC = 0.08838834764831845f * 1.4426950408889634f;
    if (MODE <= 1 || premask) {
#pragma unroll
        for (int r = 0; r < 16; ++r) {
            const int kk0 = crow16(r, hi), kk1 = kk0 + 32;
            bool v0, v1;
            if (MODE <= 1) { v0 = (64 * j + kk0) < cx.ncv; v1 = (64 * j + kk1) < cx.ncv; }
            else if (MODE == 2) { v0 = (j < cx.tb || kk0 <= cx.tl6); v1 = (j < cx.tb || kk1 <= cx.tl6); }
            else { v0 = (j != cx.tb || kk0 <= cx.tl6) && (j != cx.tb - 8 || kk0 > cx.tl6); v1 = (j != cx.tb || kk1 <= cx.tl6) && (j != cx.tb - 8 || kk1 > cx.tl6); }
            p0[r] = v0 ? p0[r] : -INFINITY; p1[r] = v1 ? p1[r] : -INFINITY;
        }
    }
    if (MODE != 1) {
        const bool rowvalid = (MODE == 2) ? (((cx.maskw[(j >> 5)] >> (j & 31)) & 1u) != 0u) : true;
        float ta = __builtin_fmaxf(__builtin_fmaxf(p0[0], p0[1]), p1[0]), tb_ = __builtin_fmaxf(__builtin_fmaxf(p0[2], p0[3]), p1[1]);
        ta = __builtin_fmaxf(__builtin_fmaxf(ta, p1[2]), p1[3]);
#pragma unroll
        for (int r = 4; r < 16; r += 4) { ta = __builtin_fmaxf(__builtin_fmaxf(ta, p0[r]), p0[r + 1]); tb_ = __builtin_fmaxf(__builtin_fmaxf(tb_, p0[r + 2]), p0[r + 3]);
            ta = __builtin_fmaxf(__builtin_fmaxf(ta, p1[r]), p1[r + 1]); tb_ = __builtin_fmaxf(__builtin_fmaxf(tb_, p1[r + 2]), p1[r + 3]); }
        float tmax = __builtin_fmaxf(ta, tb_);
        tmax = __builtin_fmaxf(tmax, __shfl_xor(tmax, 32));
        const float m_cand = rowvalid ? __builtin_fmaxf(m, tmax * SC) : m;
        const float m_new = (m_cand > m + 8.f) ? m_cand : m;
        const float alpha = __builtin_amdgcn_exp2f(m - m_new);
        m = m_new;
        const float nb = rowvalid ? -m_new : -INFINITY;
        float ps0 = 0.f, ps1 = 0.f;
#pragma unroll
        for (int r = 0; r < 16; ++r) { p0[r] = __builtin_amdgcn_exp2f(__builtin_fmaf(p0[r], SC, nb)); p1[r] = __builtin_amdgcn_exp2f(__builtin_fmaf(p1[r], SC, nb)); ps0 += p0[r]; ps1 += p1[r]; }
        lp = lp * alpha + (ps0 + ps1);
        if (MODE != 0) {
            if (__any(alpha != 1.f)) {
                if (hi == 0) cx.wsf[q32] = alpha;
                __builtin_amdgcn_wave_barrier();
#pragma unroll
                for (int r = 0; r < 16; ++r) { const float a = cx.wsf[crow16(r, hi)];
#pragma unroll
                    for (int c = 0; c < 4; ++c) o[c][r] *= a; }
                __builtin_amdgcn_wave_barrier();
            }
        }
    } else {
        const float nb = -m;
#pragma unroll
        for (int r = 0; r < 16; ++r) { p0[r] = __builtin_amdgcn_exp2f(__builtin_fmaf(p0[r], SC, nb)) * cx.invl; p1[r] = __builtin_amdgcn_exp2f(__builtin_fmaf(p1[r], SC, nb)) * cx.invl; }
#pragma unroll
        for (int kb2 = 0; kb2 < 2; ++kb2)
#pragma unroll
            for (int gq = 0; gq < 4; ++gq) {
                float s4, e1;
                if (kb2 == 0) { e1 = p0[4 * gq + 3]; s4 = (p0[4 * gq] + p0[4 * gq + 1]) + (p0[4 * gq + 2] + e1); }
                else { e1 = p1[4 * gq + 3]; s4 = (p1[4 * gq] + p1[4 * gq + 1]) + (p1[4 * gq + 2] + e1); }
                s4 += __shfl_xor(s4, 1); s4 += __shfl_xor(s4, 2); e1 += __shfl_xor(e1, 1); e1 += __shfl_xor(e1, 2);
                const int sblk = (64 * j + 32 * kb2 + 8 * gq + 4 * hi) >> 2;
                LAS float* impRow = cx.impW + (q32 >> 2) * 64;
                if ((q32 & 3) == 0) { __hip_atomic_fetch_add(impRow + sblk, s4, __ATOMIC_RELAXED, __HIP_MEMORY_SCOPE_WORKGROUP); if (sblk + 1 < 64) __hip_atomic_fetch_add(impRow + sblk + 1, e1, __ATOMIC_RELAXED, __HIP_MEMORY_SCOPE_WORKGROUP); }
            }
    }
    if (MODE != 0) {
        LAS const unsigned char* Vt = Kt + 16384;
        const unsigned va0 = (unsigned)(size_t)Vt + cx.vb0, va1 = (unsigned)(size_t)Vt + (cx.vb0 ^ 32u);
#define NSA_TRR(dst, addr, off) asm volatile("ds_read_b64_tr_b16 %0, %1 offset:%c2" : "=&v"(dst) : "v"(addr), "i"(off) : "memory")
#define NSA_VREADS(L, H, ks) do { NSA_TRR(L[0], va0, 4096 * (ks)); NSA_TRR(H[0], va1, 4096 * (ks) + 2048); NSA_TRR(L[1], va0, 4096 * (ks) + 512); NSA_TRR(H[1], va1, 4096 * (ks) + 2560); \
        NSA_TRR(L[2], va0, 4096 * (ks) + 1024); NSA_TRR(H[2], va1, 4096 * (ks) + 3072); NSA_TRR(L[3], va0, 4096 * (ks) + 1536); NSA_TRR(H[3], va1, 4096 * (ks) + 3584); } while (0)
#define NSA_PVMMA(L, H, ks) do { _Pragma("unroll") for (int c = 0; c < 4; ++c) o[c] = __builtin_amdgcn_mfma_f32_32x32x16_bf16(__builtin_bit_cast(bf16x8, pw[ks]), cat8(L[c], H[c]), o[c], 0, 0, 0); } while (0)
        s16x4 la[4], ha[4], lb[4], hb[4];
        u32x4 pw[4];
        pw[0] = (u32x4){cvt_pk_bf16(p0[0], p0[1]), cvt_pk_bf16(p0[2], p0[3]), cvt_pk_bf16(p0[4], p0[5]), cvt_pk_bf16(p0[6], p0[7])};
        pw[1] = (u32x4){cvt_pk_bf16(p0[8], p0[9]), cvt_pk_bf16(p0[10], p0[11]), cvt_pk_bf16(p0[12], p0[13]), cvt_pk_bf16(p0[14], p0[15])};
        pw[2] = (u32x4){cvt_pk_bf16(p1[0], p1[1]), cvt_pk_bf16(p1[2], p1[3]), cvt_pk_bf16(p1[4], p1[5]), cvt_pk_bf16(p1[6], p1[7])};
        pw[3] = (u32x4){cvt_pk_bf16(p1[8], p1[9]), cvt_pk_bf16(p1[10], p1[11]), cvt_pk_bf16(p1[12], p1[13]), cvt_pk_bf16(p1[14], p1[15])};
        NSA_VREADS(la, ha, 0); NSA_VREADS(lb, hb, 1);
        NSA_LWAIT(8);
        NSA_PVMMA(la, ha, 0);
        __builtin_amdgcn_sched_barrier(0);
        NSA_VREADS(la, ha, 2);
        NSA_LWAIT(8);
        NSA_PVMMA(lb, hb, 1);
        __builtin_amdgcn_sched_barrier(0);
        NSA_VREADS(lb, hb, 3);
        NSA_LWAIT(8);
        NSA_PVMMA(la, ha, 2);
        NSA_LWAIT(0);
        NSA_PVMMA(lb, hb, 3);
#undef NSA_TRR
#undef NSA_VREADS
#undef NSA_PVMMA
    }
}
template <int STAGE  >
__device__ __forceinline__ void nsa_flush(const f32x16 (&o)[4], float sc, const NsaCtx& cx, float* scr, bf16_t* yrow0  ) {
    if (cx.hi == 0) cx.wsf[cx.q32] = sc;
    __builtin_amdgcn_wave_barrier();
    unsigned lofs = (unsigned)cx.lane, yofs = (unsigned)(cx.hi * 1024 + cx.q32);
    asm volatile("" : "+v"(lofs), "+v"(yofs));
    f32x4* sp0 = (f32x4*)scr + lofs; bf16_t* yp0 = yrow0 + yofs;
    f32x4 acc[16];
    if (STAGE >= 1) {
#pragma unroll
        for (int i = 0; i < 16; ++i) acc[i] = sp0[i * 64];
    }
#pragma unroll
    for (int c = 0; c < 4; ++c)
#pragma unroll
        for (int v = 0; v < 4; ++v) {
            f32x4 t;
#pragma unroll
            for (int e = 0; e < 4; ++e) t[e] = o[c][4 * v + e] * cx.wsf[crow16(4 * v + e, cx.hi)];
            if (STAGE >= 1) t += acc[c * 4 + v];
            if (STAGE <= 1) sp0[(c * 4 + v) * 64] = t;
            else {
#pragma unroll
                for (int e = 0; e < 4; ++e) { const int r = 4 * v + e; yp0[(2 * (r >> 2)) * DM + (r & 3) * 128 + 32 * c] = f2bf(t[e]); }
            }
        }
    __builtin_amdgcn_wave_barrier();
}
__device__ __forceinline__ void ph_nsa(const P& p, LAS unsigned char* lds, int bid, int nblk, int mk_wk) {
    int tidx_ = MK_TID; asm volatile("" : "+v"(tidx_));
    const int tid = tidx_, wid = __builtin_amdgcn_readfirstlane(tid >> 6), lane = tid & 63;
    const bf16_t* proj = WSP(bf16_t, WS_PROJ);
    LAS float* impL = (LAS float*)(lds + NSA_IMP);
    LAS unsigned* maskL = (LAS unsigned*)(lds + NSA_MASK);
    LAS unsigned* uniL = (LAS unsigned*)(lds + NSA_UNI);
    NsaCtx cx; cx.probe = 0; cx.lane = lane; cx.q32 = lane & 31; cx.hi = lane >> 5; cx.wsf = (LAS float*)(lds + NSA_WSF) + wid * 256;
    float* scr = WSP(float, WS_NSCR) + (size_t)bid * 32768 + wid * 4096;
    { const unsigned q32 = cx.q32, hi = cx.hi, blk = (lane >> 4) & 1, qq = (lane & 15) >> 2, pq = lane & 3;
      cx.kb0 = 2048u * (q32 >> 3) + 64u * (q32 & 7u) + 16u * ((0u + hi) ^ ((q32 >> 2) & 3u));
      cx.vb0 = 64u * (4u * hi + qq) + 16u * ((2u * blk + (pq >> 1)) ^ ((0u + hi) & 3u)) + 8u * (pq & 1u); }
    for (int k2 = 0; k2 < 2; ++k2) {
        for (int ub = bid; ub < 256; ub += nblk) {
            const int idx = k2 == 0 ? ub : 511 - ub;
            const int tb = 63 - (idx >> 3), bg = idx & 7, b = bg >> 1, g = bg & 1;
            const int tokw = 64 * tb + 8 * wid;
            const int t = tokw + (cx.q32 >> 2), hq = 4 * g + (cx.q32 & 3);
            const size_t rowq = (size_t)b * SEQ + t;
            cx.tb = tb; cx.tl6 = t & 63; cx.ncv = t >= 31 ? (t - 31) / 16 + 1 : 0;
            cx.impW = impL + 8 * wid * 64;
            { unsigned tz = (unsigned)cx.lane + 64u * (unsigned)wid; asm volatile("" : "+v"(tz));
              for (unsigned i = tz; i < 4096u; i += NTHR) impL[i] = 0.f; }
            bf16x8 qr[8];
#pragma unroll
            for (int s = 0; s < 8; ++s) qr[s] = *(const bf16x8*)(proj + rowq * PLD + C_NQ + hq * 128 + 16 * s + 8 * cx.hi);
            const bf16_t* gp = proj + rowq * PLD + C_NG + hq * 3;
            if (cx.hi == 0) { cx.wsf[64 + cx.q32] = sigmoidf_(bf2f(gp[0])); cx.wsf[96 + cx.q32] = sigmoidf_(bf2f(gp[1])); cx.wsf[128 + cx.q32] = sigmoidf_(bf2f(gp[2])); }
            bf16_t* yrow0 = WSP(bf16_t, WS_YNSA) + ((size_t)b * SEQ + tokw) * DM + 4 * g * 128;
            f32x16 o[4]; float m, lp;
#define NSA_RESET() do { _Pragma("unroll") for (int c_ = 0; c_ < 4; ++c_) _Pragma("unroll") for (int r_ = 0; r_ < 16; ++r_) o[c_][r_] = 0.f; m = NSA_NEG; lp = 0.f; } while (0)
            const int ntc = (4 * tb + 3 + 63) >> 6;
            const bf16_t* kc = WSP(bf16_t, WS_KCVC) + (((size_t)0 * 4 + b) * 2 + g) * 256 * 128;
            const bf16_t* vc = WSP(bf16_t, WS_KCVC) + (((size_t)1 * 4 + b) * 2 + g) * 256 * 128;
            NSA_RESET();
            __syncthreads();
            nsa_tile_glds<false>(NSA_BUF(0), kc, vc, 128, wid, mk_wk); if (ntc > 1) nsa_tile_glds<false>(NSA_BUF(1), kc + (size_t)64 * 128, vc, 128, wid, mk_wk);
            for (int i = 0; i < ntc; ++i) {
                NSA_RING_WAIT(i + 1 < ntc, 2);
                if (i + 2 < ntc) nsa_tile_glds<false>(NSA_BUF(i + 2), kc + (size_t)(i + 2) * 64 * 128, vc, 128, wid, mk_wk);
                nsa_tile<0>(NSA_BUF(i), qr, o, m, lp, cx, i, true);
            }
            NSA_SYNC();
            { const float lt = lp + __shfl_xor(lp, 32); cx.invl = lt > 0.f ? 1.f / lt : 0.f; }
            nsa_tile_glds<true>(NSA_BUF(0), kc, vc, 128, wid, mk_wk); if (ntc > 1) nsa_tile_glds<true>(NSA_BUF(1), kc + (size_t)64 * 128, vc + (size_t)64 * 128, 128, wid, mk_wk);
            for (int i = 0; i < ntc; ++i) {
                NSA_RING_WAIT(i + 1 < ntc, 4);
                if (i + 2 < ntc) nsa_tile_glds<true>(NSA_BUF(i + 2), kc + (size_t)(i + 2) * 64 * 128, vc + (size_t)(i + 2) * 64 * 128, 128, wid, mk_wk);
                nsa_tile<1>(NSA_BUF(i), qr, o, m, lp, cx, i, true);
            }
            NSA_SYNC();
            nsa_flush<0>(o, cx.wsf[64 + cx.q32], cx, scr, yrow0);
            unsigned ulo = 0u, uhi = 0u;
            int lane_s = cx.lane; asm volatile("" : "+v"(lane_s));
            {
                unsigned key[8], T[8];
                const int tbb = tokw >> 6, s = lane_s;
                const bool forced = (s == 0) || (s == tbb) || (s == tbb - 1), valid = s <= tbb;
#pragma unroll
                for (int tl = 0; tl < 8; ++tl) {
                    const float imp = impL[(8 * wid + tl) * 64 + s];
                    const float score = forced ? INFINITY : (valid ? imp : -INFINITY);
                    const unsigned u = __float_as_uint(score);
                    key[tl] = u ^ ((u >> 31) ? 0xFFFFFFFFu : 0x80000000u);
                    T[tl] = 0u;
                }
#pragma unroll 2
                for (int b = 31; b >= 0; --b) {
#pragma unroll
                    for (int tl = 0; tl < 8; ++tl) { const unsigned cand = T[tl] | (1u << b); T[tl] = (__popcll(__ballot(key[tl] >= cand)) >= 16) ? cand : T[tl]; }
                }
#pragma unroll
                for (int tl = 0; tl < 8; ++tl) {
                    const u64 gt = __ballot(key[tl] > T[tl]); u64 eq = __ballot(key[tl] == T[tl]);
                    int r = 16 - (int)__popcll(gt);
                    u64 sel = gt;
                    if ((int)__popcll(eq) <= r) sel |= eq;
                    else { for (; r > 0; --r) { const u64 lowb = eq & (0ull - eq); sel |= lowb; eq ^= lowb; } }
                    const u64 mk = sel & __ballot(key[tl] > 0x007FFFFFu);
                    if (lane_s == 0) { maskL[(8 * wid + tl) * 2] = (unsigned)mk; maskL[(8 * wid + tl) * 2 + 1] = (unsigned)(mk >> 32); }
                    ulo |= (unsigned)mk; uhi |= (unsigned)(mk >> 32);
                }
            }
            if (lane_s == 0) { uniL[wid * 2] = ulo; uniL[wid * 2 + 1] = uhi; }
            const u64 wmask = ((u64)(unsigned)__builtin_amdgcn_readfirstlane(ulo)) | (((u64)(unsigned)__builtin_amdgcn_readfirstlane(uhi)) << 32);
            __syncthreads();
            cx.maskw = maskL + (8 * wid + (cx.q32 >> 2)) * 2;
            u64 um = 0ull;
#pragma unroll
            for (int w8 = 0; w8 < 8; ++w8) um |= (u64)uniL[w8 * 2] | ((u64)uniL[w8 * 2 + 1] << 32);
            um = ((u64)(unsigned)__builtin_amdgcn_readfirstlane((unsigned)um)) | ((u64)(unsigned)__builtin_amdgcn_readfirstlane((unsigned)(um >> 32)) << 32);
            um &= (tb >= 63) ? ~0ull : ((1ull << (tb + 1)) - 1ull);
            NSA_RESET();
            {
                const bf16_t* kbase = WSP(bf16_t, WS_KCB) + (((size_t)2 * 4 + b) * 2 + g) * 4096 * 128; const bf16_t* vbase = WSP(bf16_t, WS_KCB) + (((size_t)3 * 4 + b) * 2 + g) * 4096 * 128;
#define NSA_POP(r_) (__ffsll((long long)(r_)) - 1)
                u64 rem = um; int ja = NSA_POP(rem); rem &= rem - 1;
                int jb = -1; if (rem) { jb = NSA_POP(rem); rem &= rem - 1; }
                nsa_tile_glds<true>(NSA_BUF(0), kbase + (size_t)ja * 64 * 128, vbase + (size_t)ja * 64 * 128, 128, wid, mk_wk);
                if (jb >= 0) nsa_tile_glds<true>(NSA_BUF(1), kbase + (size_t)jb * 64 * 128, vbase + (size_t)jb * 64 * 128, 128, wid, mk_wk);
                for (int i = 0;; i += 2) {
                    NSA_SYNC();
                    int jc = -1, jd = -1;
                    if (rem) { jc = NSA_POP(rem); rem &= rem - 1; nsa_tile_glds<true>(NSA_BUF(i + 2), kbase + (size_t)jc * 64 * 128, vbase + (size_t)jc * 64 * 128, 128, wid, mk_wk);
                        if (rem) { jd = NSA_POP(rem); rem &= rem - 1; nsa_tile_glds<true>(NSA_BUF(i + 3), kbase + (size_t)jd * 64 * 128, vbase + (size_t)jd * 64 * 128, 128, wid, mk_wk); } }
                    if ((wmask >> ja) & 1ull) nsa_tile<2>(NSA_BUF(i), qr, o, m, lp, cx, ja, ja >= tb);
                    if (jb >= 0 && ((wmask >> jb) & 1ull)) nsa_tile<2>(NSA_BUF(i + 1), qr, o, m, lp, cx, jb, jb >= tb);
                    if (jc < 0) break;
                    ja = jc; jb = jd;
                }
                NSA_SYNC();
#undef NSA_POP
                cx.probe = 0;
                const float lt = lp + __shfl_xor(lp, 32);
                nsa_flush<1>(o, lt > 0.f ? cx.wsf[96 + cx.q32] / lt : 0.f, cx, scr, yrow0);
            }
            NSA_RESET();
            {
                const bf16_t* kbase = WSP(bf16_t, WS_KCB) + (((size_t)4 * 4 + b) * 2 + g) * 4096 * 128; const bf16_t* vbase = WSP(bf16_t, WS_KCB) + (((size_t)5 * 4 + b) * 2 + g) * 4096 * 128;
                const int j0 = tb >= 8 ? tb - 8 : 0, nt = tb - j0 + 1;
                nsa_tile_glds<true>(NSA_BUF(0), kbase + (size_t)j0 * 64 * 128, vbase + (size_t)j0 * 64 * 128, 128, wid, mk_wk);
                if (nt > 1) nsa_tile_glds<true>(NSA_BUF(1), kbase + (size_t)(j0 + 1) * 64 * 128, vbase + (size_t)(j0 + 1) * 64 * 128, 128, wid, mk_wk);
                for (int i = 0; i < nt; i += 2) {
                    NSA_SYNC();
                    if (i + 2 < nt) nsa_tile_glds<true>(NSA_BUF(i + 2), kbase + (size_t)(j0 + i + 2) * 64 * 128, vbase + (size_t)(j0 + i + 2) * 64 * 128, 128, wid, mk_wk);
                    if (i + 3 < nt) nsa_tile_glds<true>(NSA_BUF(i + 3), kbase + (size_t)(j0 + i + 3) * 64 * 128, vbase + (size_t)(j0 + i + 3) * 64 * 128, 128, wid, mk_wk);
                    nsa_tile<3>(NSA_BUF(i), qr, o, m, lp, cx, j0 + i, (j0 + i == tb) || (j0 + i == tb - 8));
                    if (i + 1 < nt) nsa_tile<3>(NSA_BUF(i + 1), qr, o, m, lp, cx, j0 + i + 1, (j0 + i + 1 == tb) || (j0 + i + 1 == tb - 8));
                }
                NSA_SYNC();
                const float lt = lp + __shfl_xor(lp, 32);
                nsa_flush<2>(o, lt > 0.f ? cx.wsf[128 + cx.q32] / lt : 0.f, cx, scr, yrow0);
            }
#undef NSA_RESET
        }
    }
}
#ifndef REP_U1
#define REP_U1 1
#endif
#ifndef REP_ROUTE
#define REP_ROUTE 1
#endif
#ifndef REP_P0
#define REP_P0 1
#endif
#ifndef REP_INPROJ
#define REP_INPROJ 1
#endif
#ifndef REP_G3
#define REP_G3 1
#endif
#ifndef REP_G4
#define REP_G4 1
#endif
#ifndef REP_NSA
#define REP_NSA 1
#endif
#ifndef REP_MERGE
#define REP_MERGE 1
#endif
#ifndef REP_OUT
#define REP_OUT 1
#endif
#ifndef REP_MOE1
#define REP_MOE1 1
#endif
#ifndef REP_MOE2
#define REP_MOE2 1
#endif
#ifndef REP_FINAL
#define REP_FINAL 1
#endif
#ifndef FILL_AT
#define FILL_AT(k) ((k) < PH_ASSIGN)
#endif
enum { PH_MOD = 0, PH_U1, PH_INPROJ, PH_G3, PH_G4, PH_NSA, PH_MERGE, PH_OUT, PH_ROUTE, PH_ASSIGN, PH_MOE1, PH_MOE2, PH_FINAL, PH_END };
struct Args { P p; int ph_lo, ph_hi; };
__global__ void __launch_bounds__(NTHR, 2) mega(Args a) {
    extern __shared__ __attribute__((aligned(16))) unsigned char lds_raw[];
    LAS unsigned char* lds = (LAS unsigned char*)lds_raw;
    const P& p = a.p;
    const int mk_wk = __builtin_amdgcn_readfirstlane((int)threadIdx.x >> 6);
    const int bid = blockIdx.x, nblk = gridDim.x;
    volatile LAS unsigned* MISC = (volatile LAS unsigned*)(lds + LDS_MISC_OFF);
    for (int u = MK_TID; u < (MK_LDS_BYTES - LDS_MISC_OFF) / 4; u += NTHR) ((LAS unsigned*)(lds + LDS_MISC_OFF))[u] = 0u;
    __syncthreads();
    const bool multi = (a.ph_hi - a.ph_lo) > 1;
    XcdBarrier bar; bar.bar = WSP(unsigned, WS_CTL) + CW_BAR; bar.x = 0; bar.st = nullptr;
    if (multi) bar = xcd_barrier_post(WSP(unsigned, WS_CTL) + CW_BAR, MISC + 8, mk_wk);
#define IN(k) (a.ph_lo <= (k) && (k) < a.ph_hi)
#ifdef TS_A
#define SEAM(k) do { if (IN(k) && IN((k) + 1)) xcd_barrier(bar, mk_wk); if (bid == 0 && MK_TID == 0) ((unsigned long long*)(WSP(int, WS_CTL) + 2048))[(k) + 1] = __builtin_amdgcn_s_memrealtime(); } while (0)
#else
#define SEAM(k) do { if (IN(k) && IN((k) + 1)) { if (FILL_AT(k)) xcd_barrier_fill(bar, mk_wk, p, lds); else xcd_barrier(bar, mk_wk); } } while (0)
#endif
    for (int rep_ = 0; rep_ < REP_P0; ++rep_)
#ifdef TS_A
    if (bid == 0 && MK_TID == 0) ((unsigned long long*)(WSP(int, WS_CTL) + 2048))[0] = __builtin_amdgcn_s_memrealtime();
#endif
    if (IN(PH_MOD)) { ph_cmp_bias(p, bid, nblk, mk_wk); ph_mod(p, lds, bid, nblk, mk_wk); ph_convert(p, lds, bid, nblk, mk_wk); }
    SEAM(PH_MOD);
    for (int rep_ = 0; rep_ < REP_U1; ++rep_)
    if (IN(PH_U1)) ph_u1(p, bid, nblk, mk_wk);
    SEAM(PH_U1);
#ifdef PROBE_BARRIERS
    for (int xb_ = 0; xb_ < 20; ++xb_) xcd_barrier(bar, mk_wk);
#endif
    for (int rep_ = 0; rep_ < REP_INPROJ; ++rep_)
    if (IN(PH_INPROJ)) {
        if (((bid >> 3) & 1) != 0) conv_take(p, lds, MISC + 8, mk_wk, 3);
        pg8::Gemm g{WSP(bf16_t, WS_U1), WSP(bf16_t, WS_WINT), NTOK, PLD, 1024, 1024}; pg8::StaticOrder S; S.init(NTOK, PLD, nblk, bid);
        EpiProj E{WSP(bf16_t, WS_PROJ), PLD, WSP(bf16_t, WS_KCB), WSP(unsigned char, WS_MG8)};
        pg8::gemm_phase<EpiProj, pg8::StaticOrder, true, true>(lds, g, S, E, mk_wk);
    }
    SEAM(PH_INPROJ);
    for (int rep_ = 0; rep_ < REP_G3; ++rep_)
    if (IN(PH_G3)) {
        ph_gla_g1(p, lds, bid, nblk, mk_wk);
        { pg8::Gemm g{WSP(bf16_t, WS_KCB), WSP(bf16_t, WS_CW1T), 2048, 512, 512, 2048}; CmpOrder S{nblk, bid}; EpiSlab E{WSP(float, WS_SLAB)};
          pg8::gemm_phase<EpiSlab, CmpOrder, true, true>(lds, g, S, E, mk_wk); }
    }
    SEAM(PH_G3);
    for (int rep_ = 0; rep_ < REP_G4; ++rep_)
    if (IN(PH_G4)) {
        ph_cmp_fin(p, lds, bid, nblk, mk_wk);
        ph_gla_g2(p, lds, bid, nblk, mk_wk);
    }
    SEAM(PH_G4);
    for (int rep_ = 0; rep_ < REP_NSA; ++rep_)
    if (IN(PH_NSA)) { ph_ygla_naive(p, bid, nblk, mk_wk); ph_nsa(p, lds, bid, nblk, mk_wk); }
    SEAM(PH_NSA);
    for (int rep_ = 0; rep_ < REP_MERGE; ++rep_)
    if (IN(PH_MERGE)) {
        pg8::StaticOrder S; S.init(NTOK, 1024, nblk, bid);
        { pg8::Gemm g{WSP(bf16_t, WS_YGLA), WSP(bf16_t, WS_PGLAT), NTOK, 1024, 1024, 1024}; EpiMerge<1> E{WSP(unsigned char, WS_MG8), WSP(bf16_t, WS_T1), WSP(bf16_t, WS_MERG)};
          pg8::gemm_phase<EpiMerge<1>, pg8::StaticOrder, true, true>(lds, g, S, E, mk_wk); }
        asm volatile("s_waitcnt vmcnt(0)" ::: "memory"); __syncthreads();
        { pg8::Gemm g{WSP(bf16_t, WS_YNSA), WSP(bf16_t, WS_PNSAT), NTOK, 1024, 1024, 1024}; EpiMerge<2> E{WSP(unsigned char, WS_MG8), WSP(bf16_t, WS_T1), WSP(bf16_t, WS_MERG)};
          pg8::gemm_phase<EpiMerge<2>, pg8::StaticOrder, true, true>(lds, g, S, E, mk_wk); }
    }
    SEAM(PH_MERGE);
    for (int rep_ = 0; rep_ < REP_OUT; ++rep_)
    if (IN(PH_OUT)) {
        pg8::Gemm g{WSP(bf16_t, WS_MERG), WSP(bf16_t, WS_WOUTT), NTOK, 1024, 1024, 1024}; pg8::StaticOrder S; S.init(NTOK, 1024, nblk, bid);
        EpiOut E{p.x, WSP(float, WS_MOD), WSP(bf16_t, WS_H1)};
        pg8::gemm_phase<EpiOut, pg8::StaticOrder, true, true>(lds, g, S, E, mk_wk);
    }
    SEAM(PH_OUT);
    for (int rep_ = 0; rep_ < REP_ROUTE; ++rep_)
    if (IN(PH_ROUTE)) ph_route(p, lds, bid, nblk, mk_wk, rep_ == 0);
    SEAM(PH_ROUTE);
    if (IN(PH_ASSIGN)) { conv_drain(p, lds, MISC + 8, mk_wk, CV_QL); ph_assign(p, lds, bid, nblk, mk_wk); }
    SEAM(PH_ASSIGN);
    for (int rep_ = 0; rep_ < REP_MOE1; ++rep_)
    if (IN(PH_MOE1)) {
        const int* ctl = WSP(int, WS_CTL);
        pg8::Gemm g{WSP(bf16_t, WS_XS), WSP(bf16_t, WS_W1T), PROWS, 2048, 512, 512};
        MoeOrder S(ctl, 8, nblk, bid, (size_t)2048 * 1024);
        EpiSwiglu E{p.moe_b1, WSP(bf16_t, WS_ACT), ctl + CT_BLKE};
        pg8::gemm_phase<EpiSwiglu, MoeOrder, true, true, true>(lds, g, S, E, mk_wk);
    }
    SEAM(PH_MOE1);
    for (int rep_ = 0; rep_ < REP_MOE2; ++rep_)
    if (IN(PH_MOE2)) {
        const int* ctl = WSP(int, WS_CTL);
        pg8::Gemm g{WSP(bf16_t, WS_ACT), WSP(bf16_t, WS_W2T), PROWS, 1024, 512, 512};
        MoeOrder S(ctl, 4, nblk, bid, (size_t)1024 * 1024);
        EpiMoe2 E{p.moe_b2, WSP(bf16_t, WS_YSLOT), ctl + CT_BLKE};
        pg8::gemm_phase<EpiMoe2, MoeOrder, true, true, true>(lds, g, S, E, mk_wk);
    }
    SEAM(PH_MOE2);
    for (int rep_ = 0; rep_ < REP_FINAL; ++rep_)
    if (IN(PH_FINAL)) ph_final(p, bid, nblk, mk_wk);
#undef IN
#undef SEAM
}

extern "C" void kernel_launch(void* const* d_in, const int* in_sizes, int n_in, void* d_out, int out_size, void* d_ws, size_t ws_size, hipStream_t stream) {
    static int grid = 0;
    if (grid == 0) {
        (void)hipFuncSetAttribute((const void*)mega, hipFuncAttributeMaxDynamicSharedMemorySize, MK_LDS_BYTES);
        int dev = 0, cus = 0, per_cu = 0;
        if (hipGetDevice(&dev) != hipSuccess || hipDeviceGetAttribute(&cus, hipDeviceAttributeMultiprocessorCount, dev) != hipSuccess || cus <= 0) cus = 256;
        if (hipOccupancyMaxActiveBlocksPerMultiprocessor(&per_cu, (const void*)mega, NTHR, MK_LDS_BYTES) != hipSuccess || per_cu < 1) per_cu = 1;
        (void)hipGetLastError();
        grid = cus;
    }
    Args a{};
    const float** pp = (const float**)&a.p;
    for (int i = 0; i < 23; ++i) pp[i] = (const float*)d_in[i];
    a.p.out = (float*)d_out; a.p.ws = (unsigned char*)d_ws;
    (void)hipMemsetAsync((char*)d_ws + WS_CTL, 0, 65536, stream);
    a.ph_lo = 0; a.ph_hi = PH_END;
    hipLaunchKernelGGL(mega, dim3(grid), dim3(NTHR), MK_LDS_BYTES, stream, a);
}
```
